# Optimizing an MI355X kernel written in HIP

```python
import math
import jax, jax.numpy as jnp
from jax import lax
import numpy as np

D_MODEL = 1024
BATCH = 8
SEQ = 2048
DEPTH = 2
DEC_BATCH = 128
DEC_SEQ = 8
PAST_LEN = 16384
PAGE_SIZE = 128

R_HEADS = 6
R_DK = 64
R_DV = 64
G_HEADS = 6
G_DK = 32
G_DV = 64
G_RANK = 16
G_NORMALIZER = 16.0
M_HEADS = 4
M_DK = 64
M_DV = 64
CONV_W = 4
R_W = R_HEADS * R_DV
G_W = G_HEADS * G_DV
M_W = M_HEADS * M_DV
D_MIX = R_W + G_W + M_W
X_HEADS = 4
X_HD = D_MODEL // X_HEADS
N_MEM = 256
D_FF = int(math.ceil(8 * D_MODEL / 3 / 256)) * 256
CHUNK = 128
EPS = 1e-6
ROPE_BASE = 10000.0
IN_SIZES = (R_HEADS * R_DK, R_HEADS * R_DK, R_W, R_W,
            G_HEADS * G_DK, G_HEADS * G_DK, G_W, G_W, G_RANK,
            2 * M_HEADS * M_DK, M_W, M_W, M_HEADS, M_HEADS)
D_IN = sum(IN_SIZES)
SPLIT_POINTS = tuple(int(v) for v in np.cumsum(IN_SIZES)[:-1])

kernel_name = 'hybrid_ret_gla_mlstm_step'


def rmsnorm(x, g):
    x32 = x.astype(jnp.float32)
    y = x32 * lax.rsqrt(jnp.mean(x32 * x32, axis=-1, keepdims=True) + EPS)
    return (y * g).astype(x.dtype)


def head_rmsnorm(o, g):
    B, T = o.shape[:2]
    y = o * lax.rsqrt(jnp.mean(o * o, axis=-1, keepdims=True) + EPS)
    return y.reshape(B, T, -1) * g


def rope(x, pos):
    d = x.shape[-1]
    half = d // 2
    inv = ROPE_BASE ** (-jnp.arange(half, dtype=jnp.float32) * 2.0 / d)
    ang = pos[:, None] * inv[None, :]
    cos = jnp.cos(ang)[None, :, None, :]
    sin = jnp.sin(ang)[None, :, None, :]
    x1, x2 = x[..., :half], x[..., half:]
    return jnp.concatenate([x1 * cos - x2 * sin, x1 * sin + x2 * cos], axis=-1)


def _chunk_len(T):
    return CHUNK if T % CHUNK == 0 else T


def _to_chunks(a, L):
    B, T, H = a.shape[:3]
    a = a.reshape((B, T // L, L, H) + a.shape[3:])
    return jnp.moveaxis(jnp.swapaxes(a, 2, 3), 1, 0)


def _from_chunks(o):
    N, B, H, L, d = o.shape
    return jnp.transpose(o, (1, 0, 3, 2, 4)).reshape(B, N * L, H, d)


def retention(q, k, v, S0):
    T = q.shape[1]
    H = q.shape[2]
    L = _chunk_len(T)
    log_gamma = jnp.log(1.0 - 2.0 ** (-5.0 - jnp.arange(H, dtype=jnp.float32)))
    idx = jnp.arange(L, dtype=jnp.float32)
    rel = idx[:, None] - idx[None, :]
    causal = rel >= 0
    decay = jnp.where(causal[None], jnp.exp(log_gamma[:, None, None] * jnp.where(causal, rel, 0.0)[None]), 0.0)
    q_decay = jnp.exp(log_gamma[:, None] * (idx + 1.0))[..., None]
    k_decay = jnp.exp(log_gamma[:, None] * (L - 1.0 - idx))[..., None]
    chunk_decay = jnp.exp(log_gamma * L)[:, None, None]

    def step(S, inp):
        qc, kc, vc = inp
        s = jnp.einsum('bhid,bhjd->bhij', qc, kc) * decay
        o = jnp.einsum('bhij,bhjv->bhiv', s, vc) + jnp.einsum('bhid,bhdv->bhiv', qc, S) * q_decay
        S = S * chunk_decay + jnp.einsum('bhjd,bhjv->bhdv', kc * k_decay, vc)
        return S, o

    S, o = lax.scan(step, S0, (_to_chunks(q, L), _to_chunks(k, L), _to_chunks(v, L)))
    return _from_chunks(o), S


def gla(q, k, v, log_a, S0):
    T = q.shape[1]
    L = _chunk_len(T)
    mask = jnp.tril(jnp.ones((L, L), dtype=bool))[None, None, :, :, None]

    def step(S, inp):
        qc, kc, vc, ac = inp
        b = jnp.cumsum(ac, axis=2)
        rel = jnp.where(mask, b[:, :, :, None, :] - b[:, :, None, :, :], -jnp.inf)
        s = jnp.einsum('bhic,bhjc,bhijc->bhij', qc, kc, jnp.exp(rel))
        o = jnp.einsum('bhij,bhjv->bhiv', s, vc) + jnp.einsum('bhic,bhcv->bhiv', qc * jnp.exp(b), S)
        bL = b[:, :, -1:, :]
        S = S * jnp.exp(bL[:, :, 0, :, None]) + jnp.einsum('bhjc,bhjv->bhcv', kc * jnp.exp(bL - b), vc)
        return S, o

    S, o = lax.scan(step, S0, (_to_chunks(q, L), _to_chunks(k, L), _to_chunks(v, L), _to_chunks(log_a, L)))
    return _from_chunks(o), S


def mlstm(q, k, v, log_i, log_f, C0, n0, m0):
    T = q.shape[1]
    L = _chunk_len(T)
    mask = jnp.tril(jnp.ones((L, L), dtype=bool))

    def step(carry, inp):
        C, n, m = carry
        qc, kc, vc, ic, fc = inp
        F = jnp.cumsum(fc, axis=-1)
        a = F + m[..., None]
        D = jnp.where(mask, F[..., :, None] - F[..., None, :] + ic[..., None, :], -jnp.inf)
        m_tok = jnp.maximum(a, jnp.max(D, axis=-1))
        w_inter = jnp.exp(a - m_tok)
        s = jnp.einsum('bhid,bhjd->bhij', qc, kc) * jnp.exp(D - m_tok[..., None])
        num = jnp.einsum('bhij,bhjv->bhiv', s, vc) + jnp.einsum('bhid,bhdv->bhiv', qc, C) * w_inter[..., None]
        den = jnp.sum(s, axis=-1) + jnp.einsum('bhid,bhd->bhi', qc, n) * w_inter
        h = num / jnp.maximum(jnp.abs(den), jnp.exp(-m_tok))[..., None]
        m_new = m_tok[..., -1]
        wk = jnp.exp(F[..., -1:] - F + ic - m_new[..., None])[..., None]
        scale = jnp.exp(a[..., -1] - m_new)
        C = C * scale[..., None, None] + jnp.einsum('bhjd,bhjv->bhdv', kc * wk, vc)
        n = n * scale[..., None] + jnp.sum(kc * wk, axis=2)
        return (C, n, m_new), h

    (C, n, m), h = lax.scan(step, (C0, n0, m0),
                            (_to_chunks(q, L), _to_chunks(k, L), _to_chunks(v, L),
                             _to_chunks(log_i, L), _to_chunks(log_f, L)))
    return _from_chunks(h), C, n, m


def causal_conv(u, buf, w, b):
    T = u.shape[1]
    up = jnp.concatenate([buf, u], axis=1)
    y = b
    for j in range(CONV_W):
        y = y + up[:, j:j + T, :] * w[j]
    return jax.nn.silu(y), up[:, -(CONV_W - 1):, :]


def mixing(xn, pos, state, w_in, w_ga2, b_ga, conv_w, conv_b, b_i, b_f, g_ret, g_gla, g_mlstm, w_out):
    S_r0, S_g0, C0, n0, m0, buf0 = state
    B, T, _ = xn.shape
    f32 = jnp.float32
    proj = (xn @ w_in).astype(f32)
    (qr, kr, vr, gr, qg, kg, vg, rg, ag, qkm, vm, om, im, fm) = jnp.split(proj, SPLIT_POINTS, axis=-1)
    qr = rope(qr.reshape(B, T, R_HEADS, R_DK), pos) * (R_DK ** -0.5)
    kr = rope(kr.reshape(B, T, R_HEADS, R_DK), pos)
    o_r, S_r = retention(qr, kr, vr.reshape(B, T, R_HEADS, R_DV), S_r0.astype(f32))
    o_r = head_rmsnorm(o_r, g_ret) * jax.nn.silu(gr)
    log_a = jax.nn.log_sigmoid(ag @ w_ga2 + b_ga) / G_NORMALIZER
    o_g, S_g = gla(qg.reshape(B, T, G_HEADS, G_DK) * (G_DK ** -0.5), kg.reshape(B, T, G_HEADS, G_DK),
                   vg.reshape(B, T, G_HEADS, G_DV), log_a.reshape(B, T, G_HEADS, G_DK), S_g0.astype(f32))
    o_g = head_rmsnorm(o_g, g_gla) * jax.nn.silu(rg)
    qk, buf = causal_conv(qkm, buf0.astype(f32), conv_w, conv_b)
    qm, km = jnp.split(qk, 2, axis=-1)
    log_i = im + b_i
    log_f = jax.nn.log_sigmoid(fm + b_f)
    h_m, C, n, m = mlstm(qm.reshape(B, T, M_HEADS, M_DK), km.reshape(B, T, M_HEADS, M_DK) * (M_DK ** -0.5),
                         vm.reshape(B, T, M_HEADS, M_DV), log_i, log_f,
                         C0.astype(f32), n0.astype(f32), m0.astype(f32))
    o_m = head_rmsnorm(h_m, g_mlstm) * jax.nn.sigmoid(om)
    out = jnp.concatenate([o_r, o_g, o_m], axis=-1).astype(xn.dtype) @ w_out
    new_state = (S_r.astype(S_r0.dtype), S_g.astype(S_g0.dtype), C.astype(C0.dtype),
                 n.astype(n0.dtype), m.astype(m0.dtype), buf.astype(buf0.dtype))
    return out, new_state


def memory_kv(mem, g_mem, w_xk, w_xv):
    B = mem.shape[0]
    mn = rmsnorm(mem, g_mem)
    k = (mn @ w_xk).reshape(B, N_MEM, X_HEADS, X_HD)
    v = (mn @ w_xv).reshape(B, N_MEM, X_HEADS, X_HD)
    return k, v


def cross_attn(xn, mk, mv, w_xq, w_xo):
    B, T, _ = xn.shape
    q = (xn @ w_xq).reshape(B, T, X_HEADS, X_HD)
    s = jnp.einsum('bthd,bmhd->bhtm', q, mk).astype(jnp.float32) * (X_HD ** -0.5)
    p = jax.nn.softmax(s, axis=-1).astype(xn.dtype)
    o = jnp.einsum('bhtm,bmhd->bthd', p, mv).reshape(B, T, X_HEADS * X_HD)
    return o @ w_xo


def swiglu(xn, w_gate, w_up, w_down):
    return (jax.nn.silu(xn @ w_gate) * (xn @ w_up)) @ w_down


def layer(x, pos, mem_k, mem_v, state, lw):
    (g_mix, w_in, w_ga2, b_ga, conv_w, conv_b, b_i, b_f, g_ret, g_gla, g_mlstm, w_out,
     g_xattn, w_xq, w_xo, g_ffn, w_gate, w_up, w_down) = lw
    mix, new_state = mixing(rmsnorm(x, g_mix), pos, state, w_in, w_ga2, b_ga, conv_w, conv_b,
                            b_i, b_f, g_ret, g_gla, g_mlstm, w_out)
    x = x + mix
    x = x + cross_attn(rmsnorm(x, g_xattn), mem_k, mem_v, w_xq, w_xo)
    x = x + swiglu(rmsnorm(x, g_ffn), w_gate, w_up, w_down)
    return x, new_state


def setup_inputs(seed: int = 0) -> dict:
    key = jax.random.key(seed)
    ks = iter(jax.random.split(key, 48))
    f32 = jnp.float32

    def nrm(shape, scale):
        return scale * jax.random.normal(next(ks), shape, f32)

    def gain(shape):
        return 1.0 + 0.01 * jax.random.normal(next(ks), shape, f32)

    QK_M = 2 * M_HEADS * M_DK
    return {
        'x_prompt': nrm((BATCH, SEQ, D_MODEL), 1.0),
        'x_sample': nrm((DEC_BATCH, DEC_SEQ, D_MODEL), 1.0),
        'state_ret': nrm((DEPTH, DEC_BATCH, R_HEADS, R_DK, R_DV), 1.0),
        'state_gla': nrm((DEPTH, DEC_BATCH, G_HEADS, G_DK, G_DV), 1.0),
        'state_mlstm_C': nrm((DEPTH, DEC_BATCH, M_HEADS, M_DK, M_DV), 0.5),
        'state_mlstm_n': nrm((DEPTH, DEC_BATCH, M_HEADS, M_DK), 1.0),
        'state_mlstm_m': nrm((DEPTH, DEC_BATCH, M_HEADS), 0.5),
        'state_mlstm_conv': nrm((DEPTH, DEC_BATCH, CONV_W - 1, QK_M), 1.0),
        'cache_mem_k': nrm((DEPTH, DEC_BATCH, N_MEM, X_HEADS, X_HD), 1.0),
        'cache_mem_v': nrm((DEPTH, DEC_BATCH, N_MEM, X_HEADS, X_HD), 1.0),
        'mem_prompt': nrm((BATCH, N_MEM, D_MODEL), 1.0),
        'g_mix': gain((DEPTH, D_MODEL)),
        'w_in': nrm((DEPTH, D_MODEL, D_IN), D_MODEL ** -0.5),
        'w_ga2': nrm((DEPTH, G_RANK, G_HEADS * G_DK), G_RANK ** -0.5),
        'b_ga': nrm((DEPTH, G_HEADS * G_DK), 0.1),
        'conv_w': nrm((DEPTH, CONV_W, QK_M), CONV_W ** -0.5),
        'conv_b': nrm((DEPTH, QK_M), 0.01),
        'b_i': nrm((DEPTH, M_HEADS), 0.1),
        'b_f': jnp.linspace(3.0, 6.0, M_HEADS, dtype=f32)[None, :] + nrm((DEPTH, M_HEADS), 0.1),
        'g_ret': gain((DEPTH, R_W)),
        'g_gla': gain((DEPTH, G_W)),
        'g_mlstm': gain((DEPTH, M_W)),
        'w_out': nrm((DEPTH, D_MIX, D_MODEL), D_MIX ** -0.5),
        'g_xattn': gain((DEPTH, D_MODEL)),
        'g_mem': gain((DEPTH, D_MODEL)),
        'w_xq': nrm((DEPTH, D_MODEL, X_HEADS * X_HD), D_MODEL ** -0.5),
        'w_xk': nrm((DEPTH, D_MODEL, X_HEADS * X_HD), D_MODEL ** -0.5),
        'w_xv': nrm((DEPTH, D_MODEL, X_HEADS * X_HD), D_MODEL ** -0.5),
        'w_xo': nrm((DEPTH, X_HEADS * X_HD, D_MODEL), (X_HEADS * X_HD) ** -0.5),
        'g_ffn': gain((DEPTH, D_MODEL)),
        'w_gate': nrm((DEPTH, D_MODEL, D_FF), D_MODEL ** -0.5),
        'w_up': nrm((DEPTH, D_MODEL, D_FF), D_MODEL ** -0.5),
        'w_down': nrm((DEPTH, D_FF, D_MODEL), D_FF ** -0.5),
        'g_final': gain((D_MODEL,)),
    }


def reference(x_prompt, x_sample, state_ret, state_gla, state_mlstm_C, state_mlstm_n, state_mlstm_m,
              state_mlstm_conv, cache_mem_k, cache_mem_v, mem_prompt, g_mix, w_in, w_ga2, b_ga, conv_w,
              conv_b, b_i, b_f, g_ret, g_gla, g_mlstm, w_out, g_xattn, g_mem, w_xq, w_xk, w_xv, w_xo,
              g_ffn, w_gate, w_up, w_down, g_final):
    B, T, _ = x_prompt.shape
    Ts = x_sample.shape[1]
    dt = x_prompt.dtype
    pos_p = jnp.arange(T, dtype=jnp.float32)
    pos_s = PAST_LEN + jnp.arange(Ts, dtype=jnp.float32)
    hp, hs = x_prompt, x_sample
    p_st = [[] for _ in range(6)]
    s_st = [[] for _ in range(6)]
    p_mk, p_mv = [], []
    for l in range(DEPTH):
        lw = (g_mix[l], w_in[l], w_ga2[l], b_ga[l], conv_w[l], conv_b[l], b_i[l], b_f[l], g_ret[l],
              g_gla[l], g_mlstm[l], w_out[l], g_xattn[l], w_xq[l], w_xo[l], g_ffn[l], w_gate[l],
              w_up[l], w_down[l])
        mk, mv = memory_kv(mem_prompt, g_mem[l], w_xk[l], w_xv[l])
        init_p = (jnp.zeros((B, R_HEADS, R_DK, R_DV), dt), jnp.zeros((B, G_HEADS, G_DK, G_DV), dt),
                  jnp.zeros((B, M_HEADS, M_DK, M_DV), dt), jnp.zeros((B, M_HEADS, M_DK), dt),
                  jnp.zeros((B, M_HEADS), dt), jnp.zeros((B, CONV_W - 1, 2 * M_HEADS * M_DK), dt))
        hp, new_p = layer(hp, pos_p, mk, mv, init_p, lw)
        p_mk.append(mk)
        p_mv.append(mv)
        init_s = (state_ret[l], state_gla[l], state_mlstm_C[l], state_mlstm_n[l], state_mlstm_m[l],
                  state_mlstm_conv[l])
        hs, new_s = layer(hs, pos_s, cache_mem_k[l], cache_mem_v[l], init_s, lw)
        for i in range(6):
            p_st[i].append(new_p[i])
            s_st[i].append(new_s[i])
    y_prompt = rmsnorm(hp, g_final)
    y_sample = rmsnorm(hs, g_final)
    p_ret, p_gla, p_C, p_n, p_m, p_conv = [jnp.stack(a, axis=0) for a in p_st]
    s_ret, s_gla, s_C, s_n, s_m, s_conv = [jnp.stack(a, axis=0) for a in s_st]
    p_mem_k = jnp.stack(p_mk, axis=0)
    p_mem_v = jnp.stack(p_mv, axis=0)
    return (y_prompt, y_sample, p_ret, p_gla, p_C, p_n, p_m, p_conv, p_mem_k, p_mem_v,
            s_ret, s_gla, s_C, s_n, s_m, s_conv)
```

```cpp
#include <hip/hip_runtime.h>
#include <hip/hip_cooperative_groups.h>
#include <cstdio>
#include <cstdint>
namespace cg = cooperative_groups;
__device__ __forceinline__ int opaque_tid() { int t = threadIdx.x; asm volatile("" : "+v"(t)); return t; }
#define DBG_CHAIN 0
#define REP_MASK 0
#define DBG_REP_SAMPLE 0
#define DBG_DUP 0
#define DBG_VAR 0
#define DBG_TYPES 7
#define DBG_REPS 1
#define DBG_NOLO 0
#define DBG_EXTRA_BARS 0
#define DBG_UNIT_REPS 1
#ifndef DBG_SMALL_MODE
#define DBG_SMALL_MODE 0
#endif

namespace pg8 {
#define PG8_LAS __attribute__((address_space(3)))
typedef unsigned short bf16_t;
typedef short bf16x8 __attribute__((ext_vector_type(8)));
typedef float f32x4 __attribute__((ext_vector_type(4)));
typedef unsigned u32x4 __attribute__((ext_vector_type(4)));
constexpr int BM = 256, BK = 64, HALF = 128, HTB = HALF * BK * 2  , STAGE_BYTES = 8 * HTB, NXCD = 8, WGM = 8;

__host__ __device__ __forceinline__ int lds_byte(int r, int c) { const int st = (r >> 4) * 2 + (c >> 5), rr = r & 15, cc = c & 31, ob = rr * 64 + cc * 2; return st * 1024 + (ob ^ (((ob >> 9) & 1) << 5)); }
__host__ __device__ __forceinline__ void stage_rc(int b, int& R, int& C) { const int st = b / 1024, sb = b % 1024, swz = sb ^ (((sb >> 9) & 1) << 5); R = (st >> 1) * 16 + swz / 64; C = (st & 1) * 32 + (swz % 64) / 2; }
__host__ __device__ __forceinline__ int perm32(int rho) { const int n = rho >> 4, i = rho & 15; return 8 * (i >> 2) + 4 * n + (i & 3); }

struct Unit { int pm, pn; };
struct Gemm { const bf16_t* A; const bf16_t* Bt; int M, N, K; };

struct StaticOrder {
    int nM, nN, nwg, G, c;
    __host__ __device__ void init(int M, int N, int G_, int c_) { nM = M / BM; nN = N / BM; nwg = nM * nN; G = G_; c = c_; }
    __host__ __device__ bool next(int i, Unit& u) const {
        const long L = (long)i * G + c; if (L >= nwg) return false;
        int wgid = (int)L; { const int q = nwg / NXCD, r = nwg % NXCD, xcd = wgid % NXCD, off = wgid / NXCD; wgid = (xcd < r ? xcd * (q + 1) : r * (q + 1) + (xcd - r) * q) + off; }
        const int nig = WGM * nN, gid = wgid / nig, fm = gid * WGM, gsz = (nM - fm) < WGM ? (nM - fm) : WGM;
        u.pm = fm + ((wgid % nig) % gsz); u.pn = (wgid % nig) / gsz; return true;
    }
    __device__ __forceinline__ void a_ready(const Unit&) const {}
    __device__ __forceinline__ void done(const Unit&) const {}
};
template <class Epi, class Sched, bool ALIGN_EPI = false, bool SP2 = false, bool SROWS = false>
__device__ __forceinline__ void gemm_phase(PG8_LAS unsigned char* lds, const Gemm g, const Sched& S, const Epi& E) {
    const int tid = opaque_tid(), wid = __builtin_amdgcn_readfirstlane(tid >> 6), lane = tid & 63, wr = wid >> 2, wc = wid & 3, fr = lane & 15, fq = lane >> 4;
    const int K = g.K, nt = K / BK;
    unsigned voffA[2], voffB[2];
#pragma unroll
    for (int i = 0; i < 2; ++i) { int R, C; stage_rc(tid * 16 + i * 8192, R, C); const int Rb = Epi::PERM ? ((R & ~31) + perm32(R & 31)) : R;
        voffA[i] = (unsigned)(R * K + C) * 2u; voffB[i] = (unsigned)(Rb * K + C) * 2u; }
    const size_t kstep = (size_t)(BK * 2);
    const size_t hstep = (size_t)HALF * K * 2;
    const size_t tstep = 2 * hstep;
    const unsigned ldsw = (unsigned)wid * 1024u;
    const int aoff = lds_byte(wr * 64 + fr, fq * 8), boff = lds_byte(wc * 32 + fr, fq * 8);
#define PG8_SA(b, h) (((b) * 2 + (h)) * HTB)
#define PG8_SB(b, h) ((4 + (b) * 2 + (h)) * HTB)
#define PG8_STAGE(bufoff, gbase, voff) do { _Pragma("unroll") for (int _i = 0; _i < 2; ++_i) \
        __builtin_amdgcn_global_load_lds((const unsigned*)((const char*)(gbase) + (voff)[_i]), (PG8_LAS unsigned*)(lds + (bufoff) + ldsw + _i * 8192), 16, 0, 0); } while (0)
#define PG8_LDA(dst, b, h) do { _Pragma("unroll") for (int m = 0; m < 4; ++m) _Pragma("unroll") for (int k = 0; k < 2; ++k) dst[m][k] = *(const PG8_LAS bf16x8*)(lds + PG8_SA(b, h) + aoff + m * 2048 + k * 1024); } while (0)
#define PG8_LDB(dst, b, h) do { _Pragma("unroll") for (int n = 0; n < 2; ++n) _Pragma("unroll") for (int k = 0; k < 2; ++k) dst[n][k] = *(const PG8_LAS bf16x8*)(lds + PG8_SB(b, h) + boff + n * 2048 + k * 1024); } while (0)
#define PG8_MMA(ai, bj, At, Bt) do { __builtin_amdgcn_s_setprio(1); _Pragma("unroll") for (int m = 0; m < 4; ++m) _Pragma("unroll") for (int n = 0; n < 2; ++n) _Pragma("unroll") for (int k = 0; k < 2; ++k) \
        acc[ai][bj][m][n] = __builtin_amdgcn_mfma_f32_16x16x32_bf16(Bt[n][k], At[m][k], acc[ai][bj][m][n], 0, 0, 0); __builtin_amdgcn_s_setprio(0); } while (0)
#define PG8_WAIT_V(n) asm volatile("s_waitcnt vmcnt(" #n ")" ::: "memory")
#define PG8_WAIT_L(n) asm volatile("s_waitcnt lgkmcnt(" #n ")" ::: "memory")
#define PG8_BAR __builtin_amdgcn_s_barrier()
#define PG8_SCHED __builtin_amdgcn_sched_barrier(0)
    Unit cur, nxt; int ui = 0;
    if (!S.next(0, cur)) return;
    f32x4 acc[2][2][4][2];
#pragma unroll
    for (int a = 0; a < 2; ++a)
#pragma unroll
        for (int b = 0; b < 2; ++b)
#pragma unroll
            for (int m = 0; m < 4; ++m)
#pragma unroll
                for (int n = 0; n < 2; ++n) acc[a][b][m][n] = (f32x4){0.f, 0.f, 0.f, 0.f};
    bf16x8 At[4][2], B0[2][2], B1[2][2];
    f32x4 accS[2]; bf16x8 AsS[2]; const char* sA = (const char*)g.A; unsigned voffS = 0u;
    accS[0] = (f32x4){0.f, 0.f, 0.f, 0.f}; accS[1] = (f32x4){0.f, 0.f, 0.f, 0.f};
    AsS[0] = (bf16x8){0, 0, 0, 0, 0, 0, 0, 0}; AsS[1] = AsS[0];
#define PG8_SLOAD(tn) do { const char* pt_ = sA + (size_t)(tn) * 128; \
        asm volatile("global_load_dwordx4 %0, %1, %2" : "+v"(AsS[0]) : "v"(voffS), "s"(pt_) : "memory"); \
        asm volatile("global_load_dwordx4 %0, %1, %2 offset:64" : "+v"(AsS[1]) : "v"(voffS), "s"(pt_) : "memory"); } while (0)
#define PG8_SFENCE() do { if constexpr (SROWS) asm volatile("" : "+v"(AsS[0]), "+v"(AsS[1])); } while (0)
    if constexpr (SROWS) {
        static_assert(SP2, "SROWS needs the SP2 loop");
        sA = (const char*)g.A + (size_t)(g.M + 16 * cur.pm) * K * 2; voffS = (unsigned)(fr * K + fq * 8) * 2u;
        PG8_SLOAD(0);
    }
#define PG8_SMMA(tn) do { if constexpr (SROWS) { __builtin_amdgcn_s_setprio(1); \
        if (wr == 0) { _Pragma("unroll") for (int n = 0; n < 2; ++n) _Pragma("unroll") for (int k = 0; k < 2; ++k) accS[n] = __builtin_amdgcn_mfma_f32_16x16x32_bf16(B0[n][k], AsS[k], accS[n], 0, 0, 0); } \
        else         { _Pragma("unroll") for (int n = 0; n < 2; ++n) _Pragma("unroll") for (int k = 0; k < 2; ++k) accS[n] = __builtin_amdgcn_mfma_f32_16x16x32_bf16(B1[n][k], AsS[k], accS[n], 0, 0, 0); } \
        __builtin_amdgcn_s_setprio(0); \
        if ((tn) < nt) PG8_SLOAD(tn); } } while (0)
#define PG8_WAIT_V2(tn) do { if constexpr (SROWS) { if ((tn) < nt) PG8_WAIT_V(10); else PG8_WAIT_V(8); } else PG8_WAIT_V(8); } while (0)
    const char* cA = (const char*)g.A + (size_t)cur.pm * tstep; const char* cB = (const char*)g.Bt + (size_t)cur.pn * tstep;
    S.a_ready(cur);
    if constexpr (SP2) {
        PG8_STAGE(PG8_SB(0, 0), cB, voffB); PG8_STAGE(PG8_SB(0, 1), cB + hstep, voffB); PG8_STAGE(PG8_SA(0, 0), cA, voffA); PG8_STAGE(PG8_SA(0, 1), cA + hstep, voffA);
        if (wr == 1) PG8_BAR;
        PG8_WAIT_V(2); PG8_BAR;
        PG8_STAGE(PG8_SB(1, 0), cB + kstep, voffB); PG8_STAGE(PG8_SA(1, 0), cA + kstep, voffA); PG8_STAGE(PG8_SB(1, 1), cB + hstep + kstep, voffB);
        PG8_WAIT_V(6); PG8_BAR;
    } else {
        PG8_STAGE(PG8_SB(0, 0), cB, voffB); PG8_STAGE(PG8_SA(0, 0), cA, voffA); PG8_STAGE(PG8_SB(0, 1), cB + hstep, voffB); PG8_STAGE(PG8_SA(0, 1), cA + hstep, voffA);
        if (wr == 1) PG8_BAR;
        PG8_WAIT_V(4); PG8_BAR;
        PG8_STAGE(PG8_SB(1, 0), cB + kstep, voffB); PG8_STAGE(PG8_SA(1, 0), cA + kstep, voffA); PG8_STAGE(PG8_SB(1, 1), cB + hstep + kstep, voffB);
        PG8_WAIT_V(6); PG8_BAR;
    }
    for (;;) {
        const bool has_next = S.next(ui + 1, nxt);
        const char* nA = has_next ? (const char*)g.A + (size_t)nxt.pm * tstep : cA; const char* nB = has_next ? (const char*)g.Bt + (size_t)nxt.pn * tstep : cB;
        for (int t = 0; t < nt; t += 2) {
            const bool last = (t == nt - 2);
            const char* a1 = cA + (size_t)(t + 1) * kstep;
            const char* a2 = last ? nA : cA + (size_t)(t + 2) * kstep; const char* b2 = last ? nB : cB + (size_t)(t + 2) * kstep;
            const char* a3 = a2 + kstep; const char* b3 = b2 + kstep;
            if (last && has_next) S.a_ready(nxt);
            if constexpr (SP2) {
            PG8_LDB(B0, 0, 0); PG8_LDB(B1, 0, 1); PG8_SCHED; PG8_LDA(At, 0, 0); PG8_STAGE(PG8_SA(1, 1), a1 + hstep, voffA);
            PG8_WAIT_V(8); PG8_WAIT_L(0); PG8_BAR; PG8_SFENCE(); PG8_MMA(0, 0, At, B0); PG8_MMA(0, 1, At, B1); PG8_SMMA(t + 1); PG8_BAR; PG8_SCHED;
            PG8_LDA(At, 0, 1); PG8_STAGE(PG8_SB(0, 0), b2, voffB); PG8_STAGE(PG8_SB(0, 1), b2 + hstep, voffB); PG8_STAGE(PG8_SA(0, 0), a2, voffA);
            PG8_WAIT_V2(t + 1); PG8_WAIT_L(0); PG8_BAR; PG8_MMA(1, 0, At, B0); PG8_MMA(1, 1, At, B1); PG8_BAR; PG8_SCHED;
            PG8_LDB(B0, 1, 0); PG8_LDB(B1, 1, 1); PG8_SCHED; PG8_LDA(At, 1, 0); PG8_STAGE(PG8_SA(0, 1), a2 + hstep, voffA);
            PG8_WAIT_V(8); PG8_WAIT_L(0); PG8_BAR; PG8_SFENCE(); PG8_MMA(0, 0, At, B0); PG8_MMA(0, 1, At, B1); PG8_SMMA(t + 2); PG8_BAR; PG8_SCHED;
            PG8_LDA(At, 1, 1); PG8_STAGE(PG8_SB(1, 0), b3, voffB); PG8_STAGE(PG8_SB(1, 1), b3 + hstep, voffB); PG8_STAGE(PG8_SA(1, 0), a3, voffA);
            PG8_WAIT_V2(t + 2); PG8_WAIT_L(0); PG8_BAR; PG8_MMA(1, 0, At, B0); PG8_MMA(1, 1, At, B1); PG8_BAR; PG8_SCHED;
            } else {
            PG8_LDB(B0, 0, 0); PG8_SCHED; PG8_LDA(At, 0, 0); PG8_STAGE(PG8_SA(1, 1), a1 + hstep, voffA);
            PG8_WAIT_L(8); PG8_BAR; PG8_WAIT_L(0); PG8_MMA(0, 0, At, B0); PG8_BAR; PG8_SCHED;
            PG8_LDB(B1, 0, 1); PG8_STAGE(PG8_SB(0, 0), b2, voffB);
            PG8_BAR; PG8_WAIT_L(0); PG8_MMA(0, 1, At, B1); PG8_BAR;
            PG8_LDA(At, 0, 1); PG8_STAGE(PG8_SA(0, 0), a2, voffA);
            PG8_BAR; PG8_WAIT_L(0); PG8_MMA(1, 0, At, B0); PG8_BAR; PG8_SCHED;
            PG8_STAGE(PG8_SB(0, 1), b2 + hstep, voffB);
            PG8_WAIT_V(6); PG8_BAR; PG8_MMA(1, 1, At, B1); PG8_BAR;
            PG8_LDB(B0, 1, 0); PG8_SCHED; PG8_LDA(At, 1, 0); PG8_STAGE(PG8_SA(0, 1), a2 + hstep, voffA);
            PG8_WAIT_L(8); PG8_BAR; PG8_WAIT_L(0); PG8_MMA(0, 0, At, B0); PG8_BAR; PG8_SCHED;
            PG8_LDB(B1, 1, 1); PG8_STAGE(PG8_SB(1, 0), b3, voffB);
            PG8_BAR; PG8_WAIT_L(0); PG8_MMA(0, 1, At, B1); PG8_BAR;
            PG8_LDA(At, 1, 1); PG8_STAGE(PG8_SA(1, 0), a3, voffA);
            PG8_BAR; PG8_WAIT_L(0); PG8_MMA(1, 0, At, B0); PG8_BAR; PG8_SCHED;
            PG8_STAGE(PG8_SB(1, 1), b3 + hstep, voffB);
            PG8_WAIT_V(6); PG8_BAR; PG8_MMA(1, 1, At, B1); PG8_BAR;
            }
        }
        if constexpr (ALIGN_EPI) { if (wr == 0) PG8_BAR; }
        if constexpr (!Epi::AFTER_DRAIN) { E(acc, cur, wr, wc, fr, fq); S.done(cur); }
        if (!has_next) break;
#pragma unroll
        for (int a = 0; a < 2; ++a)
#pragma unroll
            for (int b = 0; b < 2; ++b)
#pragma unroll
                for (int m = 0; m < 4; ++m)
#pragma unroll
                    for (int n = 0; n < 2; ++n) acc[a][b][m][n] = (f32x4){0.f, 0.f, 0.f, 0.f};
        cur = nxt; cA = nA; cB = nB; ++ui;
        if constexpr (ALIGN_EPI) { if (wr == 1) PG8_BAR; }
    }
    PG8_WAIT_V(0);
    if constexpr (!ALIGN_EPI) { if (wr == 0) PG8_BAR; }
    PG8_BAR;
    if constexpr (Epi::AFTER_DRAIN) { E.fused(acc, accS, SROWS, cur, wr, wc, fr, fq, lds, wid, lane); S.done(cur); }
    else if constexpr (SROWS) E.sample16(accS, cur, wr, wc, fr, fq, lds, wid);
#undef PG8_SMMA
#undef PG8_SLOAD
#undef PG8_SFENCE
#undef PG8_WAIT_V2
#undef PG8_SA
#undef PG8_SB
#undef PG8_STAGE
#undef PG8_LDA
#undef PG8_LDB
#undef PG8_MMA
#undef PG8_WAIT_V
#undef PG8_WAIT_L
#undef PG8_BAR
#undef PG8_SCHED
}
}
#define LAS __attribute__((address_space(3)))
typedef unsigned short bf16;
typedef short bf16x8 __attribute__((ext_vector_type(8)));
typedef float f32x4 __attribute__((ext_vector_type(4)));
typedef unsigned u32x4 __attribute__((ext_vector_type(4)));
typedef unsigned u32x2 __attribute__((ext_vector_type(2)));

constexpr int DM = 1024, NB = 8, SEQ = 2048, DEPTH = 2, DECB = 128, DECT = 8;
constexpr int MP = NB * SEQ, MS = DECB * DECT, MT = MP + MS;
constexpr int NPROJ = 3840;
constexpr int DFF = 2816, NGU = 2 * DFF;
constexpr int NMEM = 256, XH = 4, XHD = 256;
constexpr float EPS = 1e-6f;
constexpr int C_QR = 0, C_KR = 384, C_VR = 768, C_GR = 1152, C_QG = 1536, C_KG = 1728, C_VG = 1920, C_RG = 2304;
constexpr int C_QKM = 2688, C_VM = 3200, C_OM = 3456, C_GATES = 3712;
enum { I_XP = 0, I_XS, I_SRET, I_SGLA, I_SC, I_SN, I_SM, I_SCONV, I_CK, I_CV, I_MEMP, I_GMIX, I_WIN, I_WGA2, I_BGA, I_CONVW, I_CONVB, I_BI, I_BF,
       I_GRET, I_GGLA, I_GMLSTM, I_WOUT, I_GXATTN, I_GMEM, I_WXQ, I_WXK, I_WXV, I_WXO, I_GFFN, I_WGATE, I_WUP, I_WDOWN, I_GFINAL, N_IN };
constexpr size_t O_YP = 0, O_YS = O_YP + (size_t)MP * DM, O_PRET = O_YS + (size_t)MS * DM, O_PGLA = O_PRET + 2 * 8 * 6 * 64 * 64,
                 O_PC = O_PGLA + 2 * 8 * 6 * 32 * 64, O_PN = O_PC + 2 * 8 * 4 * 64 * 64, O_PM = O_PN + 2 * 8 * 4 * 64, O_PCONV = O_PM + 2 * 8 * 4,
                 O_PMK = O_PCONV + 2 * 8 * 3 * 512, O_PMV = O_PMK + (size_t)2 * 8 * 256 * 1024, O_SRET = O_PMV + (size_t)2 * 8 * 256 * 1024,
                 O_SGLA = O_SRET + (size_t)2 * 128 * 6 * 64 * 64, O_SC = O_SGLA + (size_t)2 * 128 * 6 * 32 * 64, O_SN = O_SC + (size_t)2 * 128 * 4 * 64 * 64,
                 O_SM = O_SN + 2 * 128 * 4 * 64, O_SCONV = O_SM + 2 * 128 * 4, O_END = O_SCONV + 2 * 128 * 3 * 512;
constexpr size_t MiB = 1u << 20;
constexpr size_t WS_CTL = 0, CTL_BYTES = 1 * MiB;
constexpr size_t WS_WIN = 1 * MiB, WS_WOUT = 16 * MiB, WS_WXQ = 20 * MiB, WS_WXO = 24 * MiB, WS_WXKV = 28 * MiB, WS_WGU = 36 * MiB, WS_WDN = 58 * MiB;
constexpr size_t WS_ROPE = 69 * MiB, WS_RSS = 70 * MiB, WS_RMEM = 72 * MiB, WS_MEMB = 73 * MiB, WS_MEMK = 77 * MiB, WS_MEMVT = 85 * MiB, WS_PROJG = 93 * MiB;
constexpr size_t WS_XB = 96 * MiB, WS_XF = 130 * MiB, WS_PROJ = 198 * MiB, WS_O = 326 * MiB, WS_Q = 360 * MiB, WS_ATT = 394 * MiB, WS_H = 428 * MiB;
constexpr size_t WS_QKC = 522 * MiB, WS_GM = 538 * MiB, WS_CM = 539 * MiB, WS_GQ = 540 * MiB, WS_GK = 546 * MiB, WS_GKT = 552 * MiB, WS_GBL = 558 * MiB, WS_END = 559 * MiB;
static_assert(WS_WIN + (size_t)2 * NPROJ * DM * 2 <= WS_WOUT && WS_WGU + (size_t)2 * NGU * DM * 2 <= WS_WDN && WS_WDN + (size_t)2 * DM * DFF * 2 <= WS_ROPE, "ws map");
static_assert(WS_XB + (size_t)MT * DM * 2 <= WS_XF && WS_XF + (size_t)MT * DM * 4 <= WS_PROJ && WS_PROJ + (size_t)MT * NPROJ * 2 <= WS_O && WS_H + (size_t)MT * DFF * 2 <= WS_QKC, "ws map 2");
constexpr int LDS_BYTES = 147456;
constexpr int NTHREADS = 512;

struct Params { const float* in[N_IN]; float* out; unsigned char* ws; int ph_lo, ph_hi; };
typedef const __attribute__((address_space(4))) Params* PP;
__device__ __forceinline__ PP get_params() { PP p = (PP)__builtin_amdgcn_kernarg_segment_ptr(); asm volatile("" : "+s"(p)); return p; }

__device__ __forceinline__ float bf2f(unsigned short b) { return __uint_as_float(((unsigned)b) << 16); }
typedef __bf16 bf16x2_t __attribute__((ext_vector_type(2)));
__device__ __forceinline__ unsigned pk2(float lo, float hi) { bf16x2_t v = {(__bf16)lo, (__bf16)hi}; return __builtin_bit_cast(unsigned, v); }
__device__ __forceinline__ unsigned short f2bf(float f) { return __builtin_bit_cast(unsigned short, (__bf16)f); }
__device__ __forceinline__ float wave_sum(float v) {
#pragma unroll
    for (int o = 1; o < 64; o <<= 1) v += __shfl_xor(v, o);
    return v;
}
template <int CTRL, int ROW_MASK>
__device__ __forceinline__ float dpp_f(float oldv, float src) {
    return __builtin_bit_cast(float, __builtin_amdgcn_update_dpp(__builtin_bit_cast(int, oldv), __builtin_bit_cast(int, src), CTRL, ROW_MASK, 0xf, false));
}
__device__ __forceinline__ float scan_sum(float v, int lane) {
    (void)lane;
    v += dpp_f<0x111, 0xf>(0.f, v); v += dpp_f<0x112, 0xf>(0.f, v); v += dpp_f<0x114, 0xf>(0.f, v); v += dpp_f<0x118, 0xf>(0.f, v);
    v += dpp_f<0x142, 0xa>(0.f, v); v += dpp_f<0x143, 0xc>(0.f, v);
    return v;
}
__device__ __forceinline__ float scan_max(float v, int lane) {
    (void)lane;
    const float ninf = -3.0e38f;
    v = fmaxf(v, dpp_f<0x111, 0xf>(ninf, v)); v = fmaxf(v, dpp_f<0x112, 0xf>(ninf, v)); v = fmaxf(v, dpp_f<0x114, 0xf>(ninf, v)); v = fmaxf(v, dpp_f<0x118, 0xf>(ninf, v));
    v = fmaxf(v, dpp_f<0x142, 0xa>(ninf, v)); v = fmaxf(v, dpp_f<0x143, 0xc>(ninf, v));
    return v;
}
__device__ __forceinline__ float log_sigmoid(float x) { return fminf(x, 0.f) - log1pf(expf(-fabsf(x))); }
__device__ __forceinline__ float sigmoidf(float x) { return 1.f / (1.f + expf(-x)); }
__device__ __forceinline__ float siluf(float x) { return x / (1.f + expf(-x)); }
__device__ __forceinline__ f32x4 mma16(bf16x8 x, bf16x8 y, f32x4 c) { return __builtin_amdgcn_mfma_f32_16x16x32_bf16(x, y, c, 0, 0, 0); }
__device__ __forceinline__ bf16x8 lfrag(const LAS unsigned char* base, int row, int ld, int k) { return *(const LAS bf16x8*)(base + ((size_t)row * ld + k) * 2); }
#define XB_TMO      128
#define XB_XCNT(j)  (256  + 64 * (j))
#define XB_XSUB(j)  (1280 + 64 * (j))
#define XB_XGEN(j)  (2304 + 64 * (j))
#define XB_TOP      3328
#define XB_TOPGEN   3392
#define XCD_BAR_WORDS 3456
#define XB_SPIN_CAP (1u << 18)

__device__ __forceinline__ unsigned xb_ld(unsigned* p)              { return __hip_atomic_load(p, __ATOMIC_RELAXED, __HIP_MEMORY_SCOPE_AGENT); }
__device__ __forceinline__ unsigned xb_add(unsigned* p, unsigned v) { return __hip_atomic_fetch_add(p, v, __ATOMIC_RELAXED, __HIP_MEMORY_SCOPE_AGENT); }
__device__ __forceinline__ unsigned xb_xcc_id() { return (unsigned)__builtin_amdgcn_s_getreg((3 << 11) | 20) & 0xFu; }
#define XB_SPIN(cond, bar) do { unsigned _sp = 0; while (cond) { __builtin_amdgcn_s_sleep(1); \
    if ((++_sp & 255u) == 0u) { if (xb_ld(&(bar)[XB_TMO])) break; if (_sp > XB_SPIN_CAP) { atomicAdd(&(bar)[XB_TMO], 1u); break; } } } } while (0)

struct XcdBarrier {
    unsigned* bar; unsigned x;
    volatile LAS unsigned* st;
};

__device__ __forceinline__ XcdBarrier xcd_barrier_post(unsigned* bar, volatile LAS unsigned* st) {
    XcdBarrier b; b.bar = bar; b.x = xb_xcc_id(); b.st = st;
    if (threadIdx.x == 0) (void)xb_add(&bar[XB_XCNT(b.x)], 1u);
    return b;
}
__device__ __forceinline__ void xcd_barrier_complete(unsigned* bar, unsigned x, unsigned& nloc, unsigned& nx) {
    const unsigned G = gridDim.x * gridDim.y * gridDim.z;
    unsigned sum, cnt, mine, sp = 0u;
    for (;;) {
        sum = 0u; cnt = 0u; mine = 0u;
#pragma unroll
        for (unsigned j = 0; j < 16; ++j) { const unsigned c = xb_ld(&bar[XB_XCNT(j)]); sum += c; cnt += (c > 0u) ? 1u : 0u; mine = (j == x) ? c : mine; }
        if (sum == G) break;
        __builtin_amdgcn_s_sleep(1);
        if ((++sp & 255u) == 0u) { if (xb_ld(&bar[XB_TMO])) break; if (sp > XB_SPIN_CAP) { atomicAdd(&bar[XB_TMO], 1u); break; } }
    }
    nloc = mine > 0u ? mine : 1u; nx = cnt > 0u ? cnt : 1u;
}

__device__ __forceinline__ void xcd_barrier(const XcdBarrier& b) {
    asm volatile("s_waitcnt vmcnt(0)" ::: "memory");
    __syncthreads();
    if (threadIdx.x == 0) {
        unsigned* bar = b.bar;
        __builtin_amdgcn_s_waitcnt(0);
        unsigned nloc = b.st[0], nx = b.st[1];
        if (nloc == 0u) { xcd_barrier_complete(bar, b.x, nloc, nx); b.st[0] = nloc; b.st[1] = nx; }
        const unsigned old = xb_add(&bar[XB_XSUB(b.x)], 1u);
        const unsigned gen = old / nloc;
        if (old + 1u == (gen + 1u) * nloc) {
            __builtin_amdgcn_fence(__ATOMIC_RELEASE, "agent");
            asm volatile("s_waitcnt vmcnt(0)" ::: "memory");
            const unsigned og = xb_add(&bar[XB_TOP], 1u);
            const unsigned tg = og / nx;
            if (og + 1u == (tg + 1u) * nx) xb_add(&bar[XB_TOPGEN], 1u);
            else XB_SPIN(xb_ld(&bar[XB_TOPGEN]) == tg, bar);
            __builtin_amdgcn_fence(__ATOMIC_ACQUIRE, "agent");
            xb_add(&bar[XB_XGEN(b.x)], 1u);
            asm volatile("s_waitcnt vmcnt(0)" ::: "memory");
        } else {
            XB_SPIN(xb_ld(&bar[XB_XGEN(b.x)]) == gen, bar);
            __builtin_amdgcn_fence(__ATOMIC_ACQUIRE, "agent");
            asm volatile("s_waitcnt vmcnt(0)" ::: "memory");
        }
    }
    __syncthreads();
}
#define HLP_PARTS 128u
#define HB_SPIN_CAP (1u << 18)

__device__ __forceinline__ unsigned hb_ld(unsigned* p)              { return __hip_atomic_load(p, __ATOMIC_RELAXED, __HIP_MEMORY_SCOPE_AGENT); }
__device__ __forceinline__ unsigned hb_add(unsigned* p, unsigned v) { return __hip_atomic_fetch_add(p, v, __ATOMIC_RELAXED, __HIP_MEMORY_SCOPE_AGENT); }
__device__ __forceinline__ unsigned hb_xcc_id() { return (unsigned)__builtin_amdgcn_s_getreg((3 << 11) | 20) & 0xFu; }
#define HB_SPIN(cond, bar) do { unsigned _sp = 0; while (cond) { __builtin_amdgcn_s_sleep(1); \
    if ((++_sp & 255u) == 0u) { if (hb_ld(&(bar)[XB_TMO])) break; if (_sp > HB_SPIN_CAP) { atomicAdd(&(bar)[XB_TMO], 1u); break; } } } } while (0)

struct HlpBarrier {
    unsigned* bar; unsigned x;
    volatile LAS unsigned* st;
};

__device__ __forceinline__ HlpBarrier hlp_barrier_post(unsigned* bar, volatile LAS unsigned* st) {
    HlpBarrier b; b.bar = bar; b.x = hb_xcc_id(); b.st = st;
    if (threadIdx.x == 0) (void)hb_add(&bar[XB_XCNT(b.x)], 1u);
    return b;
}
__device__ __forceinline__ void hlp_barrier_complete(unsigned* bar, unsigned x, unsigned& nloc, unsigned& nx) {
    const unsigned G = HLP_PARTS;
    unsigned sum, cnt, mine, sp = 0u;
    for (;;) {
        sum = 0u; cnt = 0u; mine = 0u;
#pragma unroll
        for (unsigned j = 0; j < 16; ++j) { const unsigned c = hb_ld(&bar[XB_XCNT(j)]); sum += c; cnt += (c > 0u) ? 1u : 0u; mine = (j == x) ? c : mine; }
        if (sum == G) break;
        __builtin_amdgcn_s_sleep(1);
        if ((++sp & 255u) == 0u) { if (hb_ld(&bar[XB_TMO])) break; if (sp > HB_SPIN_CAP) { atomicAdd(&bar[XB_TMO], 1u); break; } }
    }
    nloc = mine > 0u ? mine : 1u; nx = cnt > 0u ? cnt : 1u;
}

__device__ __forceinline__ void hlp_barrier(const HlpBarrier& b) {
    asm volatile("s_waitcnt vmcnt(0)" ::: "memory");
    __syncthreads();
    if (threadIdx.x == 0) {
        unsigned* bar = b.bar;
        __builtin_amdgcn_s_waitcnt(0);
        unsigned nloc = b.st[0], nx = b.st[1];
        if (nloc == 0u) { hlp_barrier_complete(bar, b.x, nloc, nx); b.st[0] = nloc; b.st[1] = nx; }
        const unsigned old = hb_add(&bar[XB_XSUB(b.x)], 1u);
        const unsigned gen = old / nloc;
        if (old + 1u == (gen + 1u) * nloc) {
            __builtin_amdgcn_fence(__ATOMIC_RELEASE, "agent");
            asm volatile("s_waitcnt vmcnt(0)" ::: "memory");
            const unsigned og = hb_add(&bar[XB_TOP], 1u);
            const unsigned tg = og / nx;
            if (og + 1u == (tg + 1u) * nx) hb_add(&bar[XB_TOPGEN], 1u);
            else HB_SPIN(hb_ld(&bar[XB_TOPGEN]) == tg, bar);
            __builtin_amdgcn_fence(__ATOMIC_ACQUIRE, "agent");
            hb_add(&bar[XB_XGEN(b.x)], 1u);
            asm volatile("s_waitcnt vmcnt(0)" ::: "memory");
        } else {
            HB_SPIN(hb_ld(&bar[XB_XGEN(b.x)]) == gen, bar);
            __builtin_amdgcn_fence(__ATOMIC_ACQUIRE, "agent");
            asm volatile("s_waitcnt vmcnt(0)" ::: "memory");
        }
    }
    __syncthreads();
}
struct SmallPre { f32x4 v[4]; };
__device__ __forceinline__ float row_rscale(const float* rss, int row) {
    const f32x4* p = (const f32x4*)(rss + (size_t)row * 16);
    const f32x4 a = p[0], b = p[1], c = p[2], d = p[3];
    const float s = (((a.x + a.y) + (a.z + a.w)) + ((b.x + b.y) + (b.z + b.w))) + (((c.x + c.y) + (c.z + c.w)) + ((d.x + d.y) + (d.z + d.w)));
    return rsqrtf(s * (1.0f / 1024.0f) + EPS);
}
__device__ __forceinline__ void rows_rscale8(const float* rss, int row0, int fq, float (&r)[2][4]) {
    f32x4 p[2][4];
#pragma unroll
    for (int ai = 0; ai < 2; ++ai)
#pragma unroll
        for (int m = 0; m < 4; ++m) p[ai][m] = *(const f32x4*)(rss + (size_t)(row0 + ai * 128 + m * 16) * 16 + 4 * fq);
#pragma unroll
    for (int ai = 0; ai < 2; ++ai)
#pragma unroll
        for (int m = 0; m < 4; ++m) {
            float s = (p[ai][m][0] + p[ai][m][1]) + (p[ai][m][2] + p[ai][m][3]);
            s += __shfl_xor(s, 16); s += __shfl_xor(s, 32);
            r[ai][m] = rsqrtf(s * (1.0f / 1024.0f) + EPS);
        }
}
struct ListOrder {
    int first, end, stride, nN;
    __device__ __forceinline__ bool next(int i, pg8::Unit& u) const { const int idx = first + i * stride; if (idx >= end) return false; u.pm = idx / nN; u.pn = idx % nN; return true; }
    __device__ __forceinline__ void a_ready(const pg8::Unit&) const {}
    __device__ __forceinline__ void done(const pg8::Unit&) const {}
};
template <int REPS> struct RepeatOrder {
    pg8::StaticOrder S;
    __device__ __forceinline__ bool next(int i, pg8::Unit& u) const { return S.next(i / REPS, u); }
    __device__ __forceinline__ void a_ready(const pg8::Unit&) const {}
    __device__ __forceinline__ void done(const pg8::Unit&) const {}
};
struct EpiScaleBf16 {
    static constexpr bool PERM = true, AFTER_DRAIN = false;
    bf16* O; int ldc; const float* rss; float mul; float* projg; int gate_pn; int nolo = 0;
    __device__ __forceinline__ void operator()(const f32x4 (&acc)[2][2][4][2], const pg8::Unit& u, int wr, int wc, int fr, int fq) const {
        const int row0 = u.pm * 256 + wr * 64 + fr, col0 = u.pn * 256 + wc * 32 + 8 * fq;
        const bool gates = (u.pn == gate_pn) && (wc == 0);
        float rr[2][4];
        if (nolo) {
#pragma unroll
            for (int a = 0; a < 2; ++a)
#pragma unroll
                for (int b = 0; b < 4; ++b) rr[a][b] = 1.f; }
        else rows_rscale8(rss, row0, fq, rr);
#pragma unroll
        for (int ai = 0; ai < 2; ++ai)
#pragma unroll
            for (int m = 0; m < 4; ++m) {
                const int row = row0 + ai * 128 + m * 16;
                const float r = rr[ai][m] * mul;
                bf16* rowp = O + (size_t)row * ldc + col0;
#pragma unroll
                for (int bj = 0; bj < 2; ++bj) {
                    const f32x4 v0 = acc[ai][bj][m][0] * r, v1 = acc[ai][bj][m][1] * r;
                    u32x4 w; w.x = pk2(v0[0], v0[1]); w.y = pk2(v0[2], v0[3]); w.z = pk2(v1[0], v1[1]); w.w = pk2(v1[2], v1[3]);
                    *(u32x4*)(rowp + bj * 128) = w;
                    if (bj == 1 && gates) { float* gp = projg + (size_t)row * 32 + 8 * fq; *(f32x4*)gp = v0; *(f32x4*)(gp + 4) = v1; }
                }
            }
    }
    __device__ __forceinline__ void sample16(const f32x4 (&accS)[2], const pg8::Unit& u, int wr, int wc, int fr, int fq, LAS unsigned char*, int) const {
        const int row = MP + 16 * u.pm + fr, col0 = u.pn * 256 + wr * 128 + wc * 32 + 8 * fq;
        const f32x4 p = *(const f32x4*)(rss + (size_t)row * 16 + 4 * fq);
        float s = (p[0] + p[1]) + (p[2] + p[3]);
        s += __shfl_xor(s, 16); s += __shfl_xor(s, 32);
        const float r = rsqrtf(s * (1.0f / 1024.0f) + EPS) * mul;
        const f32x4 v0 = accS[0] * r, v1 = accS[1] * r;
        u32x4 w; w.x = pk2(v0[0], v0[1]); w.y = pk2(v0[2], v0[3]); w.z = pk2(v1[0], v1[1]); w.w = pk2(v1[2], v1[3]);
        *(u32x4*)(O + (size_t)row * ldc + col0) = w;
    }
    __device__ __forceinline__ void small_load(SmallPre& pre, int row, int, int) const {
        const f32x4* p = (const f32x4*)(rss + (size_t)row * 16);
#pragma unroll
        for (int i = 0; i < 4; ++i) pre.v[i] = p[i];
    }
    __device__ __forceinline__ void small(const f32x4 (&acc)[4], const SmallPre& pre, int row, int n0, int l4) const {
        const f32x4 a = pre.v[0], b = pre.v[1], c = pre.v[2], d = pre.v[3];
        const float s = (((a.x + a.y) + (a.z + a.w)) + ((b.x + b.y) + (b.z + b.w))) + (((c.x + c.y) + (c.z + c.w)) + ((d.x + d.y) + (d.z + d.w)));
        const float r = rsqrtf(s * (1.0f / 1024.0f) + EPS) * mul;
#pragma unroll
        for (int t = 0; t < 4; ++t) { const f32x4 v = acc[t] * r; u32x2 w; w.x = pk2(v[0], v[1]); w.y = pk2(v[2], v[3]); *(u32x2*)(O + (size_t)row * ldc + n0 + 16 * t + 4 * l4) = w; }
    }
};
__device__ __forceinline__ f32x4 bf4_to_f32(const u32x2 w) { return (f32x4){__uint_as_float(w.x << 16), __uint_as_float(w.x & 0xffff0000u), __uint_as_float(w.y << 16), __uint_as_float(w.y & 0xffff0000u)}; }
struct EpiResid {
    static constexpr bool PERM = true, AFTER_DRAIN = false;
    bf16* xb; float* rss;
    __device__ __forceinline__ void operator()(const f32x4 (&acc)[2][2][4][2], const pg8::Unit& u, int wr, int wc, int fr, int fq) const {
        const int row0 = u.pm * 256 + wr * 64 + fr, col0 = u.pn * 256 + wc * 32 + 8 * fq;
#pragma unroll
        for (int ai = 0; ai < 2; ++ai) {
            u32x4 bv[4][2];
#pragma unroll
            for (int m = 0; m < 4; ++m) {
                const bf16* bp = xb + (size_t)(row0 + ai * 128 + m * 16) * DM + col0;
#pragma unroll
                for (int bj = 0; bj < 2; ++bj) bv[m][bj] = *(const u32x4*)(bp + bj * 128);
            }
            asm volatile("" ::: "memory");
#pragma unroll
            for (int m = 0; m < 4; ++m) {
                const int row = row0 + ai * 128 + m * 16;
                bf16* bbp = xb + (size_t)row * DM + col0;
                float ss = 0.f;
#pragma unroll
                for (int bj = 0; bj < 2; ++bj) {
                    u32x2 lo; lo.x = bv[m][bj].x; lo.y = bv[m][bj].y; u32x2 hi; hi.x = bv[m][bj].z; hi.y = bv[m][bj].w;
                    const f32x4 v0 = bf4_to_f32(lo) + acc[ai][bj][m][0], v1 = bf4_to_f32(hi) + acc[ai][bj][m][1];
                    u32x4 w; w.x = pk2(v0[0], v0[1]); w.y = pk2(v0[2], v0[3]); w.z = pk2(v1[0], v1[1]); w.w = pk2(v1[2], v1[3]);
                    *(u32x4*)(bbp + bj * 128) = w;
                    ss += ((v0[0] * v0[0] + v0[1] * v0[1]) + (v0[2] * v0[2] + v0[3] * v0[3])) + ((v1[0] * v1[0] + v1[1] * v1[1]) + (v1[2] * v1[2] + v1[3] * v1[3]));
                }
                ss += __shfl_xor(ss, 16); ss += __shfl_xor(ss, 32);
                if (fq == 0) rss[(size_t)row * 16 + u.pn * 4 + wc] = ss;
            }
            asm volatile("" ::: "memory");
        }
    }
    __device__ __forceinline__ void sample16(const f32x4 (&accS)[2], const pg8::Unit& u, int wr, int wc, int fr, int fq, LAS unsigned char* lds, int wid) const {
        const int row = MP + 16 * u.pm + fr, col0 = u.pn * 256 + wr * 128 + wc * 32 + 8 * fq;
        bf16* bbp = xb + (size_t)row * DM + col0;
        const u32x4 bw = *(const u32x4*)bbp;
        u32x2 lo; lo.x = bw.x; lo.y = bw.y; u32x2 hi; hi.x = bw.z; hi.y = bw.w;
        const f32x4 v0 = bf4_to_f32(lo) + accS[0], v1 = bf4_to_f32(hi) + accS[1];
        { u32x4 w; w.x = pk2(v0[0], v0[1]); w.y = pk2(v0[2], v0[3]); w.z = pk2(v1[0], v1[1]); w.w = pk2(v1[2], v1[3]); *(u32x4*)bbp = w; }
        float ss = ((v0[0] * v0[0] + v0[1] * v0[1]) + (v0[2] * v0[2] + v0[3] * v0[3])) + ((v1[0] * v1[0] + v1[1] * v1[1]) + (v1[2] * v1[2] + v1[3] * v1[3]));
        ss += __shfl_xor(ss, 16); ss += __shfl_xor(ss, 32);
        LAS float* sred = (LAS float*)lds;
        if (fq == 0) sred[wid * 16 + fr] = ss;
        __syncthreads();
        if (wr == 0 && fq == 0) rss[(size_t)row * 16 + u.pn * 4 + wc] = ss + sred[(4 + wc) * 16 + fr];
    }
    __device__ __forceinline__ void small_load(SmallPre& pre, int row, int n0, int l4) const {
        const bf16* bp = xb + (size_t)row * DM + n0 + 4 * l4;
#pragma unroll
        for (int t = 0; t < 4; ++t) pre.v[t] = bf4_to_f32(*(const u32x2*)(bp + 16 * t));
    }
    __device__ __forceinline__ void small(const f32x4 (&acc)[4], const SmallPre& pre, int row, int n0, int l4) const {
        float ss = 0.f;
#pragma unroll
        for (int t = 0; t < 4; ++t) {
            const f32x4 v = pre.v[t] + acc[t];
            u32x2 w; w.x = pk2(v[0], v[1]); w.y = pk2(v[2], v[3]); *(u32x2*)(xb + (size_t)row * DM + n0 + 16 * t + 4 * l4) = w;
            ss += (v[0] * v[0] + v[1] * v[1]) + (v[2] * v[2] + v[3] * v[3]);
        }
        ss += __shfl_xor(ss, 16); ss += __shfl_xor(ss, 32);
        if (l4 == 0) rss[(size_t)row * 16 + (n0 >> 6)] = ss;
    }
};
__device__ __forceinline__ void panel_meet(unsigned* cnt, const unsigned need, const bool same_l2 = false) {
    asm volatile("s_waitcnt vmcnt(0)" ::: "memory");
    __syncthreads();
    if (threadIdx.x == 0) {
        if (!same_l2) __builtin_amdgcn_fence(__ATOMIC_RELEASE, "agent");
        asm volatile("s_waitcnt vmcnt(0)" ::: "memory");
        (void)xb_add(cnt, 1u);
        unsigned sp = 0u;
        while (xb_ld(cnt) < need) { __builtin_amdgcn_s_sleep(1); if (++sp > (1u << 21)) break; }
        __builtin_amdgcn_fence(__ATOMIC_ACQUIRE, "agent");
        asm volatile("s_waitcnt vmcnt(0)" ::: "memory");
    }
    __syncthreads();
}
struct EpiResidFinal {
    static constexpr bool PERM = true, AFTER_DRAIN = true;
    const bf16* xb; float* rss; unsigned* cnt; const float* gfin; float* y; int same_l2 = 0;
    __device__ __forceinline__ void fused(f32x4 (&acc)[2][2][4][2], f32x4 (&accS)[2], const bool srows, const pg8::Unit& u, int wr, int wc, int fr, int fq, LAS unsigned char* lds, int wid, int) const {
        const int row0 = u.pm * 256 + wr * 64 + fr, col0 = u.pn * 256 + wc * 32 + 8 * fq;
        const int srow = MP + 16 * u.pm + fr, scol0 = u.pn * 256 + wr * 128 + wc * 32 + 8 * fq;
        if (srows) {
            const u32x4 bw = *(const u32x4*)(xb + (size_t)srow * DM + scol0);
            u32x2 lo; lo.x = bw.x; lo.y = bw.y; u32x2 hi; hi.x = bw.z; hi.y = bw.w;
            const f32x4 v0 = bf4_to_f32(lo) + accS[0], v1 = bf4_to_f32(hi) + accS[1];
            accS[0] = v0; accS[1] = v1;
            float ss = ((v0[0] * v0[0] + v0[1] * v0[1]) + (v0[2] * v0[2] + v0[3] * v0[3])) + ((v1[0] * v1[0] + v1[1] * v1[1]) + (v1[2] * v1[2] + v1[3] * v1[3]));
            ss += __shfl_xor(ss, 16); ss += __shfl_xor(ss, 32);
            LAS float* sred = (LAS float*)lds;
            if (fq == 0) sred[wid * 16 + fr] = ss;
            __syncthreads();
            if (wr == 0 && fq == 0) rss[(size_t)srow * 16 + u.pn * 4 + wc] = ss + sred[(4 + wc) * 16 + fr];
        }
#pragma unroll
        for (int ai = 0; ai < 2; ++ai) {
            u32x4 bv[4][2];
#pragma unroll
            for (int m = 0; m < 4; ++m) {
                const bf16* bp = xb + (size_t)(row0 + ai * 128 + m * 16) * DM + col0;
#pragma unroll
                for (int bj = 0; bj < 2; ++bj) bv[m][bj] = *(const u32x4*)(bp + bj * 128);
            }
            asm volatile("" ::: "memory");
#pragma unroll
            for (int m = 0; m < 4; ++m) {
                const int row = row0 + ai * 128 + m * 16;
                float ss = 0.f;
#pragma unroll
                for (int bj = 0; bj < 2; ++bj) {
                    u32x2 lo; lo.x = bv[m][bj].x; lo.y = bv[m][bj].y; u32x2 hi; hi.x = bv[m][bj].z; hi.y = bv[m][bj].w;
                    const f32x4 v0 = bf4_to_f32(lo) + acc[ai][bj][m][0], v1 = bf4_to_f32(hi) + acc[ai][bj][m][1];
                    acc[ai][bj][m][0] = v0; acc[ai][bj][m][1] = v1;
                    ss += ((v0[0] * v0[0] + v0[1] * v0[1]) + (v0[2] * v0[2] + v0[3] * v0[3])) + ((v1[0] * v1[0] + v1[1] * v1[1]) + (v1[2] * v1[2] + v1[3] * v1[3]));
                }
                ss += __shfl_xor(ss, 16); ss += __shfl_xor(ss, 32);
                if (fq == 0) rss[(size_t)row * 16 + u.pn * 4 + wc] = ss;
            }
            asm volatile("" ::: "memory");
        }
        panel_meet(cnt + 64 * u.pm, 4u, same_l2 != 0);
        float rr[2][4];
        rows_rscale8(rss, row0, fq, rr);
        f32x4 gg[2][2];
#pragma unroll
        for (int bj = 0; bj < 2; ++bj)
#pragma unroll
            for (int n = 0; n < 2; ++n) gg[bj][n] = *(const f32x4*)(gfin + col0 + bj * 128 + n * 4);
#pragma unroll
        for (int ai = 0; ai < 2; ++ai)
#pragma unroll
            for (int m = 0; m < 4; ++m) {
                float* yp = y + (size_t)(row0 + ai * 128 + m * 16) * DM + col0;
                const float r = rr[ai][m];
#pragma unroll
                for (int bj = 0; bj < 2; ++bj)
#pragma unroll
                    for (int n = 0; n < 2; ++n) *(f32x4*)(yp + bj * 128 + n * 4) = acc[ai][bj][m][n] * r * gg[bj][n];
            }
        if (srows) {
            const f32x4 p = *(const f32x4*)(rss + (size_t)srow * 16 + 4 * fq);
            float s = (p[0] + p[1]) + (p[2] + p[3]);
            s += __shfl_xor(s, 16); s += __shfl_xor(s, 32);
            const float r = rsqrtf(s * (1.0f / 1024.0f) + EPS);
            float* yp = y + (size_t)srow * DM + scol0;
            *(f32x4*)yp = accS[0] * r * *(const f32x4*)(gfin + scol0); *(f32x4*)(yp + 4) = accS[1] * r * *(const f32x4*)(gfin + scol0 + 4);
        }
    }
    __device__ __forceinline__ void small_load(SmallPre& pre, int row, int n0, int l4) const {
        const bf16* bp = xb + (size_t)row * DM + n0 + 4 * l4;
#pragma unroll
        for (int t = 0; t < 4; ++t) pre.v[t] = bf4_to_f32(*(const u32x2*)(bp + 16 * t));
    }
    __device__ __forceinline__ void small_pre(f32x4 (&acc)[4], const SmallPre& pre, int row, int n0, int l4) const {
        float ss = 0.f;
#pragma unroll
        for (int t = 0; t < 4; ++t) { const f32x4 v = pre.v[t] + acc[t]; acc[t] = v; ss += (v[0] * v[0] + v[1] * v[1]) + (v[2] * v[2] + v[3] * v[3]); }
        ss += __shfl_xor(ss, 16); ss += __shfl_xor(ss, 32);
        if (l4 == 0) rss[(size_t)row * 16 + (n0 >> 6)] = ss;
    }
    __device__ __forceinline__ void small_meet(int m0) const { panel_meet(cnt + 64 * (68 + ((m0 - MP) >> 6)), 16u); }
    __device__ __forceinline__ void small_post(const f32x4 (&acc)[4], int row, int n0, int l4) const {
        const float r = row_rscale(rss, row);
#pragma unroll
        for (int t = 0; t < 4; ++t) { const f32x4 gg = *(const f32x4*)(gfin + n0 + 16 * t + 4 * l4); *(f32x4*)(y + (size_t)row * DM + n0 + 16 * t + 4 * l4) = acc[t] * r * gg; }
    }
};
struct EpiGU {
    static constexpr bool PERM = true, AFTER_DRAIN = false;
    bf16* H; const float* rss; int nolo = 0;
    __device__ __forceinline__ void operator()(const f32x4 (&acc)[2][2][4][2], const pg8::Unit& u, int wr, int wc, int fr, int fq) const {
        const int row0 = u.pm * 256 + wr * 64 + fr, col0 = u.pn * 128 + wc * 32 + 8 * fq;
        float rr[2][4];
        if (nolo) {
#pragma unroll
            for (int a = 0; a < 2; ++a)
#pragma unroll
                for (int b = 0; b < 4; ++b) rr[a][b] = 1.f; }
        else rows_rscale8(rss, row0, fq, rr);
#pragma unroll
        for (int ai = 0; ai < 2; ++ai)
#pragma unroll
            for (int m = 0; m < 4; ++m) {
                const int row = row0 + ai * 128 + m * 16;
                const float r = rr[ai][m];
                float hv[8];
#pragma unroll
                for (int n = 0; n < 2; ++n)
#pragma unroll
                    for (int j = 0; j < 4; ++j) { const float g = acc[ai][0][m][n][j] * r, up = acc[ai][1][m][n][j] * r; hv[n * 4 + j] = g * __builtin_amdgcn_rcpf(1.f + __expf(-g)) * up; }
                u32x4 w; w.x = pk2(hv[0], hv[1]); w.y = pk2(hv[2], hv[3]); w.z = pk2(hv[4], hv[5]); w.w = pk2(hv[6], hv[7]);
                *(u32x4*)(H + (size_t)row * DFF + col0) = w;
            }
    }
};
struct EpiMemKV {
    static constexpr bool PERM = false, AFTER_DRAIN = false;
    float* outk; float* outv; bf16* memK; bf16* memVt; const float* rmem;
    __device__ __forceinline__ void operator()(const f32x4 (&acc)[2][2][4][2], const pg8::Unit& u, int wr, int wc, int fr, int fq) const {
        const int row0 = u.pm * 256 + wr * 64 + fr, col0 = u.pn * 256 + wc * 32 + 4 * fq;
#pragma unroll
        for (int ai = 0; ai < 2; ++ai)
#pragma unroll
            for (int m = 0; m < 4; ++m) {
                const int row = row0 + ai * 128 + m * 16;
                const float r = rmem[row];
#pragma unroll
                for (int bj = 0; bj < 2; ++bj)
#pragma unroll
                    for (int n = 0; n < 2; ++n) {
                        const int c = col0 + bj * 128 + n * 16;
                        const f32x4 v = acc[ai][bj][m][n] * r;
                        if (u.pn < 4) {
                            *(f32x4*)(outk + (size_t)row * 1024 + c) = v;
                            u32x2 w; w.x = pk2(v[0], v[1]); w.y = pk2(v[2], v[3]);
                            *(u32x2*)(memK + (size_t)row * 1024 + c) = w;
                        } else {
                            const int cc = c - 1024;
                            *(f32x4*)(outv + (size_t)row * 1024 + cc) = v;
                            const int b = row >> 8, mm = row & 255, hh = cc >> 8, d = cc & 255;
                            bf16* tp = memVt + (((size_t)b * 4 + hh) * 256 + d) * 256 + mm;
                            tp[0] = f2bf(v[0]); tp[256] = f2bf(v[1]); tp[512] = f2bf(v[2]); tp[768] = f2bf(v[3]);
                        }
                    }
            }
    }
};

template <class Epi>
__device__ __forceinline__ void small_gemm_tile(const bf16* __restrict__ A, const bf16* __restrict__ Bt, const int K, const int m0, const int n0, const Epi& E, LAS unsigned char* lds, const int dbg_mode = 0) {
    const int tid = opaque_tid(), lane = tid & 63, w = __builtin_amdgcn_readfirstlane(tid >> 6), l15 = lane & 15, l4 = lane >> 4;
    const int klen = K >> 3;
    const bf16* ap = A + (size_t)(m0 + l15) * K + w * klen + 8 * l4;
    const bf16* bp = Bt + (size_t)(n0 + l15) * K + w * klen + 8 * l4;
    const int erow = m0 + 16 * (w & 3) + l15;
    SmallPre pre;
#pragma unroll
    for (int i = 0; i < 4; ++i) pre.v[i] = (f32x4){0.f, 0.f, 0.f, 0.f};
    if (w < 4) E.small_load(pre, erow, n0, l4);
    f32x4 acc[4][4];
#pragma unroll
    for (int r = 0; r < 4; ++r)
#pragma unroll
        for (int t = 0; t < 4; ++t) acc[r][t] = (f32x4){0.f, 0.f, 0.f, 0.f};
    const int nsteps = klen >> 5;
    for (int s0 = 0; s0 < nsteps; s0 += 4) {
        bf16x8 ya[4][4], xb[4][4];
#pragma unroll
        for (int s = 0; s < 4; ++s) {
            const int k = (s0 + s < nsteps ? s0 + s : nsteps - 1) * 32;
#pragma unroll
            for (int r = 0; r < 4; ++r) ya[s][r] = *(const bf16x8*)(ap + (size_t)r * 16 * K + k);
#pragma unroll
            for (int t = 0; t < 4; ++t) xb[s][t] = *(const bf16x8*)(bp + (size_t)t * 16 * K + k);
        }
        __builtin_amdgcn_sched_barrier(0);
#pragma unroll
        for (int s = 0; s < 4; ++s) if (s0 + s < nsteps) {
#pragma unroll
            for (int r = 0; r < 4; ++r)
#pragma unroll
                for (int t = 0; t < 4; ++t) acc[r][t] = mma16(xb[s][t], ya[s][r], acc[r][t]);
        }
    }
    LAS f32x4* red = (LAS f32x4*)lds;
#if DBG_SMALL_MODE
    if (dbg_mode == 1) { red[tid] = acc[0][0] + acc[1][1] + acc[2][2] + acc[3][3] + pre.v[0]; __syncthreads(); return; }
#endif
#pragma unroll
    for (int r = 0; r < 4; ++r)
#pragma unroll
        for (int t = 0; t < 4; ++t) red[((w * 4 + r) * 4 + t) * 64 + lane] = acc[r][t];
    __syncthreads();
    f32x4 o[4];
    if (w < 4) {
#pragma unroll
        for (int t = 0; t < 4; ++t) {
            f32x4 a = red[((0 * 4 + w) * 4 + t) * 64 + lane] + red[((1 * 4 + w) * 4 + t) * 64 + lane];
            f32x4 b = red[((2 * 4 + w) * 4 + t) * 64 + lane] + red[((3 * 4 + w) * 4 + t) * 64 + lane];
            f32x4 c = red[((4 * 4 + w) * 4 + t) * 64 + lane] + red[((5 * 4 + w) * 4 + t) * 64 + lane];
            f32x4 d = red[((6 * 4 + w) * 4 + t) * 64 + lane] + red[((7 * 4 + w) * 4 + t) * 64 + lane];
            o[t] = (a + b) + (c + d);
        }
    }
    if constexpr (Epi::AFTER_DRAIN) {
        if (w < 4) E.small_pre(o, pre, erow, n0, l4);
        E.small_meet(m0);
        if (w < 4) E.small_post(o, erow, n0, l4);
    } else {
        if (w < 4) E.small(o, pre, erow, n0, l4);
    }
    __syncthreads();
}
struct TItem { const float* W; const float* gain; bf16* WT; int ldw, k0, src0, ncols, K, dst0; };
__device__ __forceinline__ TItem decode_item(PP P, unsigned char* ws, const int it) {
    constexpr int IT_IN = 118 * 16, IT_SQ = 32 * 16, IT_FF = 88 * 16;
    constexpr int IT_LAYER = IT_IN + 5 * IT_SQ + 3 * IT_FF;
    TItem t; t.gain = nullptr; t.ncols = 32;
    const int l = it / IT_LAYER; int r = it % IT_LAYER;
    if (r < IT_IN) {
        const int kb = r / 118, g = r % 118;
        if (g < 84) { t.src0 = 32 * g; t.dst0 = 32 * g; }
        else if (g < 116) { t.src0 = 2704 + 32 * (g - 84); t.dst0 = 2688 + 32 * (g - 84); }
        else if (g == 116) { t.src0 = 2688; t.dst0 = 3712; t.ncols = 16; }
        else { t.src0 = 3728; t.dst0 = 3728; t.ncols = 8; }
        t.W = P->in[I_WIN] + (size_t)l * DM * 3736; t.ldw = 3736; t.gain = P->in[I_GMIX] + l * DM; t.k0 = kb * 64; t.WT = (bf16*)(ws + WS_WIN) + (size_t)l * NPROJ * DM; t.K = DM;
        return t;
    }
    r -= IT_IN;
    if (r < 5 * IT_SQ) {
        const int which = r / IT_SQ, rr = r % IT_SQ, kb = rr / 32, g = rr % 32;
        t.dst0 = 32 * g; t.src0 = 32 * g; t.ldw = DM; t.k0 = kb * 64; t.K = DM;
        if (which == 0) { t.W = P->in[I_WOUT]; t.WT = (bf16*)(ws + WS_WOUT) + (size_t)l * DM * DM; }
        else if (which == 1) { t.W = P->in[I_WXQ]; t.gain = P->in[I_GXATTN] + l * DM; t.WT = (bf16*)(ws + WS_WXQ) + (size_t)l * DM * DM; }
        else if (which == 2) { t.W = P->in[I_WXO]; t.WT = (bf16*)(ws + WS_WXO) + (size_t)l * DM * DM; }
        else if (which == 3) { t.W = P->in[I_WXK]; t.gain = P->in[I_GMEM] + l * DM; t.WT = (bf16*)(ws + WS_WXKV) + (size_t)l * 2048 * DM; }
        else { t.W = P->in[I_WXV]; t.gain = P->in[I_GMEM] + l * DM; t.WT = (bf16*)(ws + WS_WXKV) + (size_t)l * 2048 * DM; t.dst0 += 1024; }
        t.W += (size_t)l * DM * DM;
        return t;
    }
    r -= 5 * IT_SQ;
    if (r < 2 * IT_FF) {
        const int which = r / IT_FF, rr = r % IT_FF, kb = rr / 88, g = rr % 88;
        t.src0 = 32 * g; t.dst0 = (t.src0 >> 7) * 256 + (t.src0 & 127) + which * 128;
        t.W = P->in[which ? I_WUP : I_WGATE] + (size_t)l * DM * DFF; t.ldw = DFF; t.gain = P->in[I_GFFN] + l * DM; t.k0 = kb * 64; t.WT = (bf16*)(ws + WS_WGU) + (size_t)l * NGU * DM; t.K = DM;
        return t;
    }
    r -= 2 * IT_FF;
    { const int kb = r / 32, g = r % 32;
      t.W = P->in[I_WDOWN] + (size_t)l * DFF * DM; t.ldw = DM; t.k0 = kb * 64; t.src0 = 32 * g; t.dst0 = 32 * g; t.WT = (bf16*)(ws + WS_WDN) + (size_t)l * DM * DFF; t.K = DFF; }
    return t;
}
__device__ __forceinline__ void item_load(const TItem& t, const int lane, f32x4 (&v)[8], float (&g)[8]) {
    const int c4 = 4 * (lane & 7), rr = lane >> 3;
#pragma unroll
    for (int i = 0; i < 8; ++i) {
        const int kk = rr + 8 * i;
        if (c4 < t.ncols) v[i] = *(const f32x4*)(t.W + (size_t)(t.k0 + kk) * t.ldw + t.src0 + c4); else v[i] = (f32x4){0.f, 0.f, 0.f, 0.f};
        g[i] = t.gain ? t.gain[t.k0 + kk] : 1.0f;
    }
}
__device__ __forceinline__ void item_finish(const TItem& t, const int lane, const f32x4 (&v)[8], const float (&g)[8], LAS float* scr) {
    const int c4 = 4 * (lane & 7), rr = lane >> 3;
#pragma unroll
    for (int i = 0; i < 8; ++i) {
        const int kk = rr + 8 * i;
        const f32x4 x = v[i] * g[i];
        scr[kk * 33 + c4] = x[0]; scr[kk * 33 + c4 + 1] = x[1]; scr[kk * 33 + c4 + 2] = x[2]; scr[kk * 33 + c4 + 3] = x[3];
    }
    asm volatile("s_waitcnt lgkmcnt(0)" ::: "memory");
    const int c8 = lane & 7;
#pragma unroll
    for (int j = 0; j < 4; ++j) {
        const int n = (lane >> 3) + 8 * j;
        const LAS float* s = scr + (8 * c8) * 33 + n;
        u32x4 o; o.x = pk2(s[0 * 33], s[1 * 33]); o.y = pk2(s[2 * 33], s[3 * 33]); o.z = pk2(s[4 * 33], s[5 * 33]); o.w = pk2(s[6 * 33], s[7 * 33]);
        if (n < t.ncols) *(u32x4*)(t.WT + (size_t)(t.dst0 + n) * t.K + t.k0 + 8 * c8) = o;
    }
    asm volatile("s_waitcnt lgkmcnt(0)" ::: "memory");
}
#ifndef DEFER_ON
#define DEFER_ON 1
#endif
constexpr int ITM_IN = 118 * 16, ITM_SQ = 32 * 16, ITM_FF = 88 * 16, ITM_LAYER = ITM_IN + 5 * ITM_SQ + 3 * ITM_FF, ITM_EARLY = ITM_IN + 2 * ITM_SQ, ITM_REST = ITM_LAYER - ITM_EARLY;
__device__ __forceinline__ int item_early(int l, int j) { return l * ITM_LAYER + (j < ITM_IN ? j : 3 * ITM_SQ + j); }
__device__ __forceinline__ int item_rest(int l, int j) { return l * ITM_LAYER + ITM_IN + (j < 3 * ITM_SQ ? j : 2 * ITM_SQ + j); }
#ifndef DEFER_SPLIT
#define DEFER_SPLIT 0
#endif
#ifndef DEFER_L1
#define DEFER_L1 1
#endif
__device__ __forceinline__ int item_map(int set, int j) { return set == 0 ? (j < ITM_EARLY ? item_early(0, j) : item_rest(1, j - ITM_EARLY)) : set == 1 ? (j < ITM_REST ? item_rest(0, j) : item_early(1, j - ITM_REST)) : item_rest(1, j); }
static_assert(ITM_REST % 4 == 0 && (ITM_REST + ITM_EARLY) % 4 == 0, "per-wave groups of 4 items");
__device__ __forceinline__ float wave_total(float v, int lane) { return __shfl(scan_sum(v, lane), 63); }

__device__ __forceinline__ void phase_prep(PP P, LAS unsigned char* lds) {
    const int tid = opaque_tid(), lane = tid & 63, wave = __builtin_amdgcn_readfirstlane(tid >> 6);
    const int gw = blockIdx.x * 8 + wave, NGW = gridDim.x * 8;
    unsigned char* ws = P->ws;
    LAS float* scrA = (LAS float*)(lds + wave * 17408); LAS float* scrB = scrA + 64 * 33;
    const bool defer = gridDim.x == 256 && DEFER_ON;
    const int N_ITEMS = defer ? (DEFER_L1 ? ITM_EARLY : ITM_EARLY + ITM_REST) : 2 * ITM_LAYER;
    for (int it = gw; it < N_ITEMS; it += 2 * NGW) {
        const bool hasB = it + NGW < N_ITEMS;
        const TItem A = decode_item(P, ws, defer ? item_map(0, it) : it), B = decode_item(P, ws, defer ? item_map(0, hasB ? it + NGW : it) : (hasB ? it + NGW : it));
        f32x4 va[8], vb[8]; float ga[8], gb[8];
        item_load(A, lane, va, ga); item_load(B, lane, vb, gb);
        item_finish(A, lane, va, ga, scrA);
        if (hasB) item_finish(B, lane, vb, gb, scrB);
    }
    {
        const int gt = blockIdx.x * NTHREADS + tid, NGT = gridDim.x * NTHREADS;
        constexpr int PER = 104 * DM * 2 / 16;
        for (int i = gt; i < 2 * PER; i += NGT) {
            const int l = i / PER, j = i % PER;
            u32x4 z; z.x = 0; z.y = 0; z.z = 0; z.w = 0;
            *(u32x4*)(ws + WS_WIN + ((size_t)l * NPROJ + 3736) * DM * 2 + (size_t)j * 16) = z;
        }
        float* rc = (float*)(ws + WS_ROPE); float* rs = rc + 2056 * 32;
        for (int i = gt; i < 2056 * 32; i += NGT) {
            const int pi = i >> 5, k = i & 31;
            const float pos = (float)(pi < 2048 ? pi : 16384 + (pi - 2048));
            const float inv = powf(10000.0f, -(float)k * 2.0f / 64.0f);
            const float ang = pos * inv;
            rc[i] = (float)cos((double)ang); rs[i] = (float)sin((double)ang);
        }
    }
    bf16* xb = (bf16*)(ws + WS_XB); float* rss = (float*)(ws + WS_RSS);
    bf16* memb = (bf16*)(ws + WS_MEMB); float* rmem = (float*)(ws + WS_RMEM);
    for (int row0 = gw * 4; row0 < MT + 2048; row0 += NGW * 4) {
        f32x4 v[4][4];
#pragma unroll
        for (int r = 0; r < 4; ++r) {
            const int row = row0 + r;
            const float* src = (row < MP) ? P->in[I_XP] + (size_t)row * DM : (row < MT) ? P->in[I_XS] + (size_t)(row - MP) * DM : P->in[I_MEMP] + (size_t)(row - MT) * DM;
#pragma unroll
            for (int j = 0; j < 4; ++j) v[r][j] = *(const f32x4*)(src + (lane + 64 * j) * 4);
        }
#pragma unroll
        for (int r = 0; r < 4; ++r) {
            const int row = row0 + r;
            bf16* dst = (row < MT) ? xb + (size_t)row * DM : memb + (size_t)(row - MT) * DM;
            float ss = 0.f;
#pragma unroll
            for (int j = 0; j < 4; ++j) {
                const f32x4 x = v[r][j];
                ss += (x[0] * x[0] + x[1] * x[1]) + (x[2] * x[2] + x[3] * x[3]);
                u32x2 w; w.x = pk2(x[0], x[1]); w.y = pk2(x[2], x[3]);
                *(u32x2*)(dst + (lane + 64 * j) * 4) = w;
            }
            ss = wave_total(ss, lane);
            if (row < MT) { if (lane < 16) rss[(size_t)row * 16 + lane] = (lane == 0) ? ss : 0.f; }
            else if (lane == 0) rmem[row - MT] = rsqrtf(ss * (1.0f / 1024.0f) + EPS);
        }
    }
}

__device__ __forceinline__ void deferred_items(PP P, const int l, LAS unsigned char* lds, const int pass = 0, const int half = 0) {
    const int tid = opaque_tid(), lane = tid & 63, wave = __builtin_amdgcn_readfirstlane(tid >> 6);
    unsigned char* ws = P->ws;
    unsigned* ctr = (unsigned*)(ws + WS_CTL) + 24576 + 64 * l + 128 * pass + 16 * half;
    LAS float* scrA = (LAS float*)(lds + wave * 17408); LAS float* scrB = scrA + 64 * 33;
    volatile LAS int* tkt = (volatile LAS int*)(lds + LDS_BYTES - 64) + 12;
    const int nall = l == 0 ? ITM_REST + ITM_EARLY : ITM_REST, set = 1 + l;
    const int nfirst = DEFER_SPLIT ? (((nall / 2) + 63) & ~63) : 0, base = half ? nfirst : 0, n = half ? nall - nfirst : nfirst;
    int nt = 0;
    constexpr int TK = 32, PW = TK / 8;
    if (tid == 0) { nt = (int)__hip_atomic_fetch_add(ctr, (unsigned)TK, __ATOMIC_RELAXED, __HIP_MEMORY_SCOPE_AGENT); tkt[0] = nt; }
    __syncthreads();
    int j = tkt[0];
    while (j < n) {
        if (tid == 0) nt = (int)__hip_atomic_fetch_add(ctr, (unsigned)TK, __ATOMIC_RELAXED, __HIP_MEMORY_SCOPE_AGENT);
        const int j0 = base + j + PW * wave;
        if (j + PW * wave < n) {
#pragma unroll 1
            for (int i = 0; i < PW; i += 2) {
                const TItem A = decode_item(P, ws, item_map(set, j0 + i)), B = decode_item(P, ws, item_map(set, j0 + i + 1));
                f32x4 va[8], vb[8]; float ga[8], gb[8];
                item_load(A, lane, va, ga); item_load(B, lane, vb, gb);
                item_finish(A, lane, va, ga, scrA);
                item_finish(B, lane, vb, gb, scrB);
            }
        }
        __syncthreads();
        if (tid == 0) tkt[0] = nt;
        __syncthreads();
        j = tkt[0];
    }
}

__device__ __forceinline__ void phase_final(PP P) {
    const int tid = opaque_tid(), lane = tid & 63, wave = tid >> 6;
    const int gw = blockIdx.x * 8 + wave, NGW = gridDim.x * 8;
    const bf16* xb = (const bf16*)(P->ws + WS_XB); const float* rss = (const float*)(P->ws + WS_RSS); const float* g = P->in[I_GFINAL];
    for (int row = gw; row < MT; row += NGW) {
        const float r = row_rscale(rss, row);
#pragma unroll
        for (int j = 0; j < 4; ++j) {
            const int c = (lane + 64 * j) * 4;
            const u32x2 xw = *(const u32x2*)(xb + (size_t)row * DM + c);
            const f32x4 v = (f32x4){__uint_as_float(xw.x << 16), __uint_as_float(xw.x & 0xffff0000u), __uint_as_float(xw.y << 16), __uint_as_float(xw.y & 0xffff0000u)}, gg = *(const f32x4*)(g + c);
            *(f32x4*)(P->out + O_YP + (size_t)row * DM + c) = v * r * gg;
        }
    }
}
#ifndef DBG_CHAIN
#define DBG_CHAIN 0
#endif
constexpr int CH_LDQ = 72, CH_LDT = 136;
constexpr int CH_OFF_Q = 0, CH_OFF_K = 18432, CH_OFF_KT = 36864, CH_OFF_VT = 54272, CH_OFF_P = 76032, CH_OFF_S = 110848, CH_OFF_B = 122368, CH_END = 140800;
static_assert(CH_END + 256 + 2304 <= LDS_BYTES - 64, "chain lds");
constexpr int CH_BS = 36;

__device__ __forceinline__ float fast_log_sigmoid(float x) { return fminf(x, 0.f) - __logf(1.0f + __expf(-fabsf(x))); }
__device__ __forceinline__ float fast_sigmoid(float x) { return __builtin_amdgcn_rcpf(1.0f + __expf(-x)); }
__device__ __forceinline__ float fast_silu(float x) { return x * __builtin_amdgcn_rcpf(1.0f + __expf(-x)); }

__device__ __forceinline__ void store_T2x8(LAS unsigned char* XT, const int ch0, const int t0, const float (&a)[8], const float (&b)[8]) {
#pragma unroll
    for (int e = 0; e < 8; ++e) *(LAS unsigned*)(XT + ((size_t)(ch0 + e) * CH_LDT + t0) * 2) = pk2(a[e], b[e]);
}
__device__ __forceinline__ void unpack8(const bf16x8 a, float (&x)[8]) {
#pragma unroll
    for (int e = 0; e < 8; ++e) x[e] = bf2f((unsigned short)a[e]);
}
__device__ __forceinline__ u32x4 pack8(const float (&x)[8]) { u32x4 w; w.x = pk2(x[0], x[1]); w.y = pk2(x[2], x[3]); w.z = pk2(x[4], x[5]); w.w = pk2(x[6], x[7]); return w; }

__device__ __forceinline__ void pm_mlstm_gates(PP P, const int layer, const int b, const int h, LAS unsigned char* lds) {
    const int tid = opaque_tid(), lane = tid & 63, w = __builtin_amdgcn_readfirstlane(tid >> 6);
    const float* projg = (const float*)(P->ws + WS_PROJG);
    float* GM = (float*)(P->ws + WS_GM); float* CM = (float*)(P->ws + WS_CM);
    LAS float* lF = (LAS float*)lds; LAS float* lG = lF + 2048; LAS float* lP = lG + 2048; LAS float* lc = lP + 2048;
    const float bfv = P->in[I_BF][layer * 4 + h], biv = P->in[I_BI][layer * 4 + h];
#pragma unroll
    for (int cc = 0; cc < 2; ++cc) {
        const int c = 2 * w + cc, t0 = c * 128;
        const float* g0 = projg + (size_t)(b * SEQ + t0 + lane) * 32; const float* g1 = g0 + 64 * 32;
        const float lf0 = log_sigmoid(g0[20 + h] + bfv), li0 = g0[16 + h] + biv;
        const float lf1 = log_sigmoid(g1[20 + h] + bfv), li1 = g1[16 + h] + biv;
        const float F0 = scan_sum(lf0, lane); const float F1 = scan_sum(lf1, lane) + __shfl(F0, 63);
        const float gg0 = li0 - F0, gg1 = li1 - F1;
        const float pm0 = scan_max(gg0, lane); const float pm1 = fmaxf(scan_max(gg1, lane), __shfl(pm0, 63));
        lF[t0 + lane] = F0; lF[t0 + 64 + lane] = F1; lG[t0 + lane] = gg0; lG[t0 + 64 + lane] = gg1; lP[t0 + lane] = pm0; lP[t0 + 64 + lane] = pm1;
        if (lane == 63) { lc[c] = F1; lc[16 + c] = pm1; }
    }
    __syncthreads();
    if (tid == 0) {
        float m = 0.f;
        for (int c = 0; c < 16; ++c) { const float uL = fmaxf(m, lc[16 + c]); lc[32 + c] = m; lc[48 + c] = uL; m = lc[c] + uL; }
    }
    __syncthreads();
    for (int t = tid; t < 2048; t += NTHREADS) {
        const int c = t >> 7;
        const float u = fmaxf(lc[32 + c], lP[t]);
        *(f32x4*)(GM + ((size_t)(b * 4 + h) * SEQ + t) * 4) = (f32x4){lF[t], lG[t], u, 0.f};
    }
    if (tid < 16) *(f32x4*)(CM + ((size_t)(b * 4 + h) * 16 + tid) * 4) = (f32x4){lc[tid], lc[48 + tid], lc[32 + tid], 0.f};
}
struct ConvPre { bf16x8 u[7]; f32x4 w0[2], w1[2], w2[2], w3[2], bb[2]; };
__device__ __forceinline__ void pm_conv_load(PP P, const int layer, const int b, const int c, const int h, ConvPre& pre) {
    const int tid = opaque_tid();
    const bf16* proj = (const bf16*)(P->ws + WS_PROJ);
    const int which = tid >> 8, cp = tid & 7, rg = (tid >> 3) & 31, chan0 = which * 256 + h * 64 + 8 * cp;
#pragma unroll
    for (int r = 0; r < 7; ++r) { const int tok = c * 128 + 4 * rg - 3 + r;
        if (tok >= 0) pre.u[r] = *(const bf16x8*)((const char*)proj + ((unsigned)(b * SEQ + tok) * NPROJ + C_QKM + chan0) * 2u); else pre.u[r] = (bf16x8){0, 0, 0, 0, 0, 0, 0, 0}; }
    const float* cwp = P->in[I_CONVW] + (size_t)layer * 4 * 512 + chan0; const float* cbp = P->in[I_CONVB] + layer * 512 + chan0;
#pragma unroll
    for (int e4 = 0; e4 < 2; ++e4) { pre.w0[e4] = *(const f32x4*)(cwp + 4 * e4); pre.w1[e4] = *(const f32x4*)(cwp + 512 + 4 * e4); pre.w2[e4] = *(const f32x4*)(cwp + 1024 + 4 * e4);
        pre.w3[e4] = *(const f32x4*)(cwp + 1536 + 4 * e4); pre.bb[e4] = *(const f32x4*)(cbp + 4 * e4); }
}
__device__ __forceinline__ void pm_conv_compute(PP P, const int b, const int c, const int h, const ConvPre& pre) {
    const int tid = opaque_tid();
    bf16* QKC = (bf16*)(P->ws + WS_QKC);
    const int which = tid >> 8, cp = tid & 7, rg = (tid >> 3) & 31, chan0 = which * 256 + h * 64 + 8 * cp;
    float y[4][8];
#pragma unroll
    for (int e4 = 0; e4 < 2; ++e4) {
        const f32x4 w0 = pre.w0[e4], w1 = pre.w1[e4], w2 = pre.w2[e4], w3 = pre.w3[e4], bb = pre.bb[e4];
#pragma unroll
        for (int e1 = 0; e1 < 4; ++e1) {
            const int e = 4 * e4 + e1;
#pragma unroll
            for (int tt = 0; tt < 4; ++tt) {
                const float a = bb[e1] + w0[e1] * bf2f((unsigned short)pre.u[tt][e]) + w1[e1] * bf2f((unsigned short)pre.u[tt + 1][e]) + w2[e1] * bf2f((unsigned short)pre.u[tt + 2][e]) + w3[e1] * bf2f((unsigned short)pre.u[tt + 3][e]);
                y[tt][e] = fast_silu(a) * (which ? 0.125f : 1.0f);
            }
        }
    }
#pragma unroll
    for (int tt = 0; tt < 4; ++tt) *(u32x4*)((char*)QKC + ((unsigned)(b * SEQ + c * 128 + 4 * rg + tt) * 512 + chan0) * 2u) = pack8(y[tt]);
}
__device__ __forceinline__ void pm_mlstm_conv(PP P, const int layer, const int b, const int c, const int h) { ConvPre pre; pm_conv_load(P, layer, b, c, h, pre); pm_conv_compute(P, b, c, h, pre); }
#define PM_GLA_DECL(S) f32x4 S##a0, S##a1, S##a2, S##a3, S##b0, S##b1, S##b2, S##b3; bf16x8 S##x0, S##x1; float S##wg, S##bg
#define PM_GLA_LOAD(S, b_, c_, h_) do { const int tid_ = opaque_tid(), lane_ = tid_ & 63; const int bb_ = (b_), cc_ = (c_), hh_ = (h_); \
    const bf16* proj_ = (const bf16*)(P->ws + WS_PROJ); const float* projg_ = (const float*)(P->ws + WS_PROJG); \
    S##wg = P->in[I_WGA2][(size_t)layer * 16 * 192 + (tid_ & 15) * 192 + hh_ * 32 + (tid_ >> 4)]; S##bg = P->in[I_BGA][layer * 192 + hh_ * 32 + (tid_ & 31)]; \
    const int row0_ = bb_ * SEQ + cc_ * 128; \
    { const f32x4* ap_ = (const f32x4*)(projg_ + (size_t)(row0_ + lane_) * 32); S##a0 = ap_[0]; S##a1 = ap_[1]; S##a2 = ap_[2]; S##a3 = ap_[3]; } \
    { const f32x4* ap_ = (const f32x4*)(projg_ + (size_t)(row0_ + 64 + lane_) * 32); S##b0 = ap_[0]; S##b1 = ap_[1]; S##b2 = ap_[2]; S##b3 = ap_[3]; } \
    const int isq_ = tid_ >> 8, tp_ = (tid_ >> 2) & 63, p_ = tid_ & 3; \
    const unsigned ro_ = ((unsigned)(row0_ + 2 * tp_) * NPROJ + (isq_ ? C_QG : C_KG) + hh_ * 32 + 8 * p_) * 2u; \
    S##x0 = *(const bf16x8*)((const char*)proj_ + ro_); S##x1 = *(const bf16x8*)((const char*)proj_ + ro_ + NPROJ * 2u); } while (0)
#define PM_GLA_VALS(S) S##a0, S##a1, S##a2, S##a3, S##b0, S##b1, S##b2, S##b3, S##x0, S##x1, S##wg, S##bg
__device__ __forceinline__ void pm_gla_compute(PP P, const int b, const int c, const int h, const f32x4 qa0, const f32x4 qa1, const f32x4 qa2, const f32x4 qa3, const f32x4 qb0, const f32x4 qb1, const f32x4 qb2, const f32x4 qb3,
                                               const bf16x8 x0, const bf16x8 x1, const float pwg, const float pbg, LAS unsigned char* lds) {
    const int tid = opaque_tid(), lane = tid & 63, w = __builtin_amdgcn_readfirstlane(tid >> 6);
    LAS float* Bs = (LAS float*)lds;
    LAS float* wgl = Bs + 128 * CH_BS;
    wgl[tid] = pwg; if (tid < 32) wgl[512 + tid] = pbg;
    const int row0 = b * SEQ + c * 128;
    const int isq = tid >> 8, tp = (tid >> 2) & 63, p = tid & 3;
    f32x4 pa[2][4];
    pa[0][0] = qa0; pa[0][1] = qa1; pa[0][2] = qa2; pa[0][3] = qa3; pa[1][0] = qb0; pa[1][1] = qb1; pa[1][2] = qb2; pa[1][3] = qb3;
    __syncthreads();
    {
        float carry[4];
#pragma unroll
        for (int hh = 0; hh < 2; ++hh) {
            const int t = hh * 64 + lane;
            const float ag[16] = {pa[hh][0][0], pa[hh][0][1], pa[hh][0][2], pa[hh][0][3], pa[hh][1][0], pa[hh][1][1], pa[hh][1][2], pa[hh][1][3],
                                  pa[hh][2][0], pa[hh][2][1], pa[hh][2][2], pa[hh][2][3], pa[hh][3][0], pa[hh][3][1], pa[hh][3][2], pa[hh][3][3]};
#pragma unroll
            for (int cc = 0; cc < 4; ++cc) {
                const int ch = 4 * w + cc;
                float x = wgl[512 + ch];
#pragma unroll
                for (int r4 = 0; r4 < 4; ++r4) { const f32x4 wv = *(const LAS f32x4*)(wgl + ch * 16 + 4 * r4);
                    x += ag[4 * r4] * wv[0] + ag[4 * r4 + 1] * wv[1] + ag[4 * r4 + 2] * wv[2] + ag[4 * r4 + 3] * wv[3]; }
                float v = scan_sum(fast_log_sigmoid(x) * (1.0f / 16.0f), lane);
                if (hh == 0) carry[cc] = __shfl(v, 63); else v += carry[cc];
                Bs[t * CH_BS + ch] = v;
            }
        }
    }
    __syncthreads();
    {
        bf16* dq = (bf16*)(P->ws + (isq ? WS_GQ : WS_GK)); bf16* dkt = (bf16*)(P->ws + WS_GKT);
        const f32x4 l0 = *(const LAS f32x4*)(Bs + 127 * CH_BS + 8 * p), l1 = *(const LAS f32x4*)(Bs + 127 * CH_BS + 8 * p + 4);
        const float blv[8] = {l0[0], l0[1], l0[2], l0[3], l1[0], l1[1], l1[2], l1[3]};
#pragma unroll
        for (int tk = 0; tk < 2; ++tk) {
            const int t = 2 * tp + tk;
            float x[8], xo[8], kt[8]; unpack8(tk ? x1 : x0, x);
            const f32x4 b0 = *(const LAS f32x4*)(Bs + t * CH_BS + 8 * p), b1 = *(const LAS f32x4*)(Bs + t * CH_BS + 8 * p + 4);
            const float btv[8] = {b0[0], b0[1], b0[2], b0[3], b1[0], b1[1], b1[2], b1[3]};
#pragma unroll
            for (int e = 0; e < 8; ++e) {
                if (isq) { xo[e] = x[e] * 0.17677669529663687f * __expf(btv[e]); kt[e] = 0.f; }
                else { xo[e] = x[e] * __expf(-btv[e]); kt[e] = x[e] * __expf(blv[e] - btv[e]); }
            }
            const unsigned oo = ((unsigned)(row0 + t) * 192 + h * 32 + 8 * p) * 2u;
            *(u32x4*)((char*)dq + oo) = pack8(xo);
            if (!isq) *(u32x4*)((char*)dkt + oo) = pack8(kt);
        }
        if (tid < 32) ((float*)(P->ws + WS_GBL))[((size_t)(b * 6 + h) * 16 + c) * 32 + tid] = Bs[127 * CH_BS + tid];
    }
}
#ifndef DBG_PM_MASK
#define DBG_PM_MASK 7
#endif
__device__ __forceinline__ void phase_premix(PP P, const int layer, LAS unsigned char* lds, const int pmask = 7) {
    const int G = gridDim.x;
    int task = blockIdx.x;
    if (task < 32) { if (pmask & 1) pm_mlstm_gates(P, layer, task >> 2, task & 3, lds); task += G; }
#define PM_GLA_ARGS(tk_) ((tk_) - 32) / 96, ((((tk_) - 32) / 6) & 15), ((tk_) - 32) % 6
#define PM_CONV_ARGS(tk_) ((tk_) - 800) >> 6, ((((tk_) - 800) >> 2) & 15), ((tk_) - 800) & 3
    if (G == 256) {
        const int t0 = task, t1 = task + 256, t2 = task + 512, t3 = task + 768, t4 = task + 1024;
        PM_GLA_DECL(A); PM_GLA_DECL(B);
        ConvPre C, D;
        if (pmask & 4) { pm_conv_load(P, layer, PM_CONV_ARGS(t3), C); pm_conv_load(P, layer, PM_CONV_ARGS(t4), D); }
        if (pmask & 2) {
        PM_GLA_LOAD(A, (t0 - 32) / 96, ((t0 - 32) / 6) & 15, (t0 - 32) % 6);
        PM_GLA_LOAD(B, (t1 - 32) / 96, ((t1 - 32) / 6) & 15, (t1 - 32) % 6);
        __syncthreads();
        pm_gla_compute(P, PM_GLA_ARGS(t0), PM_GLA_VALS(A), lds);
        PM_GLA_LOAD(A, (t2 - 32) / 96, ((t2 - 32) / 6) & 15, (t2 - 32) % 6);
        __syncthreads();
        pm_gla_compute(P, PM_GLA_ARGS(t1), PM_GLA_VALS(B), lds);
        __syncthreads();
        pm_gla_compute(P, PM_GLA_ARGS(t2), PM_GLA_VALS(A), lds);
        }
        if (pmask & 4) { pm_conv_compute(P, PM_CONV_ARGS(t3), C); pm_conv_compute(P, PM_CONV_ARGS(t4), D); }
    } else {
        for (; task < 800; task += G) { PM_GLA_DECL(A); PM_GLA_LOAD(A, (task - 32) / 96, ((task - 32) / 6) & 15, (task - 32) % 6); __syncthreads(); pm_gla_compute(P, PM_GLA_ARGS(task), PM_GLA_VALS(A), lds); }
        for (; task < 1312; task += G) pm_mlstm_conv(P, layer, PM_CONV_ARGS(task));
    }
#undef PM_GLA_ARGS
#undef PM_GLA_DECL
#undef PM_GLA_LOAD
#undef PM_GLA_VALS
#undef PM_CONV_ARGS
}
template <int TYPE, int VAR = 0>
__device__ __forceinline__ void mixer_chain(PP P, const int layer, const int b, const int h, LAS unsigned char* lds) {
    constexpr int DK = (TYPE == 1) ? 32 : 64, NDV = (TYPE == 2) ? 5 : 4, KS_DK = DK / 32;
    const int tid = opaque_tid(), lane = tid & 63, w = __builtin_amdgcn_readfirstlane(tid >> 6), l15 = lane & 15, l4 = lane >> 4;
    const bf16* proj = (const bf16*)(P->ws + WS_PROJ);
    bf16* og = (bf16*)(P->ws + WS_O);
    const float* rcos = (const float*)(P->ws + WS_ROPE); const float* rsin = rcos + 2056 * 32;
    const bf16* QKC = (const bf16*)(P->ws + WS_QKC); const float* GM = (const float*)(P->ws + WS_GM); const float* CM = (const float*)(P->ws + WS_CM);
    const bf16* GQ = (const bf16*)(P->ws + WS_GQ); const bf16* GK = (const bf16*)(P->ws + WS_GK); const bf16* GKT = (const bf16*)(P->ws + WS_GKT); const float* GBL = (const float*)(P->ws + WS_GBL);
    LAS unsigned char* Qs = lds + CH_OFF_Q; LAS unsigned char* Ks = lds + CH_OFF_K; LAS unsigned char* KT = lds + CH_OFF_KT;
    LAS unsigned char* VT = lds + CH_OFF_VT; LAS unsigned char* Ps = lds + CH_OFF_P; LAS unsigned char* Sst = lds + CH_OFF_S;
    LAS float* Bs = (LAS float*)(lds + CH_OFF_B);
    LAS float* gainl = (LAS float*)(lds + CH_END);
    LAS float* gF = Bs; LAS float* gG = Bs + 128; LAS float* gU = Bs + 256;
    const int qcol = (TYPE == 0) ? C_QR + h * 64 : 0;
    const int kcol = (TYPE == 0) ? C_KR + h * 64 : 0;
    const int vcol = (TYPE == 0) ? C_VR + h * 64 : (TYPE == 1) ? C_VG + h * 64 : C_VM + h * 64;
    const int gcol = (TYPE == 0) ? C_GR + h * 64 : (TYPE == 1) ? C_RG + h * 64 : C_OM + h * 64;
    const int ocol = (TYPE == 0) ? h * 64 : (TYPE == 1) ? 384 + h * 64 : 768 + h * 64;
    const float* gain = (TYPE == 0) ? P->in[I_GRET] + layer * 384 + h * 64 : (TYPE == 1) ? P->in[I_GGLA] + layer * 384 + h * 64 : P->in[I_GMLSTM] + layer * 256 + h * 64;
    const float lg = (TYPE == 0) ? log2f(1.0f - exp2f(-5.0f - (float)h)) : 0.f;
    const int iloc = 16 * w + l15;
    const int vt_tp = tid >> 3, vt_pc = tid & 7;
    const int qk_isq = tid >> 8, qk_tp = (tid >> 2) & 63, qk_p = tid & 3;

    if (tid < 64) gainl[tid] = gain[tid];
    for (int i = tid; i < 80 * CH_LDQ / 2; i += NTHREADS) ((LAS unsigned*)Sst)[i] = 0u;
    if (TYPE == 2) for (int i = tid; i < 16 * CH_LDT / 2; i += NTHREADS) { const int r = (2 * i) / CH_LDT; ((LAS unsigned*)(VT + 64 * CH_LDT * 2))[i] = (r == 0) ? 0x3F803F80u : 0u; }
    f32x4 acc_s[3];
#pragma unroll
    for (int t = 0; t < 3; ++t) acc_s[t] = (f32x4){0.f, 0.f, 0.f, 0.f};
    const int dkt = (TYPE == 1) ? (w & 1) : (w & 3);
    const int dvt0 = (TYPE == 1) ? (w >> 1) : (w >> 2) * 2;
    const float r_kd0 = (TYPE == 0) ? exp2f((float)(127 - 2 * qk_tp) * lg) : 1.f, r_kd1 = (TYPE == 0) ? exp2f((float)(126 - 2 * qk_tp) * lg) : 1.f;
    const float r_rsc = (TYPE == 0) ? exp2f((float)(iloc + 1) * lg) : 1.f;
    const float r_dcy = (TYPE == 0) ? exp2f(128.0f * lg) : 1.f;
    float r_wr[4];
#pragma unroll
    for (int r = 0; r < 4; ++r) r_wr[r] = (TYPE == 0) ? exp2f((float)(iloc - 4 * l4 - r) * lg) : 1.f;
    const float r_g16 = (TYPE == 0) ? exp2f(-16.0f * lg) : 1.f;

    bf16x8 pv0, pv1;
    bf16x8 px[2][2];
    f32x4 pcs[2][4];
    f32x4 pgm;
    float pgk[2];
    f32x4 pcm;
#define LD16(base_, off_) (*(const bf16x8*)((const char*)(base_) + (unsigned)(off_)))
#define LDF4(base_, off_) (*(const f32x4*)((const char*)(base_) + (unsigned)(off_)))
#define CH_LOAD(c_) do { const unsigned row0_ = (unsigned)(b * SEQ + (c_) * 128); \
        { const unsigned vo_ = ((row0_ + 2 * vt_tp) * NPROJ + vcol + 8 * vt_pc) * 2u; pv0 = LD16(proj, vo_); pv1 = LD16(proj, vo_ + NPROJ * 2u); } \
        if (TYPE == 0) { const unsigned ro_ = ((row0_ + 2 * qk_tp) * NPROJ + (qk_isq ? qcol : kcol) + 8 * qk_p) * 2u; \
            px[0][0] = LD16(proj, ro_); px[0][1] = LD16(proj, ro_ + 64u); px[1][0] = LD16(proj, ro_ + NPROJ * 2u); px[1][1] = LD16(proj, ro_ + NPROJ * 2u + 64u); \
            const unsigned co_ = (((c_) * 128 + 2 * qk_tp) * 32 + 8 * qk_p) * 4u; \
            pcs[0][0] = LDF4(rcos, co_); pcs[0][1] = LDF4(rcos, co_ + 16u); pcs[0][2] = LDF4(rsin, co_); pcs[0][3] = LDF4(rsin, co_ + 16u); \
            pcs[1][0] = LDF4(rcos, co_ + 128u); pcs[1][1] = LDF4(rcos, co_ + 144u); pcs[1][2] = LDF4(rsin, co_ + 128u); pcs[1][3] = LDF4(rsin, co_ + 144u); } \
        if (TYPE == 1) { const unsigned ro_ = ((row0_ + 2 * qk_tp) * 192 + h * 32 + 8 * qk_p) * 2u; \
            if (qk_isq) { px[0][0] = LD16(GQ, ro_); px[1][0] = LD16(GQ, ro_ + 384u); } \
            else { px[0][0] = LD16(GK, ro_); px[1][0] = LD16(GK, ro_ + 384u); px[0][1] = LD16(GKT, ro_); px[1][1] = LD16(GKT, ro_ + 384u); } \
            pcm = LDF4(GBL, (((unsigned)(b * 6 + h) * 16 + (c_)) * 32 + dkt * 16 + 4 * l4) * 4u); } \
        if (TYPE == 2) { const unsigned ro_ = ((row0_ + 2 * qk_tp) * 512 + (qk_isq ? 0 : 256) + h * 64 + 8 * qk_p) * 2u; \
            px[0][0] = LD16(QKC, ro_); px[0][1] = LD16(QKC, ro_ + 64u); px[1][0] = LD16(QKC, ro_ + 1024u); px[1][1] = LD16(QKC, ro_ + 1024u + 64u); \
            pgm = LDF4(GM, ((unsigned)(b * 4 + h) * SEQ + (c_) * 128 + (tid & 127)) * 16u); \
            pgk[0] = *(const float*)((const char*)GM + ((unsigned)(b * 4 + h) * SEQ + (c_) * 128 + 2 * qk_tp) * 16u + 4u); pgk[1] = *(const float*)((const char*)GM + ((unsigned)(b * 4 + h) * SEQ + (c_) * 128 + 2 * qk_tp + 1) * 16u + 4u); \
            pcm = LDF4(CM, (((unsigned)(b * 4 + h) * 16 + (c_)) * 4) * 4u); } \
    } while (0)
#define GR_LOAD(c_) do { const unsigned go_ = ((unsigned)(b * SEQ + (c_) * 128 + iloc) * NPROJ + gcol + 8 * l4) * 2u; gr[0] = *(const u32x4*)((const char*)proj + go_); gr[1] = *(const u32x4*)((const char*)proj + go_ + 64u); } while (0)
#define SCHED_FENCE() __builtin_amdgcn_sched_barrier(0)
    u32x4 gr[2];
#define CH_PROW(dt_) ((dt_) * 16 + l15)
    float m_last = 0.f;
    CH_LOAD(0);
    __syncthreads();

    for (int c = 0; c < 16; ++c) {
        const int row0 = b * SEQ + c * 128;
        {
            float v1[8], v2[8]; unpack8(pv0, v1); unpack8(pv1, v2);
#pragma unroll
            for (int e = 0; e < 8; ++e) *(LAS unsigned*)(VT + ((size_t)(32 * (vt_pc >> 2) + 16 * (e >> 2) + 4 * (vt_pc & 3) + (e & 3)) * CH_LDT + 2 * vt_tp) * 2) = pk2(v1[e], v2[e]);
        }
        float FL = 0.f, uL = 0.f, m_prev = 0.f;
        f32x4 bl4 = (f32x4){0.f, 0.f, 0.f, 0.f};
        if (TYPE == 1) bl4 = pcm;
        if (TYPE == 2) { FL = pcm[0]; uL = pcm[1]; m_prev = pcm[2]; }
        if (TYPE == 0) {
            float o1[2][8], o2[2][8];
#pragma unroll
            for (int tk = 0; tk < 2; ++tk) {
                const float cv[8] = {pcs[tk][0][0], pcs[tk][0][1], pcs[tk][0][2], pcs[tk][0][3], pcs[tk][1][0], pcs[tk][1][1], pcs[tk][1][2], pcs[tk][1][3]};
                const float sv[8] = {pcs[tk][2][0], pcs[tk][2][1], pcs[tk][2][2], pcs[tk][2][3], pcs[tk][3][0], pcs[tk][3][1], pcs[tk][3][2], pcs[tk][3][3]};
                float x1[8], x2[8]; unpack8(px[tk][0], x1); unpack8(px[tk][1], x2);
                const float sc = qk_isq ? 0.125f : 1.0f;
#pragma unroll
                for (int e = 0; e < 8; ++e) { o1[tk][e] = (x1[e] * cv[e] - x2[e] * sv[e]) * sc; o2[tk][e] = (x1[e] * sv[e] + x2[e] * cv[e]) * sc; }
                LAS unsigned char* dst = (qk_isq ? Qs : Ks) + ((2 * qk_tp + tk) * CH_LDQ + 8 * qk_p) * 2;
                *(LAS u32x4*)dst = pack8(o1[tk]); *(LAS u32x4*)(dst + 64) = pack8(o2[tk]);
            }
            if (!qk_isq) {
#pragma unroll
                for (int e = 0; e < 8; ++e) { o1[0][e] *= r_kd0; o2[0][e] *= r_kd0; o1[1][e] *= r_kd1; o2[1][e] *= r_kd1; }
                store_T2x8(KT, 8 * qk_p, 2 * qk_tp, o1[0], o1[1]); store_T2x8(KT, 32 + 8 * qk_p, 2 * qk_tp, o2[0], o2[1]);
            }
        }
        if (TYPE == 1) {
#pragma unroll
            for (int tk = 0; tk < 2; ++tk) *(LAS bf16x8*)((qk_isq ? Qs : Ks) + ((2 * qk_tp + tk) * CH_LDQ + 8 * qk_p) * 2) = px[tk][0];
            if (!qk_isq) { float k0[8], k1[8]; unpack8(px[0][1], k0); unpack8(px[1][1], k1); store_T2x8(KT, 8 * qk_p, 2 * qk_tp, k0, k1); }
        }
        if (TYPE == 2) {
#pragma unroll
            for (int tk = 0; tk < 2; ++tk) { LAS unsigned char* dst = (qk_isq ? Qs : Ks) + ((2 * qk_tp + tk) * CH_LDQ + 8 * qk_p) * 2; *(LAS bf16x8*)dst = px[tk][0]; *(LAS bf16x8*)(dst + 64) = px[tk][1]; }
            if (!qk_isq) {
                const float wk0 = __expf(pgk[0] - uL), wk1 = __expf(pgk[1] - uL);
                float a0[8], a1[8], c0[8], c1[8]; unpack8(px[0][0], a0); unpack8(px[1][0], a1); unpack8(px[0][1], c0); unpack8(px[1][1], c1);
#pragma unroll
                for (int e = 0; e < 8; ++e) { a0[e] *= wk0; c0[e] *= wk0; a1[e] *= wk1; c1[e] *= wk1; }
                store_T2x8(KT, 8 * qk_p, 2 * qk_tp, a0, a1); store_T2x8(KT, 32 + 8 * qk_p, 2 * qk_tp, c0, c1);
            }
            if (tid < 128) { gF[tid] = pgm[0]; gG[tid] = pgm[1]; gU[tid] = pgm[2]; }
        }
        if (c + 1 < 16 && VAR != 4) CH_LOAD(c + 1);
        __syncthreads();
        GR_LOAD(c);
        bf16x8 yq[KS_DK];
        f32x4 acc_o[NDV];
        float ui = 0.f;
        if (TYPE == 2) ui = gU[iloc];
#pragma unroll
        for (int ks = 0; ks < KS_DK; ++ks) yq[ks] = lfrag(Qs, iloc, CH_LDQ, 32 * ks + 8 * l4);
        {
            bf16x8 fs[NDV][KS_DK];
#pragma unroll
            for (int dt = 0; dt < NDV; ++dt)
#pragma unroll
                for (int ks = 0; ks < KS_DK; ++ks) fs[dt][ks] = lfrag(Sst, CH_PROW(dt), CH_LDQ, 32 * ks + 8 * l4);
            SCHED_FENCE();
#pragma unroll
            for (int dt = 0; dt < NDV; ++dt) {
                acc_o[dt] = (f32x4){0.f, 0.f, 0.f, 0.f};
#pragma unroll
                for (int ks = 0; ks < KS_DK; ++ks) acc_o[dt] = mma16(fs[dt][ks], yq[ks], acc_o[dt]);
            }
            SCHED_FENCE();
        }
        if (TYPE != 1) {
            const float rsc = (TYPE == 0) ? r_rsc : __expf(m_prev - ui);
#pragma unroll
            for (int dt = 0; dt < NDV; ++dt) acc_o[dt] *= rsc;
        }
        {
            float gjt = 1.0f;
#pragma unroll
            for (int jb = 0; jb < 2; ++jb) {
                f32x4 sc[4];
                bf16x8 fk[4][KS_DK];
#pragma unroll
                for (int j4 = 0; j4 < 4; ++j4)
#pragma unroll
                    for (int ks = 0; ks < KS_DK; ++ks) fk[j4][ks] = lfrag(Ks, (jb * 4 + j4) * 16 + l15, CH_LDQ, 32 * ks + 8 * l4);
                SCHED_FENCE();
#pragma unroll
                for (int j4 = 0; j4 < 4; ++j4) {
                    sc[j4] = (f32x4){0.f, 0.f, 0.f, 0.f};
#pragma unroll
                    for (int ks = 0; ks < KS_DK; ++ks) sc[j4] = mma16(fk[j4][ks], yq[ks], sc[j4]);
                }
#pragma unroll
                for (int j4 = 0; j4 < 4; ++j4) {
                    const int jt = jb * 4 + j4, j0 = jt * 16 + 4 * l4;
                    f32x4 gg = (f32x4){0.f, 0.f, 0.f, 0.f};
                    if (TYPE == 2) gg = *(const LAS f32x4*)(gG + j0);
#pragma unroll
                    for (int r = 0; r < 4; ++r) {
                        float wgt = 1.0f;
                        if (TYPE == 0) wgt = r_wr[r] * gjt;
                        if (TYPE == 2) wgt = __expf(fminf(gg[r] - ui, 0.f));
                        sc[j4][r] = (iloc >= j0 + r) ? sc[j4][r] * wgt : 0.f;
                    }
                    u32x2 wv; wv.x = pk2(sc[j4][0], sc[j4][1]); wv.y = pk2(sc[j4][2], sc[j4][3]);
                    *(LAS u32x2*)(Ps + (iloc * CH_LDT + jt * 16 + 4 * l4) * 2) = wv;
                    gjt *= r_g16;
                }
                asm volatile("" ::: "memory");
            }
        }
        asm volatile("s_waitcnt lgkmcnt(0)" ::: "memory");
        constexpr int PVB = 2;
#pragma unroll
        for (int kb = 0; kb < 4 / PVB; ++kb) {
            bf16x8 yp[PVB], fv[PVB][NDV];
#pragma unroll
            for (int k2 = 0; k2 < PVB; ++k2) {
                yp[k2] = lfrag(Ps, iloc, CH_LDT, 32 * (PVB * kb + k2) + 8 * l4);
#pragma unroll
                for (int dt = 0; dt < NDV; ++dt) fv[k2][dt] = lfrag(VT, CH_PROW(dt), CH_LDT, 32 * (PVB * kb + k2) + 8 * l4);
            }
            SCHED_FENCE();
#pragma unroll
            for (int k2 = 0; k2 < PVB; ++k2)
#pragma unroll
                for (int dt = 0; dt < NDV; ++dt) acc_o[dt] = mma16(fv[k2][dt], yp[k2], acc_o[dt]);
            SCHED_FENCE();
        }
        {
            if (TYPE == 2) {
                const float den = __shfl(acc_o[NDV - 1][0], l15);
                const float mt = gF[iloc] + ui;
                const float inv = __builtin_amdgcn_rcpf(fmaxf(fabsf(den), __expf(-mt)));
#pragma unroll
                for (int dt = 0; dt < 4; ++dt) acc_o[dt] *= inv;
            }
            float ss = 0.f;
#pragma unroll
            for (int dt = 0; dt < 4; ++dt) ss += (acc_o[dt][0] * acc_o[dt][0] + acc_o[dt][1] * acc_o[dt][1]) + (acc_o[dt][2] * acc_o[dt][2] + acc_o[dt][3] * acc_o[dt][3]);
            ss += __shfl_xor(ss, 16); ss += __shfl_xor(ss, 32);
            const float rn = rsqrtf(ss * (1.0f / 64.0f) + EPS);
            const unsigned oo = ((unsigned)(row0 + iloc) * DM + ocol + 8 * l4) * 2u;
#pragma unroll
            for (int dp = 0; dp < 2; ++dp) {
                const f32x4 gn0 = *(const LAS f32x4*)(gainl + dp * 32 + 8 * l4), gn1 = *(const LAS f32x4*)(gainl + dp * 32 + 8 * l4 + 4);
                const float ga[8] = {__uint_as_float(gr[dp].x << 16), __uint_as_float(gr[dp].x & 0xffff0000u), __uint_as_float(gr[dp].y << 16), __uint_as_float(gr[dp].y & 0xffff0000u),
                                     __uint_as_float(gr[dp].z << 16), __uint_as_float(gr[dp].z & 0xffff0000u), __uint_as_float(gr[dp].w << 16), __uint_as_float(gr[dp].w & 0xffff0000u)};
                float vv[8];
#pragma unroll
                for (int e = 0; e < 8; ++e) vv[e] = (TYPE == 2) ? fast_sigmoid(ga[e]) : fast_silu(ga[e]);
                u32x4 wv;
                wv.x = pk2(acc_o[2 * dp][0] * rn * gn0[0] * vv[0], acc_o[2 * dp][1] * rn * gn0[1] * vv[1]); wv.y = pk2(acc_o[2 * dp][2] * rn * gn0[2] * vv[2], acc_o[2 * dp][3] * rn * gn0[3] * vv[3]);
                wv.z = pk2(acc_o[2 * dp + 1][0] * rn * gn1[0] * vv[4], acc_o[2 * dp + 1][1] * rn * gn1[1] * vv[5]); wv.w = pk2(acc_o[2 * dp + 1][2] * rn * gn1[2] * vv[6], acc_o[2 * dp + 1][3] * rn * gn1[3] * vv[7]);
                *(u32x4*)((char*)og + oo + dp * 64u) = wv;
            }
        }
        {
            if (TYPE == 0) {
#pragma unroll
                for (int t = 0; t < 2; ++t) acc_s[t] *= r_dcy; }
            if (TYPE == 1) {
#pragma unroll
                for (int r = 0; r < 4; ++r) acc_s[0][r] *= __expf(bl4[r]); }
            if (TYPE == 2) { const float dcy = __expf(m_prev - uL);
#pragma unroll
                for (int t = 0; t < 3; ++t) acc_s[t] *= dcy; }
            constexpr int SB = 2;
#pragma unroll
            for (int kb = 0; kb < 4 / SB; ++kb) {
                bf16x8 fx[SB], f0[SB], f1[SB], f2[SB];
#pragma unroll
                for (int k2 = 0; k2 < SB; ++k2) {
                    const int ks = SB * kb + k2;
                    fx[k2] = lfrag(KT, dkt * 16 + l15, CH_LDT, 32 * ks + 8 * l4);
                    f0[k2] = lfrag(VT, dvt0 * 16 + l15, CH_LDT, 32 * ks + 8 * l4);
                    if (TYPE != 1) f1[k2] = lfrag(VT, (dvt0 + 1) * 16 + l15, CH_LDT, 32 * ks + 8 * l4);
                    if (TYPE == 2) f2[k2] = lfrag(VT, 64 + l15, CH_LDT, 32 * ks + 8 * l4);
                }
                SCHED_FENCE();
#pragma unroll
                for (int k2 = 0; k2 < SB; ++k2) {
                    acc_s[0] = mma16(fx[k2], f0[k2], acc_s[0]);
                    if (TYPE != 1) acc_s[1] = mma16(fx[k2], f1[k2], acc_s[1]);
                    if (TYPE == 2) { if (w < 4) acc_s[2] = mma16(fx[k2], f2[k2], acc_s[2]); }
                }
                SCHED_FENCE();
            }
        }
        if (TYPE == 2) m_last = FL + uL;
        __syncthreads();
        {
            u32x2 wv; wv.x = pk2(acc_s[0][0], acc_s[0][1]); wv.y = pk2(acc_s[0][2], acc_s[0][3]);
            *(LAS u32x2*)(Sst + ((dvt0 * 16 + l15) * CH_LDQ + dkt * 16 + 4 * l4) * 2) = wv;
            if (TYPE != 1) { wv.x = pk2(acc_s[1][0], acc_s[1][1]); wv.y = pk2(acc_s[1][2], acc_s[1][3]);
                *(LAS u32x2*)(Sst + (((dvt0 + 1) * 16 + l15) * CH_LDQ + dkt * 16 + 4 * l4) * 2) = wv; }
            if (TYPE == 2) { if (w < 4) { wv.x = pk2(acc_s[2][0], acc_s[2][1]); wv.y = pk2(acc_s[2][2], acc_s[2][3]);
                *(LAS u32x2*)(Sst + ((64 + l15) * CH_LDQ + dkt * 16 + 4 * l4) * 2) = wv; } }
        }
    }
#undef CH_LOAD
#undef GR_LOAD
#undef LD16
#undef LDF4
#undef SCHED_FENCE
    {
        const int tid = opaque_tid(), lane = tid & 63, w = __builtin_amdgcn_readfirstlane(tid >> 6), l15 = lane & 15, l4 = lane >> 4;
        const int dkt = (TYPE == 1) ? (w & 1) : (w & 3);
        const int dvt0 = (TYPE == 1) ? (w >> 1) : (w >> 2) * 2;
        const int dvl = 8 * (l15 >> 2) + (l15 & 3);
        float* out = P->out;
        if (TYPE == 0) {
            float* sp = out + O_PRET + (((size_t)layer * NB + b) * 6 + h) * 4096;
#pragma unroll
            for (int t = 0; t < 2; ++t)
#pragma unroll
                for (int r = 0; r < 4; ++r) sp[(dkt * 16 + 4 * l4 + r) * 64 + 32 * ((dvt0 + t) >> 1) + 4 * ((dvt0 + t) & 1) + dvl] = acc_s[t][r];
        }
        if (TYPE == 1) {
            float* sp = out + O_PGLA + (((size_t)layer * NB + b) * 6 + h) * 2048;
#pragma unroll
            for (int r = 0; r < 4; ++r) sp[(dkt * 16 + 4 * l4 + r) * 64 + 32 * (dvt0 >> 1) + 4 * (dvt0 & 1) + dvl] = acc_s[0][r];
        }
        if (TYPE == 2) {
            float* sp = out + O_PC + (((size_t)layer * NB + b) * 4 + h) * 4096;
#pragma unroll
            for (int t = 0; t < 2; ++t)
#pragma unroll
                for (int r = 0; r < 4; ++r) sp[(dkt * 16 + 4 * l4 + r) * 64 + 32 * ((dvt0 + t) >> 1) + 4 * ((dvt0 + t) & 1) + dvl] = acc_s[t][r];
            if (w < 4 && l15 == 0) {
                float* np = out + O_PN + (((size_t)layer * NB + b) * 4 + h) * 64;
#pragma unroll
                for (int r = 0; r < 4; ++r) np[dkt * 16 + 4 * l4 + r] = acc_s[2][r];
            }
            if (tid == 0) out[O_PM + ((size_t)layer * NB + b) * 4 + h] = m_last;
            if (tid < 384) {
                const int r = tid >> 7, cc = tid & 127, ch = (cc >> 6) * 256 + h * 64 + (cc & 63);
                out[O_PCONV + (((size_t)layer * NB + b) * 3 + r) * 512 + ch] = bf2f(proj[(size_t)(b * SEQ + SEQ - 3 + r) * NPROJ + C_QKM + ch]);
            }
        }
    }
}
__device__ __forceinline__ void sample_mixer(PP P, const int layer, const int b, const int hh, LAS unsigned char* wl  , const int lane) {
    const bf16* proj = (const bf16*)(P->ws + WS_PROJ);
    const float* projg = (const float*)(P->ws + WS_PROJG);
    bf16* og = (bf16*)(P->ws + WS_O);
    const float* rcos = (const float*)(P->ws + WS_ROPE); const float* rsin = rcos + 2056 * 32;
    LAS float* qs = (LAS float*)wl;
    LAS float* ks = qs + 512;
    LAS float* as = ks + 512;
    LAS float* vl = as + 256;
    LAS float* ol = vl + 512;
    const int row0 = MP + b * DECT;
    if (hh < 6) {
        const int h = hh;
        const float gamma = 1.0f - exp2f(-5.0f - (float)h);
        const int dlo = lane & 31;
#pragma unroll
        for (int t = 0; t < 8; ++t) {
            const bf16* rp = proj + (size_t)(row0 + t) * NPROJ;
            const float cs = rcos[(2048 + t) * 32 + dlo], sn = rsin[(2048 + t) * 32 + dlo];
            const float q1 = bf2f(rp[C_QR + h * 64 + dlo]), q2 = bf2f(rp[C_QR + h * 64 + 32 + dlo]);
            const float k1 = bf2f(rp[C_KR + h * 64 + dlo]), k2 = bf2f(rp[C_KR + h * 64 + 32 + dlo]);
            qs[t * 64 + lane] = ((lane < 32) ? q1 * cs - q2 * sn : q1 * sn + q2 * cs) * 0.125f;
            ks[t * 64 + lane] = (lane < 32) ? k1 * cs - k2 * sn : k1 * sn + k2 * cs;
        }
        asm volatile("s_waitcnt lgkmcnt(0)" ::: "memory");
#pragma unroll
        for (int t = 0; t < 8; ++t) vl[t * 64 + lane] = bf2f(proj[(size_t)(row0 + t) * NPROJ + C_VR + h * 64 + lane]);
#pragma unroll 1
        for (int hf = 0; hf < 2; ++hf) {
            const float* s0 = P->in[I_SRET] + (((size_t)layer * DECB + b) * 6 + h) * 4096 + hf * 2048 + lane;
            float S[32];
#pragma unroll
            for (int d = 0; d < 32; ++d) S[d] = s0[d * 64];
#pragma unroll 1
            for (int t = 0; t < 8; ++t) {
                const float v = vl[t * 64 + lane];
                float o = 0.f;
#pragma unroll
                for (int d4 = 0; d4 < 8; ++d4) {
                    const f32x4 kk = *(const LAS f32x4*)(ks + t * 64 + hf * 32 + 4 * d4), qq = *(const LAS f32x4*)(qs + t * 64 + hf * 32 + 4 * d4);
#pragma unroll
                    for (int e = 0; e < 4; ++e) { S[4 * d4 + e] = gamma * S[4 * d4 + e] + kk[e] * v; o += qq[e] * S[4 * d4 + e]; }
                }
                ol[t * 64 + lane] = hf ? ol[t * 64 + lane] + o : o;
            }
            float* so = P->out + O_SRET + (((size_t)layer * DECB + b) * 6 + h) * 4096 + hf * 2048 + lane;
#pragma unroll
            for (int d = 0; d < 32; ++d) so[d * 64] = S[d];
        }
        const float gn = P->in[I_GRET][layer * 384 + h * 64 + lane];
#pragma unroll 1
        for (int t = 0; t < 8; ++t) {
            const float o = ol[t * 64 + lane];
            const float rn = rsqrtf(wave_sum(o * o) * (1.0f / 64.0f) + EPS);
            const float g = bf2f(proj[(size_t)(row0 + t) * NPROJ + C_GR + h * 64 + lane]);
            og[(size_t)(row0 + t) * DM + h * 64 + lane] = f2bf(o * rn * gn * siluf(g));
        }
    } else if (hh < 12) {
        const int h = hh - 6;
        {
            const int t = lane >> 3, c0 = (lane & 7) * 4;
            const f32x4* ap = (const f32x4*)(projg + (size_t)(row0 + t) * 32);
            const f32x4 a0 = ap[0], a1 = ap[1], a2 = ap[2], a3 = ap[3];
            const float ag[16] = {a0[0], a0[1], a0[2], a0[3], a1[0], a1[1], a1[2], a1[3], a2[0], a2[1], a2[2], a2[3], a3[0], a3[1], a3[2], a3[3]};
#pragma unroll
            for (int cc = 0; cc < 4; ++cc) {
                const int col = h * 32 + c0 + cc;
                float x = P->in[I_BGA][layer * 192 + col];
                const float* wp = P->in[I_WGA2] + (size_t)layer * 16 * 192 + col;
#pragma unroll
                for (int r = 0; r < 16; ++r) x += ag[r] * wp[r * 192];
                as[t * 32 + c0 + cc] = expf(log_sigmoid(x) * (1.0f / 16.0f));
            }
        }
        if (lane < 32) {
#pragma unroll
            for (int t = 0; t < 8; ++t) {
                const bf16* rp = proj + (size_t)(row0 + t) * NPROJ;
                qs[t * 64 + lane] = bf2f(rp[C_QG + h * 32 + lane]) * 0.17677669529663687f;
                ks[t * 64 + lane] = bf2f(rp[C_KG + h * 32 + lane]);
            }
        }
        asm volatile("s_waitcnt lgkmcnt(0)" ::: "memory");
        const float* s0 = P->in[I_SGLA] + (((size_t)layer * DECB + b) * 6 + h) * 2048 + lane;
        float S[32];
#pragma unroll
        for (int d = 0; d < 32; ++d) S[d] = s0[d * 64];
#pragma unroll 1
        for (int t = 0; t < 8; ++t) {
            const bf16* rp = proj + (size_t)(row0 + t) * NPROJ;
            const float v = bf2f(rp[C_VG + h * 64 + lane]);
            float o = 0.f;
#pragma unroll
            for (int d4 = 0; d4 < 8; ++d4) {
                const f32x4 kk = *(const LAS f32x4*)(ks + t * 64 + 4 * d4), qq = *(const LAS f32x4*)(qs + t * 64 + 4 * d4), aa = *(const LAS f32x4*)(as + t * 32 + 4 * d4);
#pragma unroll
                for (int e = 0; e < 4; ++e) { S[4 * d4 + e] = aa[e] * S[4 * d4 + e] + kk[e] * v; o += qq[e] * S[4 * d4 + e]; }
            }
            const float rn = rsqrtf(wave_sum(o * o) * (1.0f / 64.0f) + EPS);
            const float g = bf2f(rp[C_RG + h * 64 + lane]);
            og[(size_t)(row0 + t) * DM + 384 + h * 64 + lane] = f2bf(o * rn * P->in[I_GGLA][layer * 384 + h * 64 + lane] * siluf(g));
        }
        float* so = P->out + O_SGLA + (((size_t)layer * DECB + b) * 6 + h) * 2048 + lane;
#pragma unroll
        for (int d = 0; d < 32; ++d) so[d * 64] = S[d];
    } else {
        const int h = hh - 12;
        {
#pragma unroll
            for (int which = 0; which < 2; ++which) {
                const int ch = which * 256 + h * 64 + lane;
                float up[11];
                const float* cbuf = P->in[I_SCONV] + ((size_t)layer * DECB + b) * 3 * 512 + ch;
#pragma unroll
                for (int r = 0; r < 3; ++r) up[r] = cbuf[r * 512];
#pragma unroll
                for (int t = 0; t < 8; ++t) up[3 + t] = bf2f(proj[(size_t)(row0 + t) * NPROJ + C_QKM + ch]);
                const float* cw = P->in[I_CONVW] + (size_t)layer * 4 * 512 + ch;
                const float w0 = cw[0], w1 = cw[512], w2 = cw[1024], w3 = cw[1536], cb = P->in[I_CONVB][layer * 512 + ch];
#pragma unroll
                for (int t = 0; t < 8; ++t) {
                    const float y = siluf(cb + w0 * up[t] + w1 * up[t + 1] + w2 * up[t + 2] + w3 * up[t + 3]);
                    if (which) ks[t * 64 + lane] = y * 0.125f; else qs[t * 64 + lane] = y;
                }
                float* co = P->out + O_SCONV + ((size_t)layer * DECB + b) * 3 * 512 + ch;
#pragma unroll
                for (int r = 0; r < 3; ++r) co[r * 512] = up[8 + r];
            }
        }
        asm volatile("s_waitcnt lgkmcnt(0)" ::: "memory");
        float nv = P->in[I_SN][(((size_t)layer * DECB + b) * 4 + h) * 64 + lane];
        float mm = P->in[I_SM][((size_t)layer * DECB + b) * 4 + h];
        const float bfv = P->in[I_BF][layer * 4 + h], biv = P->in[I_BI][layer * 4 + h];
        LAS float* fsl = as; LAS float* denl = as + 8; LAS float* emnl = as + 16;
#pragma unroll 1
        for (int t = 0; t < 8; ++t) {
            const float* gp = projg + (size_t)(row0 + t) * 32;
            const float lf = log_sigmoid(gp[20 + h] + bfv), li = gp[16 + h] + biv;
            const float mn = fmaxf(lf + mm, li);
            const float fsv = expf(lf + mm - mn), is = expf(li - mn);
            vl[t * 64 + lane] = bf2f(proj[(size_t)(row0 + t) * NPROJ + C_VM + h * 64 + lane]) * is;
            nv = fsv * nv + is * ks[t * 64 + lane];
            const float dn = wave_sum(qs[t * 64 + lane] * nv);
            if (lane == 0) { fsl[t] = fsv; denl[t] = dn; emnl[t] = expf(-mn); }
            mm = mn;
        }
        asm volatile("s_waitcnt lgkmcnt(0)" ::: "memory");
#pragma unroll 1
        for (int hf = 0; hf < 2; ++hf) {
            const float* c0p = P->in[I_SC] + (((size_t)layer * DECB + b) * 4 + h) * 4096 + hf * 2048 + lane;
            float S[32];
#pragma unroll
            for (int d = 0; d < 32; ++d) S[d] = c0p[d * 64];
#pragma unroll 1
            for (int t = 0; t < 8; ++t) {
                const float v = vl[t * 64 + lane], fsv = fsl[t];
                float o = 0.f;
#pragma unroll
                for (int d4 = 0; d4 < 8; ++d4) {
                    const f32x4 kk = *(const LAS f32x4*)(ks + t * 64 + hf * 32 + 4 * d4), qq = *(const LAS f32x4*)(qs + t * 64 + hf * 32 + 4 * d4);
#pragma unroll
                    for (int e = 0; e < 4; ++e) { S[4 * d4 + e] = fsv * S[4 * d4 + e] + kk[e] * v; o += qq[e] * S[4 * d4 + e]; }
                }
                ol[t * 64 + lane] = hf ? ol[t * 64 + lane] + o : o;
            }
            float* so = P->out + O_SC + (((size_t)layer * DECB + b) * 4 + h) * 4096 + hf * 2048 + lane;
#pragma unroll
            for (int d = 0; d < 32; ++d) so[d * 64] = S[d];
        }
        const float gn = P->in[I_GMLSTM][layer * 256 + h * 64 + lane];
#pragma unroll 1
        for (int t = 0; t < 8; ++t) {
            const float hv = ol[t * 64 + lane] / fmaxf(fabsf(denl[t]), emnl[t]);
            const float rn = rsqrtf(wave_sum(hv * hv) * (1.0f / 64.0f) + EPS);
            const float g = bf2f(proj[(size_t)(row0 + t) * NPROJ + C_OM + h * 64 + lane]);
            og[(size_t)(row0 + t) * DM + 768 + h * 64 + lane] = f2bf(hv * rn * gn * sigmoidf(g));
        }
        P->out[O_SN + (((size_t)layer * DECB + b) * 4 + h) * 64 + lane] = nv;
        if (lane == 0) P->out[O_SM + ((size_t)layer * DECB + b) * 4 + h] = mm;
    }
    asm volatile("s_waitcnt lgkmcnt(0)" ::: "memory");
}
constexpr int AP_BUF = 36864, AP_POFF = 2 * AP_BUF, AP_PW = 8448, AP_END = AP_POFF + 8 * AP_PW;
static_assert(AP_END <= LDS_BYTES - 64, "attention lds");
__device__ __forceinline__ void attn_prompt_tile(const bf16* __restrict__ q, const bf16* __restrict__ memK, const bf16* __restrict__ memVt, bf16* __restrict__ att, const int tile, LAS unsigned char* lds) {
    const int tid = opaque_tid(), lane = tid & 63, w = __builtin_amdgcn_readfirstlane(tid >> 6), l15 = lane & 15, l4 = lane >> 4;
    const int b = tile >> 6, head = (tile >> 4) & 3, tt = tile & 15;
    const int R0 = b * SEQ + tt * 128 + 16 * w;
    const bf16* qrow = q + (size_t)(R0 + l15) * DM + head * 256 + 8 * l4;
    bf16x8 yq[8];
#pragma unroll
    for (int ks = 0; ks < 8; ++ks) yq[ks] = *(const bf16x8*)(qrow + 32 * ks);
    const bf16* kg = memK + ((size_t)b * 256) * 1024 + head * 256;
    const bf16* vg = memVt + (((size_t)b * 4 + head) * 256) * 256;
    u32x4 stA[4], stB[4];
#define AP_LOAD(n, ST) do { _Pragma("unroll") for (int i_ = 0; i_ < 4; ++i_) { const int p_ = tid + 512 * i_; \
        if ((n) < 4) ST[i_] = *(const u32x4*)(kg + (size_t)(64 * (n) + (p_ >> 5)) * 1024 + (p_ & 31) * 8); \
        else ST[i_] = *(const u32x4*)(vg + (size_t)(p_ >> 3) * 256 + 64 * ((n) - 4) + (p_ & 7) * 8); } } while (0)
#define AP_STORE(n, ST) do { LAS unsigned char* bb_ = lds + ((n) & 1) * AP_BUF; _Pragma("unroll") for (int i_ = 0; i_ < 4; ++i_) { const int p_ = tid + 512 * i_; \
        if ((n) < 4) *(LAS u32x4*)(bb_ + ((p_ >> 5) * 264 + (p_ & 31) * 8) * 2) = ST[i_]; \
        else { const int d_ = p_ >> 3, sl_ = (d_ & ~31) | (((d_ >> 2) & 1) << 4) | (((d_ >> 3) & 3) << 2) | (d_ & 3);     \
               *(LAS u32x4*)(bb_ + (sl_ * 72 + (p_ & 7) * 8) * 2) = ST[i_]; } } } while (0)
    AP_LOAD(0, stA); AP_LOAD(1, stB); AP_STORE(0, stA);
    __syncthreads();
    f32x4 s[16];
    f32x4 o[16];
    float inv = 0.f;
    LAS unsigned char* Pw = lds + AP_POFF + w * AP_PW;
#pragma unroll
    for (int n = 0; n < 8; ++n) {
        if (n < 6) { if (n & 1) AP_LOAD(n + 2, stB); else AP_LOAD(n + 2, stA); }
        const LAS unsigned char* bb = lds + (n & 1) * AP_BUF;
        if (n < 4) {
#pragma unroll
            for (int j4 = 0; j4 < 4; ++j4) {
                f32x4 a = (f32x4){0.f, 0.f, 0.f, 0.f};
#pragma unroll
                for (int ks = 0; ks < 8; ++ks) a = mma16(lfrag(bb, 16 * j4 + l15, 264, 32 * ks + 8 * l4), yq[ks], a);
                s[4 * n + j4] = a;
            }
            if (n == 3) {
                float mx = -3.0e38f;
#pragma unroll
                for (int jt = 0; jt < 16; ++jt) mx = fmaxf(mx, fmaxf(fmaxf(s[jt][0], s[jt][1]), fmaxf(s[jt][2], s[jt][3])));
                mx = fmaxf(mx, __shfl_xor(mx, 16)); mx = fmaxf(mx, __shfl_xor(mx, 32));
                float sum = 0.f;
#pragma unroll
                for (int jt = 0; jt < 16; ++jt) {
#pragma unroll
                    for (int r = 0; r < 4; ++r) { const float p = __expf(s[jt][r] - mx); s[jt][r] = p; sum += p; }
                }
                sum += __shfl_xor(sum, 16); sum += __shfl_xor(sum, 32);
                inv = 1.0f / sum;
#pragma unroll
                for (int jt = 0; jt < 16; ++jt) { u32x2 wv; wv.x = pk2(s[jt][0], s[jt][1]); wv.y = pk2(s[jt][2], s[jt][3]); *(LAS u32x2*)(Pw + (l15 * 264 + jt * 16 + 4 * l4) * 2) = wv; }
#pragma unroll
                for (int dt = 0; dt < 16; ++dt) o[dt] = (f32x4){0.f, 0.f, 0.f, 0.f};
                asm volatile("s_waitcnt lgkmcnt(0)" ::: "memory");
            }
        } else {
#pragma unroll
            for (int k2 = 0; k2 < 2; ++k2) {
                const bf16x8 y = lfrag(Pw, l15, 264, 64 * (n - 4) + 32 * k2 + 8 * l4);
#pragma unroll
                for (int dt = 0; dt < 16; ++dt) o[dt] = mma16(lfrag(bb, 16 * dt + l15, 72, 32 * k2 + 8 * l4), y, o[dt]);
            }
        }
        if (n < 7) { if (n & 1) AP_STORE(n + 1, stA); else AP_STORE(n + 1, stB); __syncthreads(); }
    }
#undef AP_LOAD
#undef AP_STORE
    bf16* orow = att + (size_t)(R0 + l15) * DM + head * 256 + 8 * l4;
#pragma unroll
    for (int dp = 0; dp < 8; ++dp) { u32x4 wv; wv.x = pk2(o[2 * dp][0] * inv, o[2 * dp][1] * inv); wv.y = pk2(o[2 * dp][2] * inv, o[2 * dp][3] * inv);
        wv.z = pk2(o[2 * dp + 1][0] * inv, o[2 * dp + 1][1] * inv); wv.w = pk2(o[2 * dp + 1][2] * inv, o[2 * dp + 1][3] * inv); *(u32x4*)(orow + dp * 32) = wv; }
}

constexpr int AS_PT = 0, AS_OP = 16384, AS_MX = 81920, AS_SM = 82944, AS_END = 83968;
__device__ __forceinline__ void attn_sample_tile(const bf16* __restrict__ q, const float* __restrict__ ck, const float* __restrict__ cv, bf16* __restrict__ att, const int tile, LAS unsigned char* lds) {
    const int tid = opaque_tid(), lane = tid & 63, w = __builtin_amdgcn_readfirstlane(tid >> 6), l15 = lane & 15, l4 = lane >> 4;
    const int b = tile >> 1, hl = w >> 2, head = (tile & 1) * 2 + hl, qtr = w & 3;
    const int R0 = MP + b * DECT;
    const bf16* qrow = q + (size_t)(R0 + (l15 & 7)) * DM + head * 256 + 4 * l4;
    bf16x8 yq[8];
#pragma unroll
    for (int ks = 0; ks < 8; ++ks) { const u32x2 qa = *(const u32x2*)(qrow + 32 * ks), qc = *(const u32x2*)(qrow + 32 * ks + 16); u32x4 qw; qw.x = qa.x; qw.y = qa.y; qw.z = qc.x; qw.w = qc.y; yq[ks] = __builtin_bit_cast(bf16x8, qw); }
    const float* kb = ck + (((size_t)b * 256 + 64 * qtr + l15) * 4 + head) * 256 + 4 * l4;
    f32x4 s[4];
    f32x4 ka0[8], kc0[8], ka1[8], kc1[8];
#define AS_KLOAD(KA, KC, jt) do { _Pragma("unroll") for (int ks_ = 0; ks_ < 8; ++ks_) { const f32x4* kp_ = (const f32x4*)(kb + (size_t)(jt) * 16 * 1024 + 32 * ks_); KA[ks_] = __builtin_nontemporal_load(kp_); KC[ks_] = __builtin_nontemporal_load(kp_ + 4); } } while (0)
#define AS_KMMA(KA, KC, jt) do { s[jt] = (f32x4){0.f, 0.f, 0.f, 0.f}; _Pragma("unroll") for (int ks_ = 0; ks_ < 8; ++ks_) { \
        u32x4 xw_; xw_.x = pk2(KA[ks_][0], KA[ks_][1]); xw_.y = pk2(KA[ks_][2], KA[ks_][3]); xw_.z = pk2(KC[ks_][0], KC[ks_][1]); xw_.w = pk2(KC[ks_][2], KC[ks_][3]); \
        s[jt] = mma16(__builtin_bit_cast(bf16x8, xw_), yq[ks_], s[jt]); } } while (0)
    AS_KLOAD(ka0, kc0, 0); AS_KLOAD(ka1, kc1, 1);
    AS_KMMA(ka0, kc0, 0); AS_KLOAD(ka0, kc0, 2);
    AS_KMMA(ka1, kc1, 1); AS_KLOAD(ka1, kc1, 3);
    AS_KMMA(ka0, kc0, 2);
    AS_KMMA(ka1, kc1, 3);
#undef AS_KLOAD
#undef AS_KMMA
    LAS float* MX = (LAS float*)(lds + AS_MX); LAS float* SM = (LAS float*)(lds + AS_SM);
    float mx = -3.0e38f;
#pragma unroll
    for (int jt = 0; jt < 4; ++jt) mx = fmaxf(mx, fmaxf(fmaxf(s[jt][0], s[jt][1]), fmaxf(s[jt][2], s[jt][3])));
    mx = fmaxf(mx, __shfl_xor(mx, 16)); mx = fmaxf(mx, __shfl_xor(mx, 32));
    if (lane < 16) MX[w * 16 + lane] = mx;
    __syncthreads();
    {
        const int wb = hl * 4;
        mx = fmaxf(fmaxf(MX[(wb + 0) * 16 + l15], MX[(wb + 1) * 16 + l15]), fmaxf(MX[(wb + 2) * 16 + l15], MX[(wb + 3) * 16 + l15]));
    }
    float sum = 0.f;
#pragma unroll
    for (int jt = 0; jt < 4; ++jt) {
#pragma unroll
        for (int r = 0; r < 4; ++r) { const float p = __expf(s[jt][r] - mx); s[jt][r] = p; sum += p; }
    }
    sum += __shfl_xor(sum, 16); sum += __shfl_xor(sum, 32);
    if (lane < 16) SM[w * 16 + lane] = sum;
#pragma unroll
    for (int jt = 0; jt < 4; ++jt)
#pragma unroll
        for (int r = 0; r < 4; ++r) { float t_ = s[jt][r]; asm volatile("" : "+v"(t_)); s[jt][r] = t_; }
    float acc[8][4];
#pragma unroll
    for (int t = 0; t < 8; ++t)
#pragma unroll
        for (int e = 0; e < 4; ++e) acc[t][e] = 0.f;
    const float* vb = cv + (((size_t)b * 256 + 64 * qtr) * 4 + head) * 256 + lane * 4;
#pragma unroll
    for (int bi = 0; bi < 4; ++bi) {
        f32x4 v[16];
#pragma unroll
        for (int jj = 0; jj < 16; ++jj) v[jj] = __builtin_nontemporal_load((const f32x4*)(vb + (size_t)(16 * bi + jj) * 1024));
#pragma unroll
        for (int jj = 0; jj < 16; ++jj) {
#pragma unroll
            for (int t = 0; t < 8; ++t) {
                const float p = __shfl(s[bi][jj & 3], 16 * (jj >> 2) + t);
#pragma unroll
                for (int e = 0; e < 4; ++e) acc[t][e] += p * v[jj][e];
            }
        }
    }
    LAS float* OP = (LAS float*)(lds + AS_OP);
#pragma unroll
    for (int t = 0; t < 8; ++t) *(LAS f32x4*)(OP + (w * 8 + t) * 256 + lane * 4) = (f32x4){acc[t][0], acc[t][1], acc[t][2], acc[t][3]};
    __syncthreads();
    {
        const int wb = hl * 4;
#pragma unroll
        for (int tt = 0; tt < 2; ++tt) {
            const int t = 2 * qtr + tt;
            const float tot = (SM[(wb + 0) * 16 + t] + SM[(wb + 1) * 16 + t]) + (SM[(wb + 2) * 16 + t] + SM[(wb + 3) * 16 + t]);
            const float inv = 1.0f / tot;
            f32x4 o = *(const LAS f32x4*)(OP + ((wb + 0) * 8 + t) * 256 + lane * 4);
            o += *(const LAS f32x4*)(OP + ((wb + 1) * 8 + t) * 256 + lane * 4);
            o += *(const LAS f32x4*)(OP + ((wb + 2) * 8 + t) * 256 + lane * 4);
            o += *(const LAS f32x4*)(OP + ((wb + 3) * 8 + t) * 256 + lane * 4);
            u32x2 wv; wv.x = pk2(o[0] * inv, o[1] * inv); wv.y = pk2(o[2] * inv, o[3] * inv);
            *(u32x2*)(att + (size_t)(R0 + t) * DM + head * 256 + lane * 4) = wv;
        }
    }
}
constexpr int N_PHASES = 20;
#ifndef DBG_S_REPS
#define DBG_S_REPS 0
#endif
#ifndef DBG_E_REP
#define DBG_E_REP 0
#endif
#ifndef DBG_GEMM_REPS
#define DBG_GEMM_REPS 1
#endif
#ifndef DBG_SMALL_REPS
#define DBG_SMALL_REPS 1
#endif
#ifndef DBG_UNIT_REPS
#define DBG_UNIT_REPS 1
#endif
#ifndef DBG_EXTRA_BARS
#define DBG_EXTRA_BARS 0
#endif
#ifndef DBG_NOLO
#define DBG_NOLO 0
#endif
#ifndef REP_MASK
#define REP_MASK 0
#endif
__host__ __device__ constexpr bool rep_sub(int s9) { return s9 == 1 ? ((REP_MASK >> 10) & 1) : (s9 == 0 ? (REP_MASK & 1) : (((REP_MASK >> (s9 - 1)) & 1) && (s9 - 1) != 2 && (s9 - 1) != 5 && (s9 - 1) != 7)); }
#ifndef HP_LEVEL
#define HP_LEVEL 0
#endif
#ifndef DBG_VAR
#define DBG_VAR 0
#endif
#ifndef DBG_TYPES
#define DBG_TYPES 7
#endif
#ifndef DBG_REPS
#define DBG_REPS 1
#endif
#ifndef DBG_REP_SAMPLE
#define DBG_REP_SAMPLE 0
#endif
#ifndef USE_CG_SYNC
#define USE_CG_SYNC 0
#endif
#ifndef DBG_STOP
#define DBG_STOP 0
#endif
#define DBG_ONLY 0
#define DBG_SKIP_HELPER 0
#define DBG_EXPR ((i < (size_t)MP * DM && (i % 1024) < 384) ? bf2f(og[i]) : 0.f)
__device__ __forceinline__ void phase_dump(PP P) {
    const size_t n = (size_t)MT * DM;
    const bf16* proj = (const bf16*)(P->ws + WS_PROJ); const bf16* og = (const bf16*)(P->ws + WS_O); const bf16* qb = (const bf16*)(P->ws + WS_Q);
    const bf16* att = (const bf16*)(P->ws + WS_ATT); const bf16* hb = (const bf16*)(P->ws + WS_H); const float* xf = (const float*)(P->ws + WS_XF);
    const bf16* xb = (const bf16*)(P->ws + WS_XB); const float* projg = (const float*)(P->ws + WS_PROJG); const float* rss = (const float*)(P->ws + WS_RSS);
    for (size_t i = (size_t)blockIdx.x * NTHREADS + threadIdx.x; i < n; i += (size_t)gridDim.x * NTHREADS) {
        float v = 0.f;
#if DBG_ONLY
        v = DBG_EXPR;
#elif DBG_STOP >= 1
        v += bf2f(proj[i]) + bf2f(proj[i + n]) + bf2f(proj[i + 2 * n]) + bf2f(proj[(i + 3 * n) % ((size_t)MT * NPROJ)]) + projg[i % ((size_t)MT * 32)] + bf2f(xb[i]) + rss[i % ((size_t)MT * 16)];
#endif
#if DBG_STOP >= 2
        v += bf2f(og[i]);
#endif
#if DBG_STOP >= 3
        v += xf[i];
#endif
#if DBG_STOP >= 4
        v += bf2f(qb[i]);
#endif
#if DBG_STOP >= 5
        v += bf2f(att[i]);
#endif
#if DBG_STOP >= 7
        v += bf2f(hb[i]) + bf2f(hb[i + n]) + bf2f(hb[(i + 2 * n) % ((size_t)MT * DFF)]);
#endif
        P->out[i] = v;
    }
#ifdef DBG_KEEP
    {
        const size_t g0[4] = {O_YP, O_PRET, O_PMK, O_SRET}, g1[4] = {O_PRET, O_PMK, O_SRET, O_END};
#pragma unroll
        for (int k = 0; k < 4; ++k) if (!((DBG_KEEP >> k) & 1)) {
            for (size_t i = g0[k] + (size_t)blockIdx.x * NTHREADS + threadIdx.x; i < g1[k]; i += (size_t)gridDim.x * NTHREADS) P->out[i] = 1.0f; }
    }
#endif
#if DBG_STOP < 10
    {
        const size_t offs[13] = {O_PRET, O_PGLA, O_PC, O_PN, O_PM, O_PCONV, O_PMK, O_SRET, O_SGLA, O_SC, O_SN, O_SM, O_SCONV};
        const size_t ends[13] = {O_PGLA, O_PC, O_PN, O_PM, O_PCONV, O_PMK, O_PMK, O_SGLA, O_SC, O_SN, O_SM, O_SCONV, O_END};
#pragma unroll
        for (int k = 0; k < 13; ++k) { const size_t half = (ends[k] - offs[k]) / 2;
            for (size_t i = (size_t)blockIdx.x * NTHREADS + threadIdx.x; i < half; i += (size_t)gridDim.x * NTHREADS) P->out[offs[k] + half + i] = 1.0f; }
    }
#endif
}

__device__ __forceinline__ void unit_of_block256(const int c, pg8::Unit& u) { const int xcd = c & 7, off = c >> 3; u.pm = 8 * xcd + (off & 7); u.pn = off >> 3; }

__device__ __forceinline__ void finalize_panel(PP P, unsigned* cnt, const unsigned need, const int row0, const int nrows, LAS unsigned char* lds) {
    const int tid = opaque_tid(), lane = tid & 63, wave = __builtin_amdgcn_readfirstlane(tid >> 6);
    volatile LAS unsigned* flag = (volatile LAS unsigned*)(lds + LDS_BYTES - 64) + 8;
    asm volatile("s_waitcnt vmcnt(0)" ::: "memory");
    __syncthreads();
    if (tid == 0) {
        __builtin_amdgcn_fence(__ATOMIC_RELEASE, "agent");
        asm volatile("s_waitcnt vmcnt(0)" ::: "memory");
        flag[0] = __hip_atomic_fetch_add(cnt, 1u, __ATOMIC_RELAXED, __HIP_MEMORY_SCOPE_AGENT);
    }
    __syncthreads();
    const bool last = (flag[0] == need - 1u);
    if (last) {
        if (tid == 0) { __builtin_amdgcn_fence(__ATOMIC_ACQUIRE, "agent"); asm volatile("s_waitcnt vmcnt(0)" ::: "memory"); }
        __syncthreads();
        const float* xf = (const float*)(P->ws + WS_XF); const float* rss = (const float*)(P->ws + WS_RSS); const float* g = P->in[I_GFINAL];
        for (int r = wave; r < nrows; r += 8) {
            const int row = row0 + r;
            const float rs = row_rscale(rss, row);
#pragma unroll
            for (int j = 0; j < 4; ++j) {
                const int c = (lane + 64 * j) * 4;
                const f32x4 v = *(const f32x4*)(xf + (size_t)row * DM + c), gg = *(const f32x4*)(g + c);
                *(f32x4*)(P->out + O_YP + (size_t)row * DM + c) = v * rs * gg;
            }
        }
    }
    __syncthreads();
}

__device__ __forceinline__ void run_phase(PP P, const int ph_in, LAS unsigned char* lds) {
    const int nolo = ph_in >= 100 && ph_in != 199 ? 1 : 0; const int ph = (ph_in >= 100 && ph_in != 199) ? ph_in - 100 : (ph_in == 199 ? 99 : ph_in);
    unsigned char* ws = P->ws;
    bf16* xb = (bf16*)(ws + WS_XB); float* xf = (float*)(ws + WS_XF); float* rss = (float*)(ws + WS_RSS);
    bf16* proj = (bf16*)(ws + WS_PROJ); float* projg = (float*)(ws + WS_PROJG);
    bf16* og = (bf16*)(ws + WS_O); bf16* qb = (bf16*)(ws + WS_Q); bf16* att = (bf16*)(ws + WS_ATT); bf16* hb = (bf16*)(ws + WS_H);
    if (ph == 99) { phase_dump(P); return; }
    if (ph == 0) { phase_prep(P, lds); return; }
    if (ph == N_PHASES - 1) { phase_final(P); return; }
    const int l = (ph - 1) / 9, sub0 = (ph - 1) % 9;
    if (sub0 == 1) { phase_premix(P, l, lds, nolo ? DBG_PM_MASK : 7); return; }
    const int sub = sub0 == 0 ? 0 : sub0 - 1;
    const int G = gridDim.x, bx = blockIdx.x;
    switch (sub) {
    case 0: {
        pg8::Gemm g{xb, (const bf16*)(ws + WS_WIN) + (size_t)l * NPROJ * DM, MT, NPROJ, DM};
        pg8::StaticOrder S; S.init(MT, NPROJ, G, bx);
        EpiScaleBf16 E{proj, NPROJ, rss, 1.0f, projg, 14, nolo};
        pg8::gemm_phase<EpiScaleBf16, pg8::StaticOrder, true, true>(lds, g, S, E);
    } break;
    case 1: {
        const bool hp = (G == 256) && (HP_LEVEL > 0);
        const int otid0 = opaque_tid();
        HlpBarrier hbar; hbar.bar = nullptr; hbar.x = 0; hbar.st = nullptr;
        if (hp && bx >= 128) {
            volatile LAS unsigned* hst = (volatile LAS unsigned*)(lds + LDS_BYTES - 64) + 2;
            if (otid0 == 0) { hst[0] = 0u; hst[1] = 0u; }
            __syncthreads();
            hbar = hlp_barrier_post((unsigned*)(ws + WS_CTL) + (1 + l) * 4096, hst);
        }
        for (int task = bx; task < 256; task += G) {
            __syncthreads();
            if (task < 128) {
                const int b = task >> 4, hh = ((task & 15) + 2 * b) & 15;
#if DBG_VAR
                for (int rep = 0; rep < DBG_REPS; ++rep) {
                if (hh < 6) { if (DBG_TYPES & 1) mixer_chain<0, DBG_VAR>(P, l, b, hh, lds); }
                else if (hh < 12) { if (DBG_TYPES & 2) mixer_chain<1, DBG_VAR>(P, l, b, hh - 6, lds); }
                else { if (DBG_TYPES & 4) mixer_chain<2, DBG_VAR>(P, l, b, hh - 12, lds); }
                __syncthreads(); }
#endif
                if (hh < 6) mixer_chain<0>(P, l, b, hh, lds);
                else if (hh < 12) mixer_chain<1>(P, l, b, hh - 6, lds);
                else mixer_chain<2>(P, l, b, hh - 12, lds);
            } else {
                const int hidx = task - 128;
                if (hidx < 64) {
                    const int lay = l, un = hidx;
                    pg8::Gemm g{(const bf16*)(ws + WS_MEMB), (const bf16*)(ws + WS_WXKV) + (size_t)lay * 2048 * DM, 2048, 2048, DM};
                    ListOrder S{un, un + 1, 1, 8};
                    EpiMemKV E{P->out + O_PMK + (size_t)lay * 2048 * 1024, P->out + O_PMV + (size_t)lay * 2048 * 1024,
                               (bf16*)(ws + WS_MEMK) + (size_t)lay * 2048 * 1024, (bf16*)(ws + WS_MEMVT) + (size_t)lay * 2048 * 1024, (const float*)(ws + WS_RMEM)};
                    pg8::gemm_phase<EpiMemKV, ListOrder, true, true>(lds, g, S, E);
                    __syncthreads();
                }
                const int otid = opaque_tid(); const int lane = otid & 63, wave = __builtin_amdgcn_readfirstlane(otid >> 6);
                {
                    const int nk = (hidx < 64) ? 1 : 3;
                    const int base = (hidx < 64) ? hidx * 8 + wave : 512 + ((hidx - 64) * 8 + wave) * 3;
                    for (int k = 0; k < nk * (1 + DBG_REP_SAMPLE); ++k) {
                        const int wt = base + (k % nk);
                        sample_mixer(P, l, wt >> 4, wt & 15, lds + wave * 10240, lane);
                    }
                }
                if (hp) {
                    hlp_barrier(hbar);
                    { EpiResid E{xb, rss};
                      for (int t = hidx; t < 256; t += 128) small_gemm_tile(og, (const bf16*)(ws + WS_WOUT) + (size_t)l * DM * DM, DM, MP + 64 * (t >> 4), 64 * (t & 15), E, lds); }
                    hlp_barrier(hbar);
                    { EpiScaleBf16 E{qb, DM, rss, 0.0625f, nullptr, -1};
                      for (int t = hidx; t < 256; t += 128) small_gemm_tile(xb, (const bf16*)(ws + WS_WXQ) + (size_t)l * DM * DM, DM, MP + 64 * (t >> 4), 64 * (t & 15), E, lds); }
#if HP_LEVEL >= 4
                    hlp_barrier(hbar);
                    { const float* ck = P->in[I_CK] + (size_t)l * DECB * 256 * 1024; const float* cv = P->in[I_CV] + (size_t)l * DECB * 256 * 1024;
                      for (int t = hidx; t < 256; t += 128) { __syncthreads(); attn_sample_tile(qb, ck, cv, att, t, lds); } }
                    hlp_barrier(hbar);
                    { EpiResid E{xb, rss};
                      for (int t = hidx; t < 256; t += 128) small_gemm_tile(att, (const bf16*)(ws + WS_WXO) + (size_t)l * DM * DM, DM, MP + 64 * (t >> 4), 64 * (t & 15), E, lds); }
#endif
                }
            }
        }
    } break;
    case 2: {
        pg8::Gemm g{og, (const bf16*)(ws + WS_WOUT) + (size_t)l * DM * DM, MP, DM, DM};
        pg8::StaticOrder S; S.init(MP, DM, G, bx);
        EpiResid E{xb, rss};
        if (G == 256) pg8::gemm_phase<EpiResid, pg8::StaticOrder, true, true, true>(lds, g, S, E);
        else { pg8::gemm_phase<EpiResid, pg8::StaticOrder, true, true>(lds, g, S, E);
               for (int t = bx; t < 256; t += G) small_gemm_tile(g.A, g.Bt, DM, MP + 64 * (t >> 4), 64 * (t & 15), E, lds); }
    } break;
    case 3: {
        pg8::Gemm g{xb, (const bf16*)(ws + WS_WXQ) + (size_t)l * DM * DM, MP, DM, DM};
        pg8::StaticOrder S; S.init(MP, DM, G, bx);
        EpiScaleBf16 E{qb, DM, rss, 0.0625f, nullptr, -1};
        if (G == 256) pg8::gemm_phase<EpiScaleBf16, pg8::StaticOrder, true, true, true>(lds, g, S, E);
        else { pg8::gemm_phase<EpiScaleBf16, pg8::StaticOrder, true, true>(lds, g, S, E);
               for (int t = bx; t < 256; t += G) small_gemm_tile(g.A, g.Bt, DM, MP + 64 * (t >> 4), 64 * (t & 15), E, lds); }
    } break;
    case 4: {
        const bf16* memK = (const bf16*)(ws + WS_MEMK) + (size_t)l * 2048 * 1024; const bf16* memVt = (const bf16*)(ws + WS_MEMVT) + (size_t)l * 2048 * 1024;
        const float* ck = P->in[I_CK] + (size_t)l * DECB * 256 * 1024; const float* cv = P->in[I_CV] + (size_t)l * DECB * 256 * 1024;
        if (G == 256 && HP_LEVEL < 4) {
            pg8::Unit u; unit_of_block256(bx, u);
            const int pt0 = (u.pm >> 3) * 64 + u.pn * 16 + 2 * (u.pm & 7), st = 4 * u.pm + u.pn;
            for (int i = 0; i < 3; ++i) {
                const int idx = (bx & 1) ? (i == 2 ? 0 : i + 1) : i;
                __syncthreads();
                if (idx == 0) { attn_sample_tile(qb, ck, cv, att, st, lds); for (int r_ = 0; r_ < DBG_S_REPS; ++r_) { __syncthreads(); attn_sample_tile(qb, ck, cv, att, st, lds); } }
                else { attn_prompt_tile(qb, memK, memVt, att, pt0 + idx - 1, lds); if (DBG_E_REP & 2) { __syncthreads(); attn_prompt_tile(qb, memK, memVt, att, pt0 + idx - 1, lds); } }
            }
        } else
        for (int task = ((G == 256 && HP_LEVEL >= 4) ? 256 + bx : bx); task < 256 + 512; task += G) {
            __syncthreads();
            if (task < 256) attn_sample_tile(qb, ck, cv, att, task, lds);
            else attn_prompt_tile(qb, memK, memVt, att, task - 256, lds);
        }
    } break;
    case 5: {
        pg8::Gemm g{att, (const bf16*)(ws + WS_WXO) + (size_t)l * DM * DM, MP, DM, DM};
        pg8::StaticOrder S; S.init(MP, DM, G, bx);
        EpiResid E{xb, rss};
        if (G == 256) pg8::gemm_phase<EpiResid, pg8::StaticOrder, true, true, true>(lds, g, S, E);
        else { pg8::gemm_phase<EpiResid, pg8::StaticOrder, true, true>(lds, g, S, E);
               for (int t = bx; t < 256; t += G) small_gemm_tile(g.A, g.Bt, DM, MP + 64 * (t >> 4), 64 * (t & 15), E, lds); }
    } break;
    case 6: {
        pg8::Gemm g{xb, (const bf16*)(ws + WS_WGU) + (size_t)l * NGU * DM, MT, NGU, DM};
        pg8::StaticOrder S; S.init(MT, NGU, G, bx);
        EpiGU E{hb, rss, nolo};
        pg8::gemm_phase<EpiGU, pg8::StaticOrder, true, true>(lds, g, S, E);
    } break;
    case 7: {
        pg8::Gemm g{hb, (const bf16*)(ws + WS_WDN) + (size_t)l * DM * DFF, MP, DM, DFF};
        pg8::StaticOrder S; S.init(MP, DM, G, bx);
        if (l == DEPTH - 1 && G == 256) {
            unsigned* fcnt = (unsigned*)(ws + WS_CTL) + 16384;
            EpiResidFinal E{xb, rss, fcnt, P->in[I_GFINAL], P->out + O_YP, ((volatile LAS unsigned*)(lds + LDS_BYTES - 64))[14] == 2u ? 1 : 0};
            pg8::gemm_phase<EpiResidFinal, pg8::StaticOrder, true, true, true>(lds, g, S, E);
        } else {
            EpiResid E{xb, rss};
            if (G == 256) pg8::gemm_phase<EpiResid, pg8::StaticOrder, true, true, true>(lds, g, S, E);
            else { pg8::gemm_phase<EpiResid, pg8::StaticOrder, true, true>(lds, g, S, E);
                   for (int t = bx; t < 256; t += G) small_gemm_tile(g.A, g.Bt, DFF, MP + 64 * (t >> 4), 64 * (t & 15), E, lds); }
        }
    } break;
    }
}

__device__ __forceinline__ void group_meet(PP P, const unsigned seq, LAS unsigned char* lds) {
    pg8::Unit u; unit_of_block256(blockIdx.x, u);
    unsigned* ctl = (unsigned*)(P->ws + WS_CTL);
    volatile LAS unsigned* gf = (volatile LAS unsigned*)(lds + LDS_BYTES - 64) + 14;
    unsigned f = gf[0];
    if (f == 0u) {
        __syncthreads();
        if (threadIdx.x == 0) { const unsigned mk = xb_ld(ctl + 31744 + u.pm); gf[0] = (mk != 0u && (mk & (mk - 1u)) == 0u) ? 2u : 3u; }
        __syncthreads();
        f = gf[0];
    }
    panel_meet(ctl + 25600 + 64 * u.pm, 4u * seq, f == 2u);
}

__global__ void __launch_bounds__(NTHREADS, 2) k_run(Params Pval) {
    PP P = get_params();
    extern __shared__ __attribute__((aligned(16))) unsigned char lds_raw[];
    LAS unsigned char* lds = (LAS unsigned char*)lds_raw;
    const int lo = P->ph_lo, hi = P->ph_hi;
#if USE_CG_SYNC
    cg::grid_group grid = cg::this_grid();
#define SEAM() grid.sync()
#else
    volatile LAS unsigned* bst = (volatile LAS unsigned*)(lds + LDS_BYTES - 64);
    if (threadIdx.x < 16) bst[threadIdx.x] = 0u;
    __syncthreads();
    XcdBarrier bar = xcd_barrier_post((unsigned*)(P->ws + WS_CTL), bst);
    if (threadIdx.x == 0 && gridDim.x == 256) { pg8::Unit u0; unit_of_block256(blockIdx.x, u0);
        (void)__hip_atomic_fetch_or((unsigned*)(P->ws + WS_CTL) + 31744 + u0.pm, 1u << xb_xcc_id(), __ATOMIC_RELAXED, __HIP_MEMORY_SCOPE_AGENT); }
#define SEAM() xcd_barrier(bar)
#endif
#ifndef REP_MASK
#define REP_MASK 0
#endif
#define GROUP_SEAM(k) ((k) == 4 ? 1 : (k) == 5 ? 2 : (k) == 6 ? 3 : (k) == 13 ? 4 : (k) == 14 ? 5 : (k) == 15 ? 6 : 0)
#define REPEAT(k) (((k) == 0 && (REP_MASK & 256)) || ((k) == 4 && (REP_MASK & 512)) || ((k) >= 1 && (k) <= 18 && rep_sub(((k) - 1) % 9)))
#ifndef DBG_PREFIX_K
#define DBG_PREFIX_K (-1)
#endif
#define N_PRE_MEETS ((4 < DBG_PREFIX_K) + (5 < DBG_PREFIX_K) + (6 < DBG_PREFIX_K) + (13 < DBG_PREFIX_K) + (14 < DBG_PREFIX_K) + (15 < DBG_PREFIX_K))
#define PREPASS(k) if ((k) <= DBG_PREFIX_K) { run_phase(get_params(), (k), lds); \
    if (((k) == 3 || (k) == 12) && gridDim.x == 256) { __syncthreads(); deferred_items(get_params(), (k) == 12 ? 1 : 0, lds, 1, 0); deferred_items(get_params(), (k) == 12 ? 1 : 0, lds, 1, 1); } \
    if (GROUP_SEAM(k) && gridDim.x == 256 && (k) < DBG_PREFIX_K) group_meet(get_params(), GROUP_SEAM(k), lds); else SEAM(); }
#define PHASE(k) if (lo <= (k) && (k) < hi) { if (REPEAT(k)) { run_phase(get_params(), (k) + (DBG_NOLO ? 100 : 0), lds); SEAM(); } \
    if (((k) == 3 || ((k) == 12 && DEFER_L1)) && gridDim.x == 256 && DEFER_ON && DEFER_SPLIT && blockIdx.x >= 128) { deferred_items(get_params(), (k) == 12 ? 1 : 0, lds, 0, 0); __syncthreads(); } \
    run_phase(get_params(), (k), lds); \
    if (((k) == 3 || ((k) == 12 && DEFER_L1)) && gridDim.x == 256 && DEFER_ON && !(blockIdx.x < 128 && (((blockIdx.x & 15) + 2 * (blockIdx.x >> 4)) & 15) >= 12)) { __syncthreads(); deferred_items(get_params(), (k) == 12 ? 1 : 0, lds, 0, 1); }         \
    if ((k) + 1 < hi) { if (GROUP_SEAM(k) && gridDim.x == 256) group_meet(get_params(), GROUP_SEAM(k) + N_PRE_MEETS, lds); else SEAM(); } }
#if DBG_PREFIX_K >= 0
    PREPASS(0) PREPASS(1) PREPASS(2) PREPASS(3) PREPASS(4) PREPASS(5) PREPASS(6) PREPASS(7) PREPASS(8) PREPASS(9) PREPASS(10) PREPASS(11) PREPASS(12) PREPASS(13) PREPASS(14) PREPASS(15) PREPASS(16) PREPASS(17)
#endif
    PHASE(0) PHASE(1) PHASE(2) PHASE(3) PHASE(4) PHASE(5) PHASE(6) PHASE(7) PHASE(8) PHASE(9) PHASE(10) PHASE(11) PHASE(12) PHASE(13) PHASE(14) PHASE(15) PHASE(16) PHASE(17) PHASE(18) PHASE(19)
#if DBG_EXTRA_BARS
    for (int i_ = 0; i_ < DBG_EXTRA_BARS; ++i_) SEAM();
#endif
#undef PHASE
#undef SEAM
    if (lo == 99) run_phase(get_params(), 199, lds);
}

#ifndef ONE_LAUNCH
#define ONE_LAUNCH 1
#endif

extern "C" void kernel_launch(void* const* d_in, const int* in_sizes, int n_in, void* d_out, int out_size, void* d_ws, size_t ws_size, hipStream_t stream) {
    static int grid = 0;
    if (grid == 0) {
        if (n_in != N_IN || (size_t)out_size != O_END || ws_size < WS_END) { fprintf(stderr, "kernel_launch: unexpected shapes n_in %d out %d ws %zu\n", n_in, out_size, ws_size); grid = -1; return; }
        int dev = 0, cus = 0, per_cu = 0;
        if (hipGetDevice(&dev) != hipSuccess || hipDeviceGetAttribute(&cus, hipDeviceAttributeMultiprocessorCount, dev) != hipSuccess) { grid = -1; return; }
        if (hipFuncSetAttribute((const void*)k_run, hipFuncAttributeMaxDynamicSharedMemorySize, LDS_BYTES) != hipSuccess) { fprintf(stderr, "kernel_launch: hipFuncSetAttribute failed\n"); grid = -1; return; }
        if (hipOccupancyMaxActiveBlocksPerMultiprocessor(&per_cu, (const void*)k_run, NTHREADS, LDS_BYTES) != hipSuccess || per_cu < 1) { fprintf(stderr, "kernel_launch: occupancy query says %d\n", per_cu); (void)hipGetLastError(); grid = -1; return; }
        grid = cus;
    }
    if (grid < 0) return;
    if (hipMemsetAsync((char*)d_ws + WS_CTL, 0, 131072, stream) != hipSuccess) { fprintf(stderr, "kernel_launch: memset failed\n"); return; }
    Params p{};
    for (int i = 0; i < N_IN; ++i) p.in[i] = (const float*)d_in[i];
    p.out = (float*)d_out; p.ws = (unsigned char*)d_ws;
#if ONE_LAUNCH
    p.ph_lo = 0; p.ph_hi = (grid == 256) ? N_PHASES - 1 : N_PHASES;
    void* args[] = {&p};
    hipError_t e = hipLaunchCooperativeKernel((const void*)k_run, dim3(grid), dim3(NTHREADS), args, LDS_BYTES, stream);
    if (e != hipSuccess) fprintf(stderr, "cooperative launch failed: %s (grid %d)\n", hipGetErrorString(e), grid);
#else
    for (int ph = 0; ph < (DBG_STOP ? DBG_STOP + 2 : N_PHASES); ++ph) {
        p.ph_lo = ph; p.ph_hi = ph + 1;
        if (DBG_STOP && ph == DBG_STOP + 1) { p.ph_lo = 99; p.ph_hi = 100; }
        hipLaunchKernelGGL(k_run, dim3(grid), dim3(NTHREADS), LDS_BYTES, stream, p);
    }
#endif
}
```

```cpp
#include <hip/hip_runtime.h>
#include <hip/hip_cooperative_groups.h>
#include <cstdio>
#include <cstdint>
namespace cg = cooperative_groups;
__device__ __forceinline__ int opaque_tid() { int t = threadIdx.x; asm volatile("" : "+v"(t)); return t; }
#define DBG_CHAIN 0
#define REP_MASK 0
#define DBG_REP_SAMPLE 0
#define DBG_DUP 0
#define DBG_VAR 0
#define DBG_TYPES 7
#define DBG_REPS 1
#define DBG_NOLO 0
#define DBG_EXTRA_BARS 0
#define DBG_UNIT_REPS 1
#ifndef DBG_SMALL_MODE
#define DBG_SMALL_MODE 0
#endif

namespace pg8 {
#define PG8_LAS __attribute__((address_space(3)))
typedef unsigned short bf16_t;
typedef short bf16x8 __attribute__((ext_vector_type(8)));
typedef float f32x4 __attribute__((ext_vector_type(4)));
typedef unsigned u32x4 __attribute__((ext_vector_type(4)));
constexpr int BM = 256, BK = 64, HALF = 128, HTB = HALF * BK * 2  , STAGE_BYTES = 8 * HTB, NXCD = 8, WGM = 8;

__host__ __device__ __forceinline__ int lds_byte(int r, int c) { const int st = (r >> 4) * 2 + (c >> 5), rr = r & 15, cc = c & 31, ob = rr * 64 + cc * 2; return st * 1024 + (ob ^ (((ob >> 9) & 1) << 5)); }
__host__ __device__ __forceinline__ void stage_rc(int b, int& R, int& C) { const int st = b / 1024, sb = b % 1024, swz = sb ^ (((sb >> 9) & 1) << 5); R = (st >> 1) * 16 + swz / 64; C = (st & 1) * 32 + (swz % 64) / 2; }
__host__ __device__ __forceinline__ int perm32(int rho) { const int n = rho >> 4, i = rho & 15; return 8 * (i >> 2) + 4 * n + (i & 3); }

struct Unit { int pm, pn; };
struct Gemm { const bf16_t* A; const bf16_t* Bt; int M, N, K; };

struct StaticOrder {
    int nM, nN, nwg, G, c;
    __host__ __device__ void init(int M, int N, int G_, int c_) { nM = M / BM; nN = N / BM; nwg = nM * nN; G = G_; c = c_; }
    __host__ __device__ bool next(int i, Unit& u) const {
        const long L = (long)i * G + c; if (L >= nwg) return false;
        int wgid = (int)L; { const int q = nwg / NXCD, r = nwg % NXCD, xcd = wgid % NXCD, off = wgid / NXCD; wgid = (xcd < r ? xcd * (q + 1) : r * (q + 1) + (xcd - r) * q) + off; }
        const int nig = WGM * nN, gid = wgid / nig, fm = gid * WGM, gsz = (nM - fm) < WGM ? (nM - fm) : WGM;
        u.pm = fm + ((wgid % nig) % gsz); u.pn = (wgid % nig) / gsz; return true;
    }
    __device__ __forceinline__ void a_ready(const Unit&) const {}
    __device__ __forceinline__ void done(const Unit&) const {}
};
template <class Epi, class Sched, bool ALIGN_EPI = false, bool SP2 = false, bool SROWS = false>
__device__ __forceinline__ void gemm_phase(PG8_LAS unsigned char* lds, const Gemm g, const Sched& S, const Epi& E) {
    const int tid = opaque_tid(), wid = __builtin_amdgcn_readfirstlane(tid >> 6), lane = tid & 63, wr = wid >> 2, wc = wid & 3, fr = lane & 15, fq = lane >> 4;
    const int K = g.K, nt = K / BK;
    unsigned voffA[2], voffB[2];
#pragma unroll
    for (int i = 0; i < 2; ++i) { int R, C; stage_rc(tid * 16 + i * 8192, R, C); const int Rb = Epi::PERM ? ((R & ~31) + perm32(R & 31)) : R;
        voffA[i] = (unsigned)(R * K + C) * 2u; voffB[i] = (unsigned)(Rb * K + C) * 2u; }
    const size_t kstep = (size_t)(BK * 2);
    const size_t hstep = (size_t)HALF * K * 2;
    const size_t tstep = 2 * hstep;
    const unsigned ldsw = (unsigned)wid * 1024u;
    const int aoff = lds_byte(wr * 64 + fr, fq * 8), boff = lds_byte(wc * 32 + fr, fq * 8);
#define PG8_SA(b, h) (((b) * 2 + (h)) * HTB)
#define PG8_SB(b, h) ((4 + (b) * 2 + (h)) * HTB)
#define PG8_STAGE(bufoff, gbase, voff) do { _Pragma("unroll") for (int _i = 0; _i < 2; ++_i) \
        __builtin_amdgcn_global_load_lds((const unsigned*)((const char*)(gbase) + (voff)[_i]), (PG8_LAS unsigned*)(lds + (bufoff) + ldsw + _i * 8192), 16, 0, 0); } while (0)
#define PG8_LDA(dst, b, h) do { _Pragma("unroll") for (int m = 0; m < 4; ++m) _Pragma("unroll") for (int k = 0; k < 2; ++k) dst[m][k] = *(const PG8_LAS bf16x8*)(lds + PG8_SA(b, h) + aoff + m * 2048 + k * 1024); } while (0)
#define PG8_LDB(dst, b, h) do { _Pragma("unroll") for (int n = 0; n < 2; ++n) _Pragma("unroll") for (int k = 0; k < 2; ++k) dst[n][k] = *(const PG8_LAS bf16x8*)(lds + PG8_SB(b, h) + boff + n * 2048 + k * 1024); } while (0)
#define PG8_MMA(ai, bj, At, Bt) do { __builtin_amdgcn_s_setprio(1); _Pragma("unroll") for (int m = 0; m < 4; ++m) _Pragma("unroll") for (int n = 0; n < 2; ++n) _Pragma("unroll") for (int k = 0; k < 2; ++k) \
        acc[ai][bj][m][n] = __builtin_amdgcn_mfma_f32_16x16x32_bf16(Bt[n][k], At[m][k], acc[ai][bj][m][n], 0, 0, 0); __builtin_amdgcn_s_setprio(0); } while (0)
#define PG8_WAIT_V(n) asm volatile("s_waitcnt vmcnt(" #n ")" ::: "memory")
#define PG8_WAIT_L(n) asm volatile("s_waitcnt lgkmcnt(" #n ")" ::: "memory")
#define PG8_BAR __builtin_amdgcn_s_barrier()
#define PG8_SCHED __builtin_amdgcn_sched_barrier(0)
    Unit cur, nxt; int ui = 0;
    if (!S.next(0, cur)) return;
    f32x4 acc[2][2][4][2];
#pragma unroll
    for (int a = 0; a < 2; ++a)
#pragma unroll
        for (int b = 0; b < 2; ++b)
#pragma unroll
            for (int m = 0; m < 4; ++m)
#pragma unroll
                for (int n = 0; n < 2; ++n) acc[a][b][m][n] = (f32x4){0.f, 0.f, 0.f, 0.f};
    bf16x8 At[4][2], B0[2][2], B1[2][2];
    f32x4 accS[2]; bf16x8 AsS[2]; const char* sA = (const char*)g.A; unsigned voffS = 0u;
    accS[0] = (f32x4){0.f, 0.f, 0.f, 0.f}; accS[1] = (f32x4){0.f, 0.f, 0.f, 0.f};
    AsS[0] = (bf16x8){0, 0, 0, 0, 0, 0, 0, 0}; AsS[1] = AsS[0];
#define PG8_SLOAD(tn) do { const char* pt_ = sA + (size_t)(tn) * 128; \
        asm volatile("global_load_dwordx4 %0, %1, %2" : "+v"(AsS[0]) : "v"(voffS), "s"(pt_) : "memory"); \
        asm volatile("global_load_dwordx4 %0, %1, %2 offset:64" : "+v"(AsS[1]) : "v"(voffS), "s"(pt_) : "memory"); } while (0)
#define PG8_SFENCE() do { if constexpr (SROWS) asm volatile("" : "+v"(AsS[0]), "+v"(AsS[1])); } while (0)
    if constexpr (SROWS) {
        static_assert(SP2, "SROWS needs the SP2 loop");
        sA = (const char*)g.A + (size_t)(g.M + 16 * cur.pm) * K * 2; voffS = (unsigned)(fr * K + fq * 8) * 2u;
        PG8_SLOAD(0);
    }
#define PG8_SMMA(tn) do { if constexpr (SROWS) { __builtin_amdgcn_s_setprio(1); \
        if (wr == 0) { _Pragma("unroll") for (int n = 0; n < 2; ++n) _Pragma("unroll") for (int k = 0; k < 2; ++k) accS[n] = __builtin_amdgcn_mfma_f32_16x16x32_bf16(B0[n][k], AsS[k], accS[n], 0, 0, 0); } \
        else         { _Pragma("unroll") for (int n = 0; n < 2; ++n) _Pragma("unroll") for (int k = 0; k < 2; ++k) accS[n] = __builtin_amdgcn_mfma_f32_16x16x32_bf16(B1[n][k], AsS[k], accS[n], 0, 0, 0); } \
        __builtin_amdgcn_s_setprio(0); \
        if ((tn) < nt) PG8_SLOAD(tn); } } while (0)
#define PG8_WAIT_V2(tn) do { if constexpr (SROWS) { if ((tn) < nt) PG8_WAIT_V(10); else PG8_WAIT_V(8); } else PG8_WAIT_V(8); } while (0)
    const char* cA = (const char*)g.A + (size_t)cur.pm * tstep; const char* cB = (const char*)g.Bt + (size_t)cur.pn * tstep;
    S.a_ready(cur);
    if constexpr (SP2) {
        PG8_STAGE(PG8_SB(0, 0), cB, voffB); PG8_STAGE(PG8_SB(0, 1), cB + hstep, voffB); PG8_STAGE(PG8_SA(0, 0), cA, voffA); PG8_STAGE(PG8_SA(0, 1), cA + hstep, voffA);
        if (wr == 1) PG8_BAR;
        PG8_WAIT_V(2); PG8_BAR;
        PG8_STAGE(PG8_SB(1, 0), cB + kstep, voffB); PG8_STAGE(PG8_SA(1, 0), cA + kstep, voffA); PG8_STAGE(PG8_SB(1, 1), cB + hstep + kstep, voffB);
        PG8_WAIT_V(6); PG8_BAR;
    } else {
        PG8_STAGE(PG8_SB(0, 0), cB, voffB); PG8_STAGE(PG8_SA(0, 0), cA, voffA); PG8_STAGE(PG8_SB(0, 1), cB + hstep, voffB); PG8_STAGE(PG8_SA(0, 1), cA + hstep, voffA);
        if (wr == 1) PG8_BAR;
        PG8_WAIT_V(4); PG8_BAR;
        PG8_STAGE(PG8_SB(1, 0), cB + kstep, voffB); PG8_STAGE(PG8_SA(1, 0), cA + kstep, voffA); PG8_STAGE(PG8_SB(1, 1), cB + hstep + kstep, voffB);
        PG8_WAIT_V(6); PG8_BAR;
    }
    for (;;) {
        const bool has_next = S.next(ui + 1, nxt);
        const char* nA = has_next ? (const char*)g.A + (size_t)nxt.pm * tstep : cA; const char* nB = has_next ? (const char*)g.Bt + (size_t)nxt.pn * tstep : cB;
        for (int t = 0; t < nt; t += 2) {
            const bool last = (t == nt - 2);
            const char* a1 = cA + (size_t)(t + 1) * kstep;
            const char* a2 = last ? nA : cA + (size_t)(t + 2) * kstep; const char* b2 = last ? nB : cB + (size_t)(t + 2) * kstep;
            const char* a3 = a2 + kstep; const char* b3 = b2 + kstep;
            if (last && has_next) S.a_ready(nxt);
            if constexpr (SP2) {
            PG8_LDB(B0, 0, 0); PG8_LDB(B1, 0, 1); PG8_SCHED; PG8_LDA(At, 0, 0); PG8_STAGE(PG8_SA(1, 1), a1 + hstep, voffA);
            PG8_WAIT_V(8); PG8_WAIT_L(0); PG8_BAR; PG8_SFENCE(); PG8_MMA(0, 0, At, B0); PG8_MMA(0, 1, At, B1); PG8_SMMA(t + 1); PG8_BAR; PG8_SCHED;
            PG8_LDA(At, 0, 1); PG8_STAGE(PG8_SB(0, 0), b2, voffB); PG8_STAGE(PG8_SB(0, 1), b2 + hstep, voffB); PG8_STAGE(PG8_SA(0, 0), a2, voffA);
            PG8_WAIT_V2(t + 1); PG8_WAIT_L(0); PG8_BAR; PG8_MMA(1, 0, At, B0); PG8_MMA(1, 1, At, B1); PG8_BAR; PG8_SCHED;
            PG8_LDB(B0, 1, 0); PG8_LDB(B1, 1, 1); PG8_SCHED; PG8_LDA(At, 1, 0); PG8_STAGE(PG8_SA(0, 1), a2 + hstep, voffA);
            PG8_WAIT_V(8); PG8_WAIT_L(0); PG8_BAR; PG8_SFENCE(); PG8_MMA(0, 0, At, B0); PG8_MMA(0, 1, At, B1); PG8_SMMA(t + 2); PG8_BAR; PG8_SCHED;
            PG8_LDA(At, 1, 1); PG8_STAGE(PG8_SB(1, 0), b3, voffB); PG8_STAGE(PG8_SB(1, 1), b3 + hstep, voffB); PG8_STAGE(PG8_SA(1, 0), a3, voffA);
            PG8_WAIT_V2(t + 2); PG8_WAIT_L(0); PG8_BAR; PG8_MMA(1, 0, At, B0); PG8_MMA(1, 1, At, B1); PG8_BAR; PG8_SCHED;
            } else {
            PG8_LDB(B0, 0, 0); PG8_SCHED; PG8_LDA(At, 0, 0); PG8_STAGE(PG8_SA(1, 1), a1 + hstep, voffA);
            PG8_WAIT_L(8); PG8_BAR; PG8_WAIT_L(0); PG8_MMA(0, 0, At, B0); PG8_BAR; PG8_SCHED;
            PG8_LDB(B1, 0, 1); PG8_STAGE(PG8_SB(0, 0), b2, voffB);
            PG8_BAR; PG8_WAIT_L(0); PG8_MMA(0, 1, At, B1); PG8_BAR;
            PG8_LDA(At, 0, 1); PG8_STAGE(PG8_SA(0, 0), a2, voffA);
            PG8_BAR; PG8_WAIT_L(0); PG8_MMA(1, 0, At, B0); PG8_BAR; PG8_SCHED;
            PG8_STAGE(PG8_SB(0, 1), b2 + hstep, voffB);
            PG8_WAIT_V(6); PG8_BAR; PG8_MMA(1, 1, At, B1); PG8_BAR;
            PG8_LDB(B0, 1, 0); PG8_SCHED; PG8_LDA(At, 1, 0); PG8_STAGE(PG8_SA(0, 1), a2 + hstep, voffA);
            PG8_WAIT_L(8); PG8_BAR; PG8_WAIT_L(0); PG8_MMA(0, 0, At, B0); PG8_BAR; PG8_SCHED;
            PG8_LDB(B1, 1, 1); PG8_STAGE(PG8_SB(1, 0), b3, voffB);
            PG8_BAR; PG8_WAIT_L(0); PG8_MMA(0, 1, At, B1); PG8_BAR;
            PG8_LDA(At, 1, 1); PG8_STAGE(PG8_SA(1, 0), a3, voffA);
            PG8_BAR; PG8_WAIT_L(0); PG8_MMA(1, 0, At, B0); PG8_BAR; PG8_SCHED;
            PG8_STAGE(PG8_SB(1, 1), b3 + hstep, voffB);
            PG8_WAIT_V(6); PG8_BAR; PG8_MMA(1, 1, At, B1); PG8_BAR;
            }
        }
        if constexpr (ALIGN_EPI) { if (wr == 0) PG8_BAR; }
        if constexpr (!Epi::AFTER_DRAIN) { E(acc, cur, wr, wc, fr, fq); S.done(cur); }
        if (!has_next) break;
#pragma unroll
        for (int a = 0; a < 2; ++a)
#pragma unroll
            for (int b = 0; b < 2; ++b)
#pragma unroll
                for (int m = 0; m < 4; ++m)
#pragma unroll
                    for (int n = 0; n < 2; ++n) acc[a][b][m][n] = (f32x4){0.f, 0.f, 0.f, 0.f};
        cur = nxt; cA = nA; cB = nB; ++ui;
        if constexpr (ALIGN_EPI) { if (wr == 1) PG8_BAR; }
    }
    PG8_WAIT_V(0);
    if constexpr (!ALIGN_EPI) { if (wr == 0) PG8_BAR; }
    PG8_BAR;
    if constexpr (Epi::AFTER_DRAIN) { E.fused(acc, accS, SROWS, cur, wr, wc, fr, fq, lds, wid, lane); S.done(cur); }
    else if constexpr (SROWS) E.sample16(accS, cur, wr, wc, fr, fq, lds, wid);
#undef PG8_SMMA
#undef PG8_SLOAD
#undef PG8_SFENCE
#undef PG8_WAIT_V2
#undef PG8_SA
#undef PG8_SB
#undef PG8_STAGE
#undef PG8_LDA
#undef PG8_LDB
#undef PG8_MMA
#undef PG8_WAIT_V
#undef PG8_WAIT_L
#undef PG8_BAR
#undef PG8_SCHED
}
}
#define LAS __attribute__((address_space(3)))
typedef unsigned short bf16;
typedef short bf16x8 __attribute__((ext_vector_type(8)));
typedef float f32x4 __attribute__((ext_vector_type(4)));
typedef unsigned u32x4 __attribute__((ext_vector_type(4)));
typedef unsigned u32x2 __attribute__((ext_vector_type(2)));

constexpr int DM = 1024, NB = 8, SEQ = 2048, DEPTH = 2, DECB = 128, DECT = 8;
constexpr int MP = NB * SEQ, MS = DECB * DECT, MT = MP + MS;
constexpr int NPROJ = 3840;
constexpr int DFF = 2816, NGU = 2 * DFF;
constexpr int NMEM = 256, XH = 4, XHD = 256;
constexpr float EPS = 1e-6f;
constexpr int C_QR = 0, C_KR = 384, C_VR = 768, C_GR = 1152, C_QG = 1536, C_KG = 1728, C_VG = 1920, C_RG = 2304;
constexpr int C_QKM = 2688, C_VM = 3200, C_OM = 3456, C_GATES = 3712;
enum { I_XP = 0, I_XS, I_SRET, I_SGLA, I_SC, I_SN, I_SM, I_SCONV, I_CK, I_CV, I_MEMP, I_GMIX, I_WIN, I_WGA2, I_BGA, I_CONVW, I_CONVB, I_BI, I_BF,
       I_GRET, I_GGLA, I_GMLSTM, I_WOUT, I_GXATTN, I_GMEM, I_WXQ, I_WXK, I_WXV, I_WXO, I_GFFN, I_WGATE, I_WUP, I_WDOWN, I_GFINAL, N_IN };
constexpr size_t O_YP = 0, O_YS = O_YP + (size_t)MP * DM, O_PRET = O_YS + (size_t)MS * DM, O_PGLA = O_PRET + 2 * 8 * 6 * 64 * 64,
                 O_PC = O_PGLA + 2 * 8 * 6 * 32 * 64, O_PN = O_PC + 2 * 8 * 4 * 64 * 64, O_PM = O_PN + 2 * 8 * 4 * 64, O_PCONV = O_PM + 2 * 8 * 4,
                 O_PMK = O_PCONV + 2 * 8 * 3 * 512, O_PMV = O_PMK + (size_t)2 * 8 * 256 * 1024, O_SRET = O_PMV + (size_t)2 * 8 * 256 * 1024,
                 O_SGLA = O_SRET + (size_t)2 * 128 * 6 * 64 * 64, O_SC = O_SGLA + (size_t)2 * 128 * 6 * 32 * 64, O_SN = O_SC + (size_t)2 * 128 * 4 * 64 * 64,
                 O_SM = O_SN + 2 * 128 * 4 * 64, O_SCONV = O_SM + 2 * 128 * 4, O_END = O_SCONV + 2 * 128 * 3 * 512;
constexpr size_t MiB = 1u << 20;
constexpr size_t WS_CTL = 0, CTL_BYTES = 1 * MiB;
constexpr size_t WS_WIN = 1 * MiB, WS_WOUT = 16 * MiB, WS_WXQ = 20 * MiB, WS_WXO = 24 * MiB, WS_WXKV = 28 * MiB, WS_WGU = 36 * MiB, WS_WDN = 58 * MiB;
constexpr size_t WS_ROPE = 69 * MiB, WS_RSS = 70 * MiB, WS_RMEM = 72 * MiB, WS_MEMB = 73 * MiB, WS_MEMK = 77 * MiB, WS_MEMVT = 85 * MiB, WS_PROJG = 93 * MiB;
constexpr size_t WS_XB = 96 * MiB, WS_XF = 130 * MiB, WS_PROJ = 198 * MiB, WS_O = 326 * MiB, WS_Q = 360 * MiB, WS_ATT = 394 * MiB, WS_H = 428 * MiB;
constexpr size_t WS_QKC = 522 * MiB, WS_GM = 538 * MiB, WS_CM = 539 * MiB, WS_GQ = 540 * MiB, WS_GK = 546 * MiB, WS_GKT = 552 * MiB, WS_GBL = 558 * MiB, WS_END = 559 * MiB;
static_assert(WS_WIN + (size_t)2 * NPROJ * DM * 2 <= WS_WOUT && WS_WGU + (size_t)2 * NGU * DM * 2 <= WS_WDN && WS_WDN + (size_t)2 * DM * DFF * 2 <= WS_ROPE, "ws map");
static_assert(WS_XB + (size_t)MT * DM * 2 <= WS_XF && WS_XF + (size_t)MT * DM * 4 <= WS_PROJ && WS_PROJ + (size_t)MT * NPROJ * 2 <= WS_O && WS_H + (size_t)MT * DFF * 2 <= WS_QKC, "ws map 2");
constexpr int LDS_BYTES = 147456;
constexpr int NTHREADS = 512;

struct Params { const float* in[N_IN]; float* out; unsigned char* ws; int ph_lo, ph_hi; };
typedef const __attribute__((address_space(4))) Params* PP;
__device__ __forceinline__ PP get_params() { PP p = (PP)__builtin_amdgcn_kernarg_segment_ptr(); asm volatile("" : "+s"(p)); return p; }

__device__ __forceinline__ float bf2f(unsigned short b) { return __uint_as_float(((unsigned)b) << 16); }
typedef __bf16 bf16x2_t __attribute__((ext_vector_type(2)));
__device__ __forceinline__ unsigned pk2(float lo, float hi) { bf16x2_t v = {(__bf16)lo, (__bf16)hi}; return __builtin_bit_cast(unsigned, v); }
__device__ __forceinline__ unsigned short f2bf(float f) { return __builtin_bit_cast(unsigned short, (__bf16)f); }
__device__ __forceinline__ float wave_sum(float v) {
#pragma unroll
    for (int o = 1; o < 64; o <<= 1) v += __shfl_xor(v, o);
    return v;
}
template <int CTRL, int ROW_MASK>
__device__ __forceinline__ float dpp_f(float oldv, float src) {
    return __builtin_bit_cast(float, __builtin_amdgcn_update_dpp(__builtin_bit_cast(int, oldv), __builtin_bit_cast(int, src), CTRL, ROW_MASK, 0xf, false));
}
__device__ __forceinline__ float scan_sum(float v, int lane) {
    (void)lane;
    v += dpp_f<0x111, 0xf>(0.f, v); v += dpp_f<0x112, 0xf>(0.f, v); v += dpp_f<0x114, 0xf>(0.f, v); v += dpp_f<0x118, 0xf>(0.f, v);
    v += dpp_f<0x142, 0xa>(0.f, v); v += dpp_f<0x143, 0xc>(0.f, v);
    return v;
}
__device__ __forceinline__ float scan_max(float v, int lane) {
    (void)lane;
    const float ninf = -3.0e38f;
    v = fmaxf(v, dpp_f<0x111, 0xf>(ninf, v)); v = fmaxf(v, dpp_f<0x112, 0xf>(ninf, v)); v = fmaxf(v, dpp_f<0x114, 0xf>(ninf, v)); v = fmaxf(v, dpp_f<0x118, 0xf>(ninf, v));
    v = fmaxf(v, dpp_f<0x142, 0xa>(ninf, v)); v = fmaxf(v, dpp_f<0x143, 0xc>(ninf, v));
    return v;
}
__device__ __forceinline__ float log_sigmoid(float x) { return fminf(x, 0.f) - log1pf(expf(-fabsf(x))); }
__device__ __forceinline__ float sigmoidf(float x) { return 1.f / (1.f + expf(-x)); }
__device__ __forceinline__ float siluf(float x) { return x / (1.f + expf(-x)); }
__device__ __forceinline__ f32x4 mma16(bf16x8 x, bf16x8 y, f32x4 c) { return __builtin_amdgcn_mfma_f32_16x16x32_bf16(x, y, c, 0, 0, 0); }
__device__ __forceinline__ bf16x8 lfrag(const LAS unsigned char* base, int row, int ld, int k) { return *(const LAS bf16x8*)(base + ((size_t)row * ld + k) * 2); }
#define XB_TMO      128
#define XB_XCNT(j)  (256  + 64 * (j))
#define XB_XSUB(j)  (1280 + 64 * (j))
#define XB_XGEN(j)  (2304 + 64 * (j))
#define XB_TOP      3328
#define XB_TOPGEN   3392
#define XCD_BAR_WORDS 3456
#define XB_SPIN_CAP (1u << 18)

__device__ __forceinline__ unsigned xb_ld(unsigned* p)              { return __hip_atomic_load(p, __ATOMIC_RELAXED, __HIP_MEMORY_SCOPE_AGENT); }
__device__ __forceinline__ unsigned xb_add(unsigned* p, unsigned v) { return __hip_atomic_fetch_add(p, v, __ATOMIC_RELAXED, __HIP_MEMORY_SCOPE_AGENT); }
__device__ __forceinline__ unsigned xb_xcc_id() { return (unsigned)__builtin_amdgcn_s_getreg((3 << 11) | 20) & 0xFu; }
#define XB_SPIN(cond, bar) do { unsigned _sp = 0; while (cond) { __builtin_amdgcn_s_sleep(1); \
    if ((++_sp & 255u) == 0u) { if (xb_ld(&(bar)[XB_TMO])) break; if (_sp > XB_SPIN_CAP) { atomicAdd(&(bar)[XB_TMO], 1u); break; } } } } while (0)

struct XcdBarrier {
    unsigned* bar; unsigned x;
    volatile LAS unsigned* st;
};

__device__ __forceinline__ XcdBarrier xcd_barrier_post(unsigned* bar, volatile LAS unsigned* st) {
    XcdBarrier b; b.bar = bar; b.x = xb_xcc_id(); b.st = st;
    if (threadIdx.x == 0) (void)xb_add(&bar[XB_XCNT(b.x)], 1u);
    return b;
}
__device__ __forceinline__ void xcd_barrier_complete(unsigned* bar, unsigned x, unsigned& nloc, unsigned& nx) {
    const unsigned G = gridDim.x * gridDim.y * gridDim.z;
    unsigned sum, cnt, mine, sp = 0u;
    for (;;) {
        sum = 0u; cnt = 0u; mine = 0u;
#pragma unroll
        for (unsigned j = 0; j < 16; ++j) { const unsigned c = xb_ld(&bar[XB_XCNT(j)]); sum += c; cnt += (c > 0u) ? 1u : 0u; mine = (j == x) ? c : mine; }
        if (sum == G) break;
        __builtin_amdgcn_s_sleep(1);
        if ((++sp & 255u) == 0u) { if (xb_ld(&bar[XB_TMO])) break; if (sp > XB_SPIN_CAP) { atomicAdd(&bar[XB_TMO], 1u); break; } }
    }
    nloc = mine > 0u ? mine : 1u; nx = cnt > 0u ? cnt : 1u;
}

__device__ __forceinline__ void xcd_barrier(const XcdBarrier& b) {
    asm volatile("s_waitcnt vmcnt(0)" ::: "memory");
    __syncthreads();
    if (threadIdx.x == 0) {
        unsigned* bar = b.bar;
        __builtin_amdgcn_s_waitcnt(0);
        unsigned nloc = b.st[0], nx = b.st[1];
        if (nloc == 0u) { xcd_barrier_complete(bar, b.x, nloc, nx); b.st[0] = nloc; b.st[1] = nx; }
        const unsigned old = xb_add(&bar[XB_XSUB(b.x)], 1u);
        const unsigned gen = old / nloc;
        if (old + 1u == (gen + 1u) * nloc) {
            __builtin_amdgcn_fence(__ATOMIC_RELEASE, "agent");
            asm volatile("s_waitcnt vmcnt(0)" ::: "memory");
            const unsigned og = xb_add(&bar[XB_TOP], 1u);
            const unsigned tg = og / nx;
            if (og + 1u == (tg + 1u) * nx) xb_add(&bar[XB_TOPGEN], 1u);
            else XB_SPIN(xb_ld(&bar[XB_TOPGEN]) == tg, bar);
            __builtin_amdgcn_fence(__ATOMIC_ACQUIRE, "agent");
            xb_add(&bar[XB_XGEN(b.x)], 1u);
            asm volatile("s_waitcnt vmcnt(0)" ::: "memory");
        } else {
            XB_SPIN(xb_ld(&bar[XB_XGEN(b.x)]) == gen, bar);
            __builtin_amdgcn_fence(__ATOMIC_ACQUIRE, "agent");
            asm volatile("s_waitcnt vmcnt(0)" ::: "memory");
        }
    }
    __syncthreads();
}
#define HLP_PARTS 128u
#define HB_SPIN_CAP (1u << 18)

__device__ __forceinline__ unsigned hb_ld(unsigned* p)              { return __hip_atomic_load(p, __ATOMIC_RELAXED, __HIP_MEMORY_SCOPE_AGENT); }
__device__ __forceinline__ unsigned hb_add(unsigned* p, unsigned v) { return __hip_atomic_fetch_add(p, v, __ATOMIC_RELAXED, __HIP_MEMORY_SCOPE_AGENT); }
__device__ __forceinline__ unsigned hb_xcc_id() { return (unsigned)__builtin_amdgcn_s_getreg((3 << 11) | 20) & 0xFu; }
#define HB_SPIN(cond, bar) do { unsigned _sp = 0; while (cond) { __builtin_amdgcn_s_sleep(1); \
    if ((++_sp & 255u) == 0u) { if (hb_ld(&(bar)[XB_TMO])) break; if (_sp > HB_SPIN_CAP) { atomicAdd(&(bar)[XB_TMO], 1u); break; } } } } while (0)

struct HlpBarrier {
    unsigned* bar; unsigned x;
    volatile LAS unsigned* st;
};

__device__ __forceinline__ HlpBarrier hlp_barrier_post(unsigned* bar, volatile LAS unsigned* st) {
    HlpBarrier b; b.bar = bar; b.x = hb_xcc_id(); b.st = st;
    if (threadIdx.x == 0) (void)hb_add(&bar[XB_XCNT(b.x)], 1u);
    return b;
}
__device__ __forceinline__ void hlp_barrier_complete(unsigned* bar, unsigned x, unsigned& nloc, unsigned& nx) {
    const unsigned G = HLP_PARTS;
    unsigned sum, cnt, mine, sp = 0u;
    for (;;) {
        sum = 0u; cnt = 0u; mine = 0u;
#pragma unroll
        for (unsigned j = 0; j < 16; ++j) { const unsigned c = hb_ld(&bar[XB_XCNT(j)]); sum += c; cnt += (c > 0u) ? 1u : 0u; mine = (j == x) ? c : mine; }
        if (sum == G) break;
        __builtin_amdgcn_s_sleep(1);
        if ((++sp & 255u) == 0u) { if (hb_ld(&bar[XB_TMO])) break; if (sp > HB_SPIN_CAP) { atomicAdd(&bar[XB_TMO], 1u); break; } }
    }
    nloc = mine > 0u ? mine : 1u; nx = cnt > 0u ? cnt : 1u;
}

__device__ __forceinline__ void hlp_barrier(const HlpBarrier& b) {
    asm volatile("s_waitcnt vmcnt(0)" ::: "memory");
    __syncthreads();
    if (threadIdx.x == 0) {
        unsigned* bar = b.bar;
        __builtin_amdgcn_s_waitcnt(0);
        unsigned nloc = b.st[0], nx = b.st[1];
        if (nloc == 0u) { hlp_barrier_complete(bar, b.x, nloc, nx); b.st[0] = nloc; b.st[1] = nx; }
        const unsigned old = hb_add(&bar[XB_XSUB(b.x)], 1u);
        const unsigned gen = old / nloc;
        if (old + 1u == (gen + 1u) * nloc) {
            __builtin_amdgcn_fence(__ATOMIC_RELEASE, "agent");
            asm volatile("s_waitcnt vmcnt(0)" ::: "memory");
            const unsigned og = hb_add(&bar[XB_TOP], 1u);
            const unsigned tg = og / nx;
            if (og + 1u == (tg + 1u) * nx) hb_add(&bar[XB_TOPGEN], 1u);
            else HB_SPIN(hb_ld(&bar[XB_TOPGEN]) == tg, bar);
            __builtin_amdgcn_fence(__ATOMIC_ACQUIRE, "agent");
            hb_add(&bar[XB_XGEN(b.x)], 1u);
            asm volatile("s_waitcnt vmcnt(0)" ::: "memory");
        } else {
            HB_SPIN(hb_ld(&bar[XB_XGEN(b.x)]) == gen, bar);
            __builtin_amdgcn_fence(__ATOMIC_ACQUIRE, "agent");
            asm volatile("s_waitcnt vmcnt(0)" ::: "memory");
        }
    }
    __syncthreads();
}
struct SmallPre { f32x4 v[4]; };
__device__ __forceinline__ float row_rscale(const float* rss, int row) {
    const f32x4* p = (const f32x4*)(rss + (size_t)row * 16);
    const f32x4 a = p[0], b = p[1], c = p[2], d = p[3];
    const float s = (((a.x + a.y) + (a.z + a.w)) + ((b.x + b.y) + (b.z + b.w))) + (((c.x + c.y) + (c.z + c.w)) + ((d.x + d.y) + (d.z + d.w)));
    return rsqrtf(s * (1.0f / 1024.0f) + EPS);
}
__device__ __forceinline__ void rows_rscale8(const float* rss, int row0, int fq, float (&r)[2][4]) {
    f32x4 p[2][4];
#pragma unroll
    for (int ai = 0; ai < 2; ++ai)
#pragma unroll
        for (int m = 0; m < 4; ++m) p[ai][m] = *(const f32x4*)(rss + (size_t)(row0 + ai * 128 + m * 16) * 16 + 4 * fq);
#pragma unroll
    for (int ai = 0; ai < 2; ++ai)
#pragma unroll
        for (int m = 0; m < 4; ++m) {
            float s = (p[ai][m][0] + p[ai][m][1]) + (p[ai][m][2] + p[ai][m][3]);
            s += __shfl_xor(s, 16); s += __shfl_xor(s, 32);
            r[ai][m] = rsqrtf(s * (1.0f / 1024.0f) + EPS);
        }
}
struct ListOrder {
    int first, end, stride, nN;
    __device__ __forceinline__ bool next(int i, pg8::Unit& u) const { const int idx = first + i * stride; if (idx >= end) return false; u.pm = idx / nN; u.pn = idx % nN; return true; }
    __device__ __forceinline__ void a_ready(const pg8::Unit&) const {}
    __device__ __forceinline__ void done(const pg8::Unit&) const {}
};
template <int REPS> struct RepeatOrder {
    pg8::StaticOrder S;
    __device__ __forceinline__ bool next(int i, pg8::Unit& u) const { return S.next(i / REPS, u); }
    __device__ __forceinline__ void a_ready(const pg8::Unit&) const {}
    __device__ __forceinline__ void done(const pg8::Unit&) const {}
};
struct EpiScaleBf16 {
    static constexpr bool PERM = true, AFTER_DRAIN = false;
    bf16* O; int ldc; const float* rss; float mul; float* projg; int gate_pn; int nolo = 0;
    __device__ __forceinline__ void operator()(const f32x4 (&acc)[2][2][4][2], const pg8::Unit& u, int wr, int wc, int fr, int fq) const {
        const int row0 = u.pm * 256 + wr * 64 + fr, col0 = u.pn * 256 + wc * 32 + 8 * fq;
        const bool gates = (u.pn == gate_pn) && (wc == 0);
        float rr[2][4];
        if (nolo) {
#pragma unroll
            for (int a = 0; a < 2; ++a)
#pragma unroll
                for (int b = 0; b < 4; ++b) rr[a][b] = 1.f; }
        else rows_rscale8(rss, row0, fq, rr);
#pragma unroll
        for (int ai = 0; ai < 2; ++ai)
#pragma unroll
            for (int m = 0; m < 4; ++m) {
                const int row = row0 + ai * 128 + m * 16;
                const float r = rr[ai][m] * mul;
                bf16* rowp = O + (size_t)row * ldc + col0;
#pragma unroll
                for (int bj = 0; bj < 2; ++bj) {
                    const f32x4 v0 = acc[ai][bj][m][0] * r, v1 = acc[ai][bj][m][1] * r;
                    u32x4 w; w.x = pk2(v0[0], v0[1]); w.y = pk2(v0[2], v0[3]); w.z = pk2(v1[0], v1[1]); w.w = pk2(v1[2], v1[3]);
                    *(u32x4*)(rowp + bj * 128) = w;
                    if (bj == 1 && gates) { float* gp = projg + (size_t)row * 32 + 8 * fq; *(f32x4*)gp = v0; *(f32x4*)(gp + 4) = v1; }
                }
            }
    }
    __device__ __forceinline__ void sample16(const f32x4 (&accS)[2], const pg8::Unit& u, int wr, int wc, int fr, int fq, LAS unsigned char*, int) const {
        const int row = MP + 16 * u.pm + fr, col0 = u.pn * 256 + wr * 128 + wc * 32 + 8 * fq;
        const f32x4 p = *(const f32x4*)(rss + (size_t)row * 16 + 4 * fq);
        float s = (p[0] + p[1]) + (p[2] + p[3]);
        s += __shfl_xor(s, 16); s += __shfl_xor(s, 32);
        const float r = rsqrtf(s * (1.0f / 1024.0f) + EPS) * mul;
        const f32x4 v0 = accS[0] * r, v1 = accS[1] * r;
        u32x4 w; w.x = pk2(v0[0], v0[1]); w.y = pk2(v0[2], v0[3]); w.z = pk2(v1[0], v1[1]); w.w = pk2(v1[2], v1[3]);
        *(u32x4*)(O + (size_t)row * ldc + col0) = w;
    }
    __device__ __forceinline__ void small_load(SmallPre& pre, int row, int, int) const {
        const f32x4* p = (const f32x4*)(rss + (size_t)row * 16);
#pragma unroll
        for (int i = 0; i < 4; ++i) pre.v[i] = p[i];
    }
    __device__ __forceinline__ void small(const f32x4 (&acc)[4], const SmallPre& pre, int row, int n0, int l4) const {
        const f32x4 a = pre.v[0], b = pre.v[1], c = pre.v[2], d = pre.v[3];
        const float s = (((a.x + a.y) + (a.z + a.w)) + ((b.x + b.y) + (b.z + b.w))) + (((c.x + c.y) + (c.z + c.w)) + ((d.x + d.y) + (d.z + d.w)));
        const float r = rsqrtf(s * (1.0f / 1024.0f) + EPS) * mul;
#pragma unroll
        for (int t = 0; t < 4; ++t) { const f32x4 v = acc[t] * r; u32x2 w; w.x = pk2(v[0], v[1]); w.y = pk2(v[2], v[3]); *(u32x2*)(O + (size_t)row * ldc + n0 + 16 * t + 4 * l4) = w; }
    }
};
__device__ __forceinline__ f32x4 bf4_to_f32(const u32x2 w) { return (f32x4){__uint_as_float(w.x << 16), __uint_as_float(w.x & 0xffff0000u), __uint_as_float(w.y << 16), __uint_as_float(w.y & 0xffff0000u)}; }
struct EpiResid {
    static constexpr bool PERM = true, AFTER_DRAIN = false;
    bf16* xb; float* rss;
    __device__ __forceinline__ void operator()(const f32x4 (&acc)[2][2][4][2], const pg8::Unit& u, int wr, int wc, int fr, int fq) const {
        const int row0 = u.pm * 256 + wr * 64 + fr, col0 = u.pn * 256 + wc * 32 + 8 * fq;
#pragma unroll
        for (int ai = 0; ai < 2; ++ai) {
            u32x4 bv[4][2];
#pragma unroll
            for (int m = 0; m < 4; ++m) {
                const bf16* bp = xb + (size_t)(row0 + ai * 128 + m * 16) * DM + col0;
#pragma unroll
                for (int bj = 0; bj < 2; ++bj) bv[m][bj] = *(const u32x4*)(bp + bj * 128);
            }
            asm volatile("" ::: "memory");
#pragma unroll
            for (int m = 0; m < 4; ++m) {
                const int row = row0 + ai * 128 + m * 16;
                bf16* bbp = xb + (size_t)row * DM + col0;
                float ss = 0.f;
#pragma unroll
                for (int bj = 0; bj < 2; ++bj) {
                    u32x2 lo; lo.x = bv[m][bj].x; lo.y = bv[m][bj].y; u32x2 hi; hi.x = bv[m][bj].z; hi.y = bv[m][bj].w;
                    const f32x4 v0 = bf4_to_f32(lo) + acc[ai][bj][m][0], v1 = bf4_to_f32(hi) + acc[ai][bj][m][1];
                    u32x4 w; w.x = pk2(v0[0], v0[1]); w.y = pk2(v0[2], v0[3]); w.z = pk2(v1[0], v1[1]); w.w = pk2(v1[2], v1[3]);
                    *(u32x4*)(bbp + bj * 128) = w;
                    ss += ((v0[0] * v0[0] + v0[1] * v0[1]) + (v0[2] * v0[2] + v0[3] * v0[3])) + ((v1[0] * v1[0] + v1[1] * v1[1]) + (v1[2] * v1[2] + v1[3] * v1[3]));
                }
                ss += __shfl_xor(ss, 16); ss += __shfl_xor(ss, 32);
                if (fq == 0) rss[(size_t)row * 16 + u.pn * 4 + wc] = ss;
            }
            asm volatile("" ::: "memory");
        }
    }
    __device__ __forceinline__ void sample16(const f32x4 (&accS)[2], const pg8::Unit& u, int wr, int wc, int fr, int fq, LAS unsigned char* lds, int wid) const {
        const int row = MP + 16 * u.pm + fr, col0 = u.pn * 256 + wr * 128 + wc * 32 + 8 * fq;
        bf16* bbp = xb + (size_t)row * DM + col0;
        const u32x4 bw = *(const u32x4*)bbp;
        u32x2 lo; lo.x = bw.x; lo.y = bw.y; u32x2 hi; hi.x = bw.z; hi.y = bw.w;
        const f32x4 v0 = bf4_to_f32(lo) + accS[0], v1 = bf4_to_f32(hi) + accS[1];
        { u32x4 w; w.x = pk2(v0[0], v0[1]); w.y = pk2(v0[2], v0[3]); w.z = pk2(v1[0], v1[1]); w.w = pk2(v1[2], v1[3]); *(u32x4*)bbp = w; }
        float ss = ((v0[0] * v0[0] + v0[1] * v0[1]) + (v0[2] * v0[2] + v0[3] * v0[3])) + ((v1[0] * v1[0] + v1[1] * v1[1]) + (v1[2] * v1[2] + v1[3] * v1[3]));
        ss += __shfl_xor(ss, 16); ss += __shfl_xor(ss, 32);
        LAS float* sred = (LAS float*)lds;
        if (fq == 0) sred[wid * 16 + fr] = ss;
        __syncthreads();
        if (wr == 0 && fq == 0) rss[(size_t)row * 16 + u.pn * 4 + wc] = ss + sred[(4 + wc) * 16 + fr];
    }
    __device__ __forceinline__ void small_load(SmallPre& pre, int row, int n0, int l4) const {
        const bf16* bp = xb + (size_t)row * DM + n0 + 4 * l4;
#pragma unroll
        for (int t = 0; t < 4; ++t) pre.v[t] = bf4_to_f32(*(const u32x2*)(bp + 16 * t));
    }
    __device__ __forceinline__ void small(const f32x4 (&acc)[4], const SmallPre& pre, int row, int n0, int l4) const {
        float ss = 0.f;
#pragma unroll
        for (int t = 0; t < 4; ++t) {
            const f32x4 v = pre.v[t] + acc[t];
            u32x2 w; w.x = pk2(v[0], v[1]); w.y = pk2(v[2], v[3]); *(u32x2*)(xb + (size_t)row * DM + n0 + 16 * t + 4 * l4) = w;
            ss += (v[0] * v[0] + v[1] * v[1]) + (v[2] * v[2] + v[3] * v[3]);
        }
        ss += __shfl_xor(ss, 16); ss += __shfl_xor(ss, 32);
        if (l4 == 0) rss[(size_t)row * 16 + (n0 >> 6)] = ss;
    }
};
__device__ __forceinline__ void panel_meet(unsigned* cnt, const unsigned need, const bool same_l2 = false) {
    asm volatile("s_waitcnt vmcnt(0)" ::: "memory");
    __syncthreads();
    if (threadIdx.x == 0) {
        if (!same_l2) __builtin_amdgcn_fence(__ATOMIC_RELEASE, "agent");
        asm volatile("s_waitcnt vmcnt(0)" ::: "memory");
        (void)xb_add(cnt, 1u);
        unsigned sp = 0u;
        while (xb_ld(cnt) < need) { __builtin_amdgcn_s_sleep(1); if (++sp > (1u << 21)) break; }
        __builtin_amdgcn_fence(__ATOMIC_ACQUIRE, "agent");
        asm volatile("s_waitcnt vmcnt(0)" ::: "memory");
    }
    __syncthreads();
}
struct EpiResidFinal {
    static constexpr bool PERM = true, AFTER_DRAIN = true;
    const bf16* xb; float* rss; unsigned* cnt; const float* gfin; float* y; int same_l2 = 0;
    __device__ __forceinline__ void fused(f32x4 (&acc)[2][2][4][2], f32x4 (&accS)[2], const bool srows, const pg8::Unit& u, int wr, int wc, int fr, int fq, LAS unsigned char* lds, int wid, int) const {
        const int row0 = u.pm * 256 + wr * 64 + fr, col0 = u.pn * 256 + wc * 32 + 8 * fq;
        const int srow = MP + 16 * u.pm + fr, scol0 = u.pn * 256 + wr * 128 + wc * 32 + 8 * fq;
        if (srows) {
            const u32x4 bw = *(const u32x4*)(xb + (size_t)srow * DM + scol0);
            u32x2 lo; lo.x = bw.x; lo.y = bw.y; u32x2 hi; hi.x = bw.z; hi.y = bw.w;
            const f32x4 v0 = bf4_to_f32(lo) + accS[0], v1 = bf4_to_f32(hi) + accS[1];
            accS[0] = v0; accS[1] = v1;
            float ss = ((v0[0] * v0[0] + v0[1] * v0[1]) + (v0[2] * v0[2] + v0[3] * v0[3])) + ((v1[0] * v1[0] + v1[1] * v1[1]) + (v1[2] * v1[2] + v1[3] * v1[3]));
            ss += __shfl_xor(ss, 16); ss += __shfl_xor(ss, 32);
            LAS float* sred = (LAS float*)lds;
            if (fq == 0) sred[wid * 16 + fr] = ss;
            __syncthreads();
            if (wr == 0 && fq == 0) rss[(size_t)srow * 16 + u.pn * 4 + wc] = ss + sred[(4 + wc) * 16 + fr];
        }
#pragma unroll
        for (int ai = 0; ai < 2; ++ai) {
            u32x4 bv[4][2];
#pragma unroll
            for (int m = 0; m < 4; ++m) {
                const bf16* bp = xb + (size_t)(row0 + ai * 128 + m * 16) * DM + col0;
#pragma unroll
                for (int bj = 0; bj < 2; ++bj) bv[m][bj] = *(const u32x4*)(bp + bj * 128);
            }
            asm volatile("" ::: "memory");
#pragma unroll
            for (int m = 0; m < 4; ++m) {
                const int row = row0 + ai * 128 + m * 16;
                float ss = 0.f;
#pragma unroll
                for (int bj = 0; bj < 2; ++bj) {
                    u32x2 lo; lo.x = bv[m][bj].x; lo.y = bv[m][bj].y; u32x2 hi; hi.x = bv[m][bj].z; hi.y = bv[m][bj].w;
                    const f32x4 v0 = bf4_to_f32(lo) + acc[ai][bj][m][0], v1 = bf4_to_f32(hi) + acc[ai][bj][m][1];
                    acc[ai][bj][m][0] = v0; acc[ai][bj][m][1] = v1;
                    ss += ((v0[0] * v0[0] + v0[1] * v0[1]) + (v0[2] * v0[2] + v0[3] * v0[3])) + ((v1[0] * v1[0] + v1[1] * v1[1]) + (v1[2] * v1[2] + v1[3] * v1[3]));
                }
                ss += __shfl_xor(ss, 16); ss += __shfl_xor(ss, 32);
                if (fq == 0) rss[(size_t)row * 16 + u.pn * 4 + wc] = ss;
            }
            asm volatile("" ::: "memory");
        }
        panel_meet(cnt + 64 * u.pm, 4u, same_l2 != 0);
        float rr[2][4];
        rows_rscale8(rss, row0, fq, rr);
        f32x4 gg[2][2];
#pragma unroll
        for (int bj = 0; bj < 2; ++bj)
#pragma unroll
            for (int n = 0; n < 2; ++n) gg[bj][n] = *(const f32x4*)(gfin + col0 + bj * 128 + n * 4);
#pragma unroll
        for (int ai = 0; ai < 2; ++ai)
#pragma unroll
            for (int m = 0; m < 4; ++m) {
                float* yp = y + (size_t)(row0 + ai * 128 + m * 16) * DM + col0;
                const float r = rr[ai][m];
#pragma unroll
                for (int bj = 0; bj < 2; ++bj)
#pragma unroll
                    for (int n = 0; n < 2; ++n) *(f32x4*)(yp + bj * 128 + n * 4) = acc[ai][bj][m][n] * r * gg[bj][n];
            }
        if (srows) {
            const f32x4 p = *(const f32x4*)(rss + (size_t)srow * 16 + 4 * fq);
            float s = (p[0] + p[1]) + (p[2] + p[3]);
            s += __shfl_xor(s, 16); s += __shfl_xor(s, 32);
            const float r = rsqrtf(s * (1.0f / 1024.0f) + EPS);
            float* yp = y + (size_t)srow * DM + scol0;
            *(f32x4*)yp = accS[0] * r * *(const f32x4*)(gfin + scol0); *(f32x4*)(yp + 4) = accS[1] * r * *(const f32x4*)(gfin + scol0 + 4);
        }
    }
    __device__ __forceinline__ void small_load(SmallPre& pre, int row, int n0, int l4) const {
        const bf16* bp = xb + (size_t)row * DM + n0 + 4 * l4;
#pragma unroll
        for (int t = 0; t < 4; ++t) pre.v[t] = bf4_to_f32(*(const u32x2*)(bp + 16 * t));
    }
    __device__ __forceinline__ void small_pre(f32x4 (&acc)[4], const SmallPre& pre, int row, int n0, int l4) const {
        float ss = 0.f;
#pragma unroll
        for (int t = 0; t < 4; ++t) { const f32x4 v = pre.v[t] + acc[t]; acc[t] = v; ss += (v[0] * v[0] + v[1] * v[1]) + (v[2] * v[2] + v[3] * v[3]); }
        ss += __shfl_xor(ss, 16); ss += __shfl_xor(ss, 32);
        if (l4 == 0) rss[(size_t)row * 16 + (n0 >> 6)] = ss;
    }
    __device__ __forceinline__ void small_meet(int m0) const { panel_meet(cnt + 64 * (68 + ((m0 - MP) >> 6)), 16u); }
    __device__ __forceinline__ void small_post(const f32x4 (&acc)[4], int row, int n0, int l4) const {
        const float r = row_rscale(rss, row);
#pragma unroll
        for (int t = 0; t < 4; ++t) { const f32x4 gg = *(const f32x4*)(gfin + n0 + 16 * t + 4 * l4); *(f32x4*)(y + (size_t)row * DM + n0 + 16 * t + 4 * l4) = acc[t] * r * gg; }
    }
};
struct EpiGU {
    static constexpr bool PERM = true, AFTER_DRAIN = false;
    bf16* H; const float* rss; int nolo = 0;
    __device__ __forceinline__ void operator()(const f32x4 (&acc)[2][2][4][2], const pg8::Unit& u, int wr, int wc, int fr, int fq) const {
        const int row0 = u.pm * 256 + wr * 64 + fr, col0 = u.pn * 128 + wc * 32 + 8 * fq;
        float rr[2][4];
        if (nolo) {
#pragma unroll
            for (int a = 0; a < 2; ++a)
#pragma unroll
                for (int b = 0; b < 4; ++b) rr[a][b] = 1.f; }
        else rows_rscale8(rss, row0, fq, rr);
#pragma unroll
        for (int ai = 0; ai < 2; ++ai)
#pragma unroll
            for (int m = 0; m < 4; ++m) {
                const int row = row0 + ai * 128 + m * 16;
                const float r = rr[ai][m];
                float hv[8];
#pragma unroll
                for (int n = 0; n < 2; ++n)
#pragma unroll
                    for (int j = 0; j < 4; ++j) { const float g = acc[ai][0][m][n][j] * r, up = acc[ai][1][m][n][j] * r; hv[n * 4 + j] = g * __builtin_amdgcn_rcpf(1.f + __expf(-g)) * up; }
                u32x4 w; w.x = pk2(hv[0], hv[1]); w.y = pk2(hv[2], hv[3]); w.z = pk2(hv[4], hv[5]); w.w = pk2(hv[6], hv[7]);
                *(u32x4*)(H + (size_t)row * DFF + col0) = w;
            }
    }
};
struct EpiMemKV {
    static constexpr bool PERM = false, AFTER_DRAIN = false;
    float* outk; float* outv; bf16* memK; bf16* memVt; const float* rmem;
    __device__ __forceinline__ void operator()(const f32x4 (&acc)[2][2][4][2], const pg8::Unit& u, int wr, int wc, int fr, int fq) const {
        const int row0 = u.pm * 256 + wr * 64 + fr, col0 = u.pn * 256 + wc * 32 + 4 * fq;
#pragma unroll
        for (int ai = 0; ai < 2; ++ai)
#pragma unroll
            for (int m = 0; m < 4; ++m) {
                const int row = row0 + ai * 128 + m * 16;
                const float r = rmem[row];
#pragma unroll
                for (int bj = 0; bj < 2; ++bj)
#pragma unroll
                    for (int n = 0; n < 2; ++n) {
                        const int c = col0 + bj * 128 + n * 16;
                        const f32x4 v = acc[ai][bj][m][n] * r;
                        if (u.pn < 4) {
                            *(f32x4*)(outk + (size_t)row * 1024 + c) = v;
                            u32x2 w; w.x = pk2(v[0], v[1]); w.y = pk2(v[2], v[3]);
                            *(u32x2*)(memK + (size_t)row * 1024 + c) = w;
                        } else {
                            const int cc = c - 1024;
                            *(f32x4*)(outv + (size_t)row * 1024 + cc) = v;
                            const int b = row >> 8, mm = row & 255, hh = cc >> 8, d = cc & 255;
                            bf16* tp = memVt + (((size_t)b * 4 + hh) * 256 + d) * 256 + mm;
                            tp[0] = f2bf(v[0]); tp[256] = f2bf(v[1]); tp[512] = f2bf(v[2]); tp[768] = f2bf(v[3]);
                        }
                    }
            }
    }
};

template <class Epi>
__device__ __forceinline__ void small_gemm_tile(const bf16* __restrict__ A, const bf16* __restrict__ Bt, const int K, const int m0, const int n0, const Epi& E, LAS unsigned char* lds, const int dbg_mode = 0) {
    const int tid = opaque_tid(), lane = tid & 63, w = __builtin_amdgcn_readfirstlane(tid >> 6), l15 = lane & 15, l4 = lane >> 4;
    const int klen = K >> 3;
    const bf16* ap = A + (size_t)(m0 + l15) * K + w * klen + 8 * l4;
    const bf16* bp = Bt + (size_t)(n0 + l15) * K + w * klen + 8 * l4;
    const int erow = m0 + 16 * (w & 3) + l15;
    SmallPre pre;
#pragma unroll
    for (int i = 0; i < 4; ++i) pre.v[i] = (f32x4){0.f, 0.f, 0.f, 0.f};
    if (w < 4) E.small_load(pre, erow, n0, l4);
    f32x4 acc[4][4];
#pragma unroll
    for (int r = 0; r < 4; ++r)
#pragma unroll
        for (int t = 0; t < 4; ++t) acc[r][t] = (f32x4){0.f, 0.f, 0.f, 0.f};
    const int nsteps = klen >> 5;
    for (int s0 = 0; s0 < nsteps; s0 += 4) {
        bf16x8 ya[4][4], xb[4][4];
#pragma unroll
        for (int s = 0; s < 4; ++s) {
            const int k = (s0 + s < nsteps ? s0 + s : nsteps - 1) * 32;
#pragma unroll
            for (int r = 0; r < 4; ++r) ya[s][r] = *(const bf16x8*)(ap + (size_t)r * 16 * K + k);
#pragma unroll
            for (int t = 0; t < 4; ++t) xb[s][t] = *(const bf16x8*)(bp + (size_t)t * 16 * K + k);
        }
        __builtin_amdgcn_sched_barrier(0);
#pragma unroll
        for (int s = 0; s < 4; ++s) if (s0 + s < nsteps) {
#pragma unroll
            for (int r = 0; r < 4; ++r)
#pragma unroll
                for (int t = 0; t < 4; ++t) acc[r][t] = mma16(xb[s][t], ya[s][r], acc[r][t]);
        }
    }
    LAS f32x4* red = (LAS f32x4*)lds;
#if DBG_SMALL_MODE
    if (dbg_mode == 1) { red[tid] = acc[0][0] + acc[1][1] + acc[2][2] + acc[3][3] + pre.v[0]; __syncthreads(); return; }
#endif
#pragma unroll
    for (int r = 0; r < 4; ++r)
#pragma unroll
        for (int t = 0; t < 4; ++t) red[((w * 4 + r) * 4 + t) * 64 + lane] = acc[r][t];
    __syncthreads();
    f32x4 o[4];
    if (w < 4) {
#pragma unroll
        for (int t = 0; t < 4; ++t) {
            f32x4 a = red[((0 * 4 + w) * 4 + t) * 64 + lane] + red[((1 * 4 + w) * 4 + t) * 64 + lane];
            f32x4 b = red[((2 * 4 + w) * 4 + t) * 64 + lane] + red[((3 * 4 + w) * 4 + t) * 64 + lane];
            f32x4 c = red[((4 * 4 + w) * 4 + t) * 64 + lane] + red[((5 * 4 + w) * 4 + t) * 64 + lane];
            f32x4 d = red[((6 * 4 + w) * 4 + t) * 64 + lane] + red[((7 * 4 + w) * 4 + t) * 64 + lane];
            o[t] = (a + b) + (c + d);
        }
    }
    if constexpr (Epi::AFTER_DRAIN) {
        if (w < 4) E.small_pre(o, pre, erow, n0, l4);
        E.small_meet(m0);
        if (w < 4) E.small_post(o, erow, n0, l4);
    } else {
        if (w < 4) E.small(o, pre, erow, n0, l4);
    }
    __syncthreads();
}
struct TItem { const float* W; const float* gain; bf16* WT; int ldw, k0, src0, ncols, K, dst0; };
__device__ __forceinline__ TItem decode_item(PP P, unsigned char* ws, const int it) {
    constexpr int IT_IN = 118 * 16, IT_SQ = 32 * 16, IT_FF = 88 * 16;
    constexpr int IT_LAYER = IT_IN + 5 * IT_SQ + 3 * IT_FF;
    TItem t; t.gain = nullptr; t.ncols = 32;
    const int l = it / IT_LAYER; int r = it % IT_LAYER;
    if (r < IT_IN) {
        const int kb = r / 118, g = r % 118;
        if (g < 84) { t.src0 = 32 * g; t.dst0 = 32 * g; }
        else if (g < 116) { t.src0 = 2704 + 32 * (g - 84); t.dst0 = 2688 + 32 * (g - 84); }
        else if (g == 116) { t.src0 = 2688; t.dst0 = 3712; t.ncols = 16; }
        else { t.src0 = 3728; t.dst0 = 3728; t.ncols = 8; }
        t.W = P->in[I_WIN] + (size_t)l * DM * 3736; t.ldw = 3736; t.gain = P->in[I_GMIX] + l * DM; t.k0 = kb * 64; t.WT = (bf16*)(ws + WS_WIN) + (size_t)l * NPROJ * DM; t.K = DM;
        return t;
    }
    r -= IT_IN;
    if (r < 5 * IT_SQ) {
        const int which = r / IT_SQ, rr = r % IT_SQ, kb = rr / 32, g = rr % 32;
        t.dst0 = 32 * g; t.src0 = 32 * g; t.ldw = DM; t.k0 = kb * 64; t.K = DM;
        if (which == 0) { t.W = P->in[I_WOUT]; t.WT = (bf16*)(ws + WS_WOUT) + (size_t)l * DM * DM; }
        else if (which == 1) { t.W = P->in[I_WXQ]; t.gain = P->in[I_GXATTN] + l * DM; t.WT = (bf16*)(ws + WS_WXQ) + (size_t)l * DM * DM; }
        else if (which == 2) { t.W = P->in[I_WXO]; t.WT = (bf16*)(ws + WS_WXO) + (size_t)l * DM * DM; }
        else if (which == 3) { t.W = P->in[I_WXK]; t.gain = P->in[I_GMEM] + l * DM; t.WT = (bf16*)(ws + WS_WXKV) + (size_t)l * 2048 * DM; }
        else { t.W = P->in[I_WXV]; t.gain = P->in[I_GMEM] + l * DM; t.WT = (bf16*)(ws + WS_WXKV) + (size_t)l * 2048 * DM; t.dst0 += 1024; }
        t.W += (size_t)l * DM * DM;
        return t;
    }
    r -= 5 * IT_SQ;
    if (r < 2 * IT_FF) {
        const int which = r / IT_FF, rr = r % IT_FF, kb = rr / 88, g = rr % 88;
        t.src0 = 32 * g; t.dst0 = (t.src0 >> 7) * 256 + (t.src0 & 127) + which * 128;
        t.W = P->in[which ? I_WUP : I_WGATE] + (size_t)l * DM * DFF; t.ldw = DFF; t.gain = P->in[I_GFFN] + l * DM; t.k0 = kb * 64; t.WT = (bf16*)(ws + WS_WGU) + (size_t)l * NGU * DM; t.K = DM;
        return t;
    }
    r -= 2 * IT_FF;
    { const int kb = r / 32, g = r % 32;
      t.W = P->in[I_WDOWN] + (size_t)l * DFF * DM; t.ldw = DM; t.k0 = kb * 64; t.src0 = 32 * g; t.dst0 = 32 * g; t.WT = (bf16*)(ws + WS_WDN) + (size_t)l * DM * DFF; t.K = DFF; }
    return t;
}
__device__ __forceinline__ void item_load(const TItem& t, const int lane, f32x4 (&v)[8], float (&g)[8]) {
    const int c4 = 4 * (lane & 7), rr = lane >> 3;
#pragma unroll
    for (int i = 0; i < 8; ++i) {
        const int kk = rr + 8 * i;
        if (c4 < t.ncols) v[i] = *(const f32x4*)(t.W + (size_t)(t.k0 + kk) * t.ldw + t.src0 + c4); else v[i] = (f32x4){0.f, 0.f, 0.f, 0.f};
        g[i] = t.gain ? t.gain[t.k0 + kk] : 1.0f;
    }
}
__device__ __forceinline__ void item_finish(const TItem& t, const int lane, const f32x4 (&v)[8], const float (&g)[8], LAS float* scr) {
    const int c4 = 4 * (lane & 7), rr = lane >> 3;
#pragma unroll
    for (int i = 0; i < 8; ++i) {
        const int kk = rr + 8 * i;
        const f32x4 x = v[i] * g[i];
        scr[kk * 33 + c4] = x[0]; scr[kk * 33 + c4 + 1] = x[1]; scr[kk * 33 + c4 + 2] = x[2]; scr[kk * 33 + c4 + 3] = x[3];
    }
    asm volatile("s_waitcnt lgkmcnt(0)" ::: "memory");
    const int c8 = lane & 7;
#pragma unroll
    for (int j = 0; j < 4; ++j) {
        const int n = (lane >> 3) + 8 * j;
        const LAS float* s = scr + (8 * c8) * 33 + n;
        u32x4 o; o.x = pk2(s[0 * 33], s[1 * 33]); o.y = pk2(s[2 * 33], s[3 * 33]); o.z = pk2(s[4 * 33], s[5 * 33]); o.w = pk2(s[6 * 33], s[7 * 33]);
        if (n < t.ncols) *(u32x4*)(t.WT + (size_t)(t.dst0 + n) * t.K + t.k0 + 8 * c8) = o;
    }
    asm volatile("s_waitcnt lgkmcnt(0)" ::: "memory");
}
#ifndef DEFER_ON
#define DEFER_ON 1
#endif
constexpr int ITM_IN = 118 * 16, ITM_SQ = 32 * 16, ITM_FF = 88 * 16, ITM_LAYER = ITM_IN + 5 * ITM_SQ + 3 * ITM_FF, ITM_EARLY = ITM_IN + 2 * ITM_SQ, ITM_REST = ITM_LAYER - ITM_EARLY;
__device__ __forceinline__ int item_early(int l, int j) { return l * ITM_LAYER + (j < ITM_IN ? j : 3 * ITM_SQ + j); }
__device__ __forceinline__ int item_rest(int l, int j) { return l * ITM_LAYER + ITM_IN + (j < 3 * ITM_SQ ? j : 2 * ITM_SQ + j); }
#ifndef DEFER_SPLIT
#define DEFER_SPLIT 0
#endif
#ifndef DEFER_L1
#define DEFER_L1 1
#endif
constexpr int ITM_PRE = 3 * ITM_SQ;
__device__ __forceinline__ int item_map(int set, int j) { return set == 0 ? (j < ITM_EARLY ? item_early(0, j) : (DEFER_L1 ? item_rest(0, j - ITM_EARLY) : item_rest(1, j - ITM_EARLY))) : set == 1 ? (j < ITM_REST - ITM_PRE ? item_rest(0, j + ITM_PRE) : item_early(1, j - (ITM_REST - ITM_PRE))) : item_rest(1, j); }
static_assert(ITM_REST % 4 == 0 && (ITM_REST + ITM_EARLY) % 4 == 0 && (3 * ITM_SQ) % 4 == 0, "per-wave groups of 4 items");
__device__ __forceinline__ float wave_total(float v, int lane) { return __shfl(scan_sum(v, lane), 63); }

__device__ __forceinline__ void phase_prep(PP P, LAS unsigned char* lds) {
    const int tid = opaque_tid(), lane = tid & 63, wave = __builtin_amdgcn_readfirstlane(tid >> 6);
    const int gw = blockIdx.x * 8 + wave, NGW = gridDim.x * 8;
    unsigned char* ws = P->ws;
    LAS float* scrA = (LAS float*)(lds + wave * 17408); LAS float* scrB = scrA + 64 * 33;
    const bool defer = gridDim.x == 256 && DEFER_ON;
    const int N_ITEMS = defer ? (DEFER_L1 ? ITM_EARLY + ITM_PRE : ITM_EARLY + ITM_REST) : 2 * ITM_LAYER;
    for (int it = gw; it < N_ITEMS; it += 2 * NGW) {
        const bool hasB = it + NGW < N_ITEMS;
        const TItem A = decode_item(P, ws, defer ? item_map(0, it) : it), B = decode_item(P, ws, defer ? item_map(0, hasB ? it + NGW : it) : (hasB ? it + NGW : it));
        f32x4 va[8], vb[8]; float ga[8], gb[8];
        item_load(A, lane, va, ga); item_load(B, lane, vb, gb);
        item_finish(A, lane, va, ga, scrA);
        if (hasB) item_finish(B, lane, vb, gb, scrB);
    }
    {
        const int gt = blockIdx.x * NTHREADS + tid, NGT = gridDim.x * NTHREADS;
        constexpr int PER = 104 * DM * 2 / 16;
        for (int i = gt; i < 2 * PER; i += NGT) {
            const int l = i / PER, j = i % PER;
            u32x4 z; z.x = 0; z.y = 0; z.z = 0; z.w = 0;
            *(u32x4*)(ws + WS_WIN + ((size_t)l * NPROJ + 3736) * DM * 2 + (size_t)j * 16) = z;
        }
        float* rc = (float*)(ws + WS_ROPE); float* rs = rc + 2056 * 32;
        for (int i = gt; i < 2056 * 32; i += NGT) {
            const int pi = i >> 5, k = i & 31;
            const float pos = (float)(pi < 2048 ? pi : 16384 + (pi - 2048));
            const float inv = powf(10000.0f, -(float)k * 2.0f / 64.0f);
            const float ang = pos * inv;
            rc[i] = (float)cos((double)ang); rs[i] = (float)sin((double)ang);
        }
    }
    bf16* xb = (bf16*)(ws + WS_XB); float* rss = (float*)(ws + WS_RSS);
    bf16* memb = (bf16*)(ws + WS_MEMB); float* rmem = (float*)(ws + WS_RMEM);
    for (int row0 = gw * 4; row0 < MT + 2048; row0 += NGW * 4) {
        f32x4 v[4][4];
#pragma unroll
        for (int r = 0; r < 4; ++r) {
            const int row = row0 + r;
            const float* src = (row < MP) ? P->in[I_XP] + (size_t)row * DM : (row < MT) ? P->in[I_XS] + (size_t)(row - MP) * DM : P->in[I_MEMP] + (size_t)(row - MT) * DM;
#pragma unroll
            for (int j = 0; j < 4; ++j) v[r][j] = *(const f32x4*)(src + (lane + 64 * j) * 4);
        }
#pragma unroll
        for (int r = 0; r < 4; ++r) {
            const int row = row0 + r;
            bf16* dst = (row < MT) ? xb + (size_t)row * DM : memb + (size_t)(row - MT) * DM;
            float ss = 0.f;
#pragma unroll
            for (int j = 0; j < 4; ++j) {
                const f32x4 x = v[r][j];
                ss += (x[0] * x[0] + x[1] * x[1]) + (x[2] * x[2] + x[3] * x[3]);
                u32x2 w; w.x = pk2(x[0], x[1]); w.y = pk2(x[2], x[3]);
                *(u32x2*)(dst + (lane + 64 * j) * 4) = w;
            }
            ss = wave_total(ss, lane);
            if (row < MT) { if (lane < 16) rss[(size_t)row * 16 + lane] = (lane == 0) ? ss : 0.f; }
            else if (lane == 0) rmem[row - MT] = rsqrtf(ss * (1.0f / 1024.0f) + EPS);
        }
    }
}

__device__ __forceinline__ void deferred_items(PP P, const int l, LAS unsigned char* lds, const int pass = 0, const int half = 0) {
    const int tid = opaque_tid(), lane = tid & 63, wave = __builtin_amdgcn_readfirstlane(tid >> 6);
    unsigned char* ws = P->ws;
    unsigned* ctr = (unsigned*)(ws + WS_CTL) + 24576 + 64 * l + 128 * pass + 16 * half;
    LAS float* scrA = (LAS float*)(lds + wave * 17408); LAS float* scrB = scrA + 64 * 33;
    volatile LAS int* tkt = (volatile LAS int*)(lds + LDS_BYTES - 64) + 12;
    const int nall = l == 0 ? ITM_REST - ITM_PRE + ITM_EARLY : ITM_REST, set = 1 + l;
    const int nfirst = DEFER_SPLIT ? (((nall / 2) + 63) & ~63) : 0, base = half ? nfirst : 0, n = half ? nall - nfirst : nfirst;
    int nt = 0;
    constexpr int TK = 32, PW = TK / 8;
    if (tid == 0) { nt = (int)__hip_atomic_fetch_add(ctr, (unsigned)TK, __ATOMIC_RELAXED, __HIP_MEMORY_SCOPE_AGENT); tkt[0] = nt; }
    __syncthreads();
    int j = tkt[0];
    while (j < n) {
        if (tid == 0) nt = (int)__hip_atomic_fetch_add(ctr, (unsigned)TK, __ATOMIC_RELAXED, __HIP_MEMORY_SCOPE_AGENT);
        const int j0 = base + j + PW * wave;
        if (j + PW * wave < n) {
#pragma unroll 1
            for (int i = 0; i < PW; i += 2) {
                const TItem A = decode_item(P, ws, item_map(set, j0 + i)), B = decode_item(P, ws, item_map(set, j0 + i + 1));
                f32x4 va[8], vb[8]; float ga[8], gb[8];
                item_load(A, lane, va, ga); item_load(B, lane, vb, gb);
                item_finish(A, lane, va, ga, scrA);
                item_finish(B, lane, vb, gb, scrB);
            }
        }
        __syncthreads();
        if (tid == 0) tkt[0] = nt;
        __syncthreads();
        j = tkt[0];
    }
}

__device__ __forceinline__ void phase_final(PP P) {
    const int tid = opaque_tid(), lane = tid & 63, wave = tid >> 6;
    const int gw = blockIdx.x * 8 + wave, NGW = gridDim.x * 8;
    const bf16* xb = (const bf16*)(P->ws + WS_XB); const float* rss = (const float*)(P->ws + WS_RSS); const float* g = P->in[I_GFINAL];
    for (int row = gw; row < MT; row += NGW) {
        const float r = row_rscale(rss, row);
#pragma unroll
        for (int j = 0; j < 4; ++j) {
            const int c = (lane + 64 * j) * 4;
            const u32x2 xw = *(const u32x2*)(xb + (size_t)row * DM + c);
            const f32x4 v = (f32x4){__uint_as_float(xw.x << 16), __uint_as_float(xw.x & 0xffff0000u), __uint_as_float(xw.y << 16), __uint_as_float(xw.y & 0xffff0000u)}, gg = *(const f32x4*)(g + c);
            *(f32x4*)(P->out + O_YP + (size_t)row * DM + c) = v * r * gg;
        }
    }
}
#ifndef DBG_CHAIN
#define DBG_CHAIN 0
#endif
constexpr int CH_LDQ = 72, CH_LDT = 136;
constexpr int CH_OFF_Q = 0, CH_OFF_K = 18432, CH_OFF_KT = 36864, CH_OFF_VT = 54272, CH_OFF_P = 76032, CH_OFF_S = 110848, CH_OFF_B = 122368, CH_END = 140800;
static_assert(CH_END + 256 + 2304 <= LDS_BYTES - 64, "chain lds");
constexpr int CH_BS = 36;

__device__ __forceinline__ float fast_log_sigmoid(float x) { return fminf(x, 0.f) - __logf(1.0f + __expf(-fabsf(x))); }
__device__ __forceinline__ float fast_sigmoid(float x) { return __builtin_amdgcn_rcpf(1.0f + __expf(-x)); }
__device__ __forceinline__ float fast_silu(float x) { return x * __builtin_amdgcn_rcpf(1.0f + __expf(-x)); }

__device__ __forceinline__ void store_T2x8(LAS unsigned char* XT, const int ch0, const int t0, const float (&a)[8], const float (&b)[8]) {
#pragma unroll
    for (int e = 0; e < 8; ++e) *(LAS unsigned*)(XT + ((size_t)(ch0 + e) * CH_LDT + t0) * 2) = pk2(a[e], b[e]);
}
__device__ __forceinline__ void unpack8(const bf16x8 a, float (&x)[8]) {
#pragma unroll
    for (int e = 0; e < 8; ++e) x[e] = bf2f((unsigned short)a[e]);
}
__device__ __forceinline__ u32x4 pack8(const float (&x)[8]) { u32x4 w; w.x = pk2(x[0], x[1]); w.y = pk2(x[2], x[3]); w.z = pk2(x[4], x[5]); w.w = pk2(x[6], x[7]); return w; }

__device__ __forceinline__ void pm_mlstm_gates(PP P, const int layer, const int b, const int h, LAS unsigned char* lds) {
    const int tid = opaque_tid(), lane = tid & 63, w = __builtin_amdgcn_readfirstlane(tid >> 6);
    const float* projg = (const float*)(P->ws + WS_PROJG);
    float* GM = (float*)(P->ws + WS_GM); float* CM = (float*)(P->ws + WS_CM);
    LAS float* lF = (LAS float*)lds; LAS float* lG = lF + 2048; LAS float* lP = lG + 2048; LAS float* lc = lP + 2048;
    const float bfv = P->in[I_BF][layer * 4 + h], biv = P->in[I_BI][layer * 4 + h];
#pragma unroll
    for (int cc = 0; cc < 2; ++cc) {
        const int c = 2 * w + cc, t0 = c * 128;
        const float* g0 = projg + (size_t)(b * SEQ + t0 + lane) * 32; const float* g1 = g0 + 64 * 32;
        const float lf0 = log_sigmoid(g0[20 + h] + bfv), li0 = g0[16 + h] + biv;
        const float lf1 = log_sigmoid(g1[20 + h] + bfv), li1 = g1[16 + h] + biv;
        const float F0 = scan_sum(lf0, lane); const float F1 = scan_sum(lf1, lane) + __shfl(F0, 63);
        const float gg0 = li0 - F0, gg1 = li1 - F1;
        const float pm0 = scan_max(gg0, lane); const float pm1 = fmaxf(scan_max(gg1, lane), __shfl(pm0, 63));
        lF[t0 + lane] = F0; lF[t0 + 64 + lane] = F1; lG[t0 + lane] = gg0; lG[t0 + 64 + lane] = gg1; lP[t0 + lane] = pm0; lP[t0 + 64 + lane] = pm1;
        if (lane == 63) { lc[c] = F1; lc[16 + c] = pm1; }
    }
    __syncthreads();
    if (tid == 0) {
        float m = 0.f;
        for (int c = 0; c < 16; ++c) { const float uL = fmaxf(m, lc[16 + c]); lc[32 + c] = m; lc[48 + c] = uL; m = lc[c] + uL; }
    }
    __syncthreads();
    for (int t = tid; t < 2048; t += NTHREADS) {
        const int c = t >> 7;
        const float u = fmaxf(lc[32 + c], lP[t]);
        *(f32x4*)(GM + ((size_t)(b * 4 + h) * SEQ + t) * 4) = (f32x4){lF[t], lG[t], u, 0.f};
    }
    if (tid < 16) *(f32x4*)(CM + ((size_t)(b * 4 + h) * 16 + tid) * 4) = (f32x4){lc[tid], lc[48 + tid], lc[32 + tid], 0.f};
}
struct ConvPre { bf16x8 u[7]; f32x4 w0[2], w1[2], w2[2], w3[2], bb[2]; };
__device__ __forceinline__ void pm_conv_load(PP P, const int layer, const int b, const int c, const int h, ConvPre& pre) {
    const int tid = opaque_tid();
    const bf16* proj = (const bf16*)(P->ws + WS_PROJ);
    const int which = tid >> 8, cp = tid & 7, rg = (tid >> 3) & 31, chan0 = which * 256 + h * 64 + 8 * cp;
#pragma unroll
    for (int r = 0; r < 7; ++r) { const int tok = c * 128 + 4 * rg - 3 + r;
        if (tok >= 0) pre.u[r] = *(const bf16x8*)((const char*)proj + ((unsigned)(b * SEQ + tok) * NPROJ + C_QKM + chan0) * 2u); else pre.u[r] = (bf16x8){0, 0, 0, 0, 0, 0, 0, 0}; }
    const float* cwp = P->in[I_CONVW] + (size_t)layer * 4 * 512 + chan0; const float* cbp = P->in[I_CONVB] + layer * 512 + chan0;
#pragma unroll
    for (int e4 = 0; e4 < 2; ++e4) { pre.w0[e4] = *(const f32x4*)(cwp + 4 * e4); pre.w1[e4] = *(const f32x4*)(cwp + 512 + 4 * e4); pre.w2[e4] = *(const f32x4*)(cwp + 1024 + 4 * e4);
        pre.w3[e4] = *(const f32x4*)(cwp + 1536 + 4 * e4); pre.bb[e4] = *(const f32x4*)(cbp + 4 * e4); }
}
__device__ __forceinline__ void pm_conv_compute(PP P, const int b, const int c, const int h, const ConvPre& pre) {
    const int tid = opaque_tid();
    bf16* QKC = (bf16*)(P->ws + WS_QKC);
    const int which = tid >> 8, cp = tid & 7, rg = (tid >> 3) & 31, chan0 = which * 256 + h * 64 + 8 * cp;
    float y[4][8];
#pragma unroll
    for (int e4 = 0; e4 < 2; ++e4) {
        const f32x4 w0 = pre.w0[e4], w1 = pre.w1[e4], w2 = pre.w2[e4], w3 = pre.w3[e4], bb = pre.bb[e4];
#pragma unroll
        for (int e1 = 0; e1 < 4; ++e1) {
            const int e = 4 * e4 + e1;
#pragma unroll
            for (int tt = 0; tt < 4; ++tt) {
                const float a = bb[e1] + w0[e1] * bf2f((unsigned short)pre.u[tt][e]) + w1[e1] * bf2f((unsigned short)pre.u[tt + 1][e]) + w2[e1] * bf2f((unsigned short)pre.u[tt + 2][e]) + w3[e1] * bf2f((unsigned short)pre.u[tt + 3][e]);
                y[tt][e] = fast_silu(a) * (which ? 0.125f : 1.0f);
            }
        }
    }
#pragma unroll
    for (int tt = 0; tt < 4; ++tt) *(u32x4*)((char*)QKC + ((unsigned)(b * SEQ + c * 128 + 4 * rg + tt) * 512 + chan0) * 2u) = pack8(y[tt]);
}
__device__ __forceinline__ void pm_mlstm_conv(PP P, const int layer, const int b, const int c, const int h) { ConvPre pre; pm_conv_load(P, layer, b, c, h, pre); pm_conv_compute(P, b, c, h, pre); }
#define PM_GLA_DECL(S) f32x4 S##a0, S##a1, S##a2, S##a3, S##b0, S##b1, S##b2, S##b3; bf16x8 S##x0, S##x1; float S##wg, S##bg
#define PM_GLA_LOAD(S, b_, c_, h_) do { const int tid_ = opaque_tid(), lane_ = tid_ & 63; const int bb_ = (b_), cc_ = (c_), hh_ = (h_); \
    const bf16* proj_ = (const bf16*)(P->ws + WS_PROJ); const float* projg_ = (const float*)(P->ws + WS_PROJG); \
    S##wg = P->in[I_WGA2][(size_t)layer * 16 * 192 + (tid_ & 15) * 192 + hh_ * 32 + (tid_ >> 4)]; S##bg = P->in[I_BGA][layer * 192 + hh_ * 32 + (tid_ & 31)]; \
    const int row0_ = bb_ * SEQ + cc_ * 128; \
    { const f32x4* ap_ = (const f32x4*)(projg_ + (size_t)(row0_ + lane_) * 32); S##a0 = ap_[0]; S##a1 = ap_[1]; S##a2 = ap_[2]; S##a3 = ap_[3]; } \
    { const f32x4* ap_ = (const f32x4*)(projg_ + (size_t)(row0_ + 64 + lane_) * 32); S##b0 = ap_[0]; S##b1 = ap_[1]; S##b2 = ap_[2]; S##b3 = ap_[3]; } \
    const int isq_ = tid_ >> 8, tp_ = (tid_ >> 2) & 63, p_ = tid_ & 3; \
    const unsigned ro_ = ((unsigned)(row0_ + 2 * tp_) * NPROJ + (isq_ ? C_QG : C_KG) + hh_ * 32 + 8 * p_) * 2u; \
    S##x0 = *(const bf16x8*)((const char*)proj_ + ro_); S##x1 = *(const bf16x8*)((const char*)proj_ + ro_ + NPROJ * 2u); } while (0)
#define PM_GLA_VALS(S) S##a0, S##a1, S##a2, S##a3, S##b0, S##b1, S##b2, S##b3, S##x0, S##x1, S##wg, S##bg
__device__ __forceinline__ void pm_gla_compute(PP P, const int b, const int c, const int h, const f32x4 qa0, const f32x4 qa1, const f32x4 qa2, const f32x4 qa3, const f32x4 qb0, const f32x4 qb1, const f32x4 qb2, const f32x4 qb3,
                                               const bf16x8 x0, const bf16x8 x1, const float pwg, const float pbg, LAS unsigned char* lds) {
    const int tid = opaque_tid(), lane = tid & 63, w = __builtin_amdgcn_readfirstlane(tid >> 6);
    LAS float* Bs = (LAS float*)lds;
    LAS float* wgl = Bs + 128 * CH_BS;
    wgl[tid] = pwg; if (tid < 32) wgl[512 + tid] = pbg;
    const int row0 = b * SEQ + c * 128;
    const int isq = tid >> 8, tp = (tid >> 2) & 63, p = tid & 3;
    f32x4 pa[2][4];
    pa[0][0] = qa0; pa[0][1] = qa1; pa[0][2] = qa2; pa[0][3] = qa3; pa[1][0] = qb0; pa[1][1] = qb1; pa[1][2] = qb2; pa[1][3] = qb3;
    __syncthreads();
    {
        float carry[4];
#pragma unroll
        for (int hh = 0; hh < 2; ++hh) {
            const int t = hh * 64 + lane;
            const float ag[16] = {pa[hh][0][0], pa[hh][0][1], pa[hh][0][2], pa[hh][0][3], pa[hh][1][0], pa[hh][1][1], pa[hh][1][2], pa[hh][1][3],
                                  pa[hh][2][0], pa[hh][2][1], pa[hh][2][2], pa[hh][2][3], pa[hh][3][0], pa[hh][3][1], pa[hh][3][2], pa[hh][3][3]};
#pragma unroll
            for (int cc = 0; cc < 4; ++cc) {
                const int ch = 4 * w + cc;
                float x = wgl[512 + ch];
#pragma unroll
                for (int r4 = 0; r4 < 4; ++r4) { const f32x4 wv = *(const LAS f32x4*)(wgl + ch * 16 + 4 * r4);
                    x += ag[4 * r4] * wv[0] + ag[4 * r4 + 1] * wv[1] + ag[4 * r4 + 2] * wv[2] + ag[4 * r4 + 3] * wv[3]; }
                float v = scan_sum(fast_log_sigmoid(x) * (1.0f / 16.0f), lane);
                if (hh == 0) carry[cc] = __shfl(v, 63); else v += carry[cc];
                Bs[t * CH_BS + ch] = v;
            }
        }
    }
    __syncthreads();
    {
        bf16* dq = (bf16*)(P->ws + (isq ? WS_GQ : WS_GK)); bf16* dkt = (bf16*)(P->ws + WS_GKT);
        const f32x4 l0 = *(const LAS f32x4*)(Bs + 127 * CH_BS + 8 * p), l1 = *(const LAS f32x4*)(Bs + 127 * CH_BS + 8 * p + 4);
        const float blv[8] = {l0[0], l0[1], l0[2], l0[3], l1[0], l1[1], l1[2], l1[3]};
#pragma unroll
        for (int tk = 0; tk < 2; ++tk) {
            const int t = 2 * tp + tk;
            float x[8], xo[8], kt[8]; unpack8(tk ? x1 : x0, x);
            const f32x4 b0 = *(const LAS f32x4*)(Bs + t * CH_BS + 8 * p), b1 = *(const LAS f32x4*)(Bs + t * CH_BS + 8 * p + 4);
            const float btv[8] = {b0[0], b0[1], b0[2], b0[3], b1[0], b1[1], b1[2], b1[3]};
#pragma unroll
            for (int e = 0; e < 8; ++e) {
                if (isq) { xo[e] = x[e] * 0.17677669529663687f * __expf(btv[e]); kt[e] = 0.f; }
                else { xo[e] = x[e] * __expf(-btv[e]); kt[e] = x[e] * __expf(blv[e] - btv[e]); }
            }
            const unsigned oo = ((unsigned)(row0 + t) * 192 + h * 32 + 8 * p) * 2u;
            *(u32x4*)((char*)dq + oo) = pack8(xo);
            if (!isq) *(u32x4*)((char*)dkt + oo) = pack8(kt);
        }
        if (tid < 32) ((float*)(P->ws + WS_GBL))[((size_t)(b * 6 + h) * 16 + c) * 32 + tid] = Bs[127 * CH_BS + tid];
    }
}
#ifndef DBG_PM_MASK
#define DBG_PM_MASK 7
#endif
__device__ __forceinline__ void phase_premix(PP P, const int layer, LAS unsigned char* lds, const int pmask = 7) {
    const int G = gridDim.x;
    int task = blockIdx.x;
    if (task < 32) { if (pmask & 1) pm_mlstm_gates(P, layer, task >> 2, task & 3, lds); task += G; }
#define PM_GLA_ARGS(tk_) ((tk_) - 32) / 96, ((((tk_) - 32) / 6) & 15), ((tk_) - 32) % 6
#define PM_CONV_ARGS(tk_) ((tk_) - 800) >> 6, ((((tk_) - 800) >> 2) & 15), ((tk_) - 800) & 3
    if (G == 256) {
        const int t0 = task, t1 = task + 256, t2 = task + 512, t3 = task + 768, t4 = task + 1024;
        PM_GLA_DECL(A); PM_GLA_DECL(B);
        ConvPre C, D;
        if (pmask & 4) { pm_conv_load(P, layer, PM_CONV_ARGS(t3), C); pm_conv_load(P, layer, PM_CONV_ARGS(t4), D); }
        if (pmask & 2) {
        PM_GLA_LOAD(A, (t0 - 32) / 96, ((t0 - 32) / 6) & 15, (t0 - 32) % 6);
        PM_GLA_LOAD(B, (t1 - 32) / 96, ((t1 - 32) / 6) & 15, (t1 - 32) % 6);
        __syncthreads();
        pm_gla_compute(P, PM_GLA_ARGS(t0), PM_GLA_VALS(A), lds);
        PM_GLA_LOAD(A, (t2 - 32) / 96, ((t2 - 32) / 6) & 15, (t2 - 32) % 6);
        __syncthreads();
        pm_gla_compute(P, PM_GLA_ARGS(t1), PM_GLA_VALS(B), lds);
        __syncthreads();
        pm_gla_compute(P, PM_GLA_ARGS(t2), PM_GLA_VALS(A), lds);
        }
        if (pmask & 4) { pm_conv_compute(P, PM_CONV_ARGS(t3), C); pm_conv_compute(P, PM_CONV_ARGS(t4), D); }
    } else {
        for (; task < 800; task += G) { PM_GLA_DECL(A); PM_GLA_LOAD(A, (task - 32) / 96, ((task - 32) / 6) & 15, (task - 32) % 6); __syncthreads(); pm_gla_compute(P, PM_GLA_ARGS(task), PM_GLA_VALS(A), lds); }
        for (; task < 1312; task += G) pm_mlstm_conv(P, layer, PM_CONV_ARGS(task));
    }
#undef PM_GLA_ARGS
#undef PM_GLA_DECL
#undef PM_GLA_LOAD
#undef PM_GLA_VALS
#undef PM_CONV_ARGS
}
template <int TYPE, int VAR = 0>
__device__ __forceinline__ void mixer_chain(PP P, const int layer, const int b, const int h, LAS unsigned char* lds) {
    constexpr int DK = (TYPE == 1) ? 32 : 64, NDV = (TYPE == 2) ? 5 : 4, KS_DK = DK / 32;
    const int tid = opaque_tid(), lane = tid & 63, w = __builtin_amdgcn_readfirstlane(tid >> 6), l15 = lane & 15, l4 = lane >> 4;
    const bf16* proj = (const bf16*)(P->ws + WS_PROJ);
    bf16* og = (bf16*)(P->ws + WS_O);
    const float* rcos = (const float*)(P->ws + WS_ROPE); const float* rsin = rcos + 2056 * 32;
    const bf16* QKC = (const bf16*)(P->ws + WS_QKC); const float* GM = (const float*)(P->ws + WS_GM); const float* CM = (const float*)(P->ws + WS_CM);
    const bf16* GQ = (const bf16*)(P->ws + WS_GQ); const bf16* GK = (const bf16*)(P->ws + WS_GK); const bf16* GKT = (const bf16*)(P->ws + WS_GKT); const float* GBL = (const float*)(P->ws + WS_GBL);
    LAS unsigned char* Qs = lds + CH_OFF_Q; LAS unsigned char* Ks = lds + CH_OFF_K; LAS unsigned char* KT = lds + CH_OFF_KT;
    LAS unsigned char* VT = lds + CH_OFF_VT; LAS unsigned char* Ps = lds + CH_OFF_P; LAS unsigned char* Sst = lds + CH_OFF_S;
    LAS float* Bs = (LAS float*)(lds + CH_OFF_B);
    LAS float* gainl = (LAS float*)(lds + CH_END);
    LAS float* gF = Bs; LAS float* gG = Bs + 128; LAS float* gU = Bs + 256;
    const int qcol = (TYPE == 0) ? C_QR + h * 64 : 0;
    const int kcol = (TYPE == 0) ? C_KR + h * 64 : 0;
    const int vcol = (TYPE == 0) ? C_VR + h * 64 : (TYPE == 1) ? C_VG + h * 64 : C_VM + h * 64;
    const int gcol = (TYPE == 0) ? C_GR + h * 64 : (TYPE == 1) ? C_RG + h * 64 : C_OM + h * 64;
    const int ocol = (TYPE == 0) ? h * 64 : (TYPE == 1) ? 384 + h * 64 : 768 + h * 64;
    const float* gain = (TYPE == 0) ? P->in[I_GRET] + layer * 384 + h * 64 : (TYPE == 1) ? P->in[I_GGLA] + layer * 384 + h * 64 : P->in[I_GMLSTM] + layer * 256 + h * 64;
    const float lg = (TYPE == 0) ? log2f(1.0f - exp2f(-5.0f - (float)h)) : 0.f;
    const int iloc = 16 * w + l15;
    const int vt_tp = tid >> 3, vt_pc = tid & 7;
    const int qk_isq = tid >> 8, qk_tp = (tid >> 2) & 63, qk_p = tid & 3;

    if (tid < 64) gainl[tid] = gain[tid];
    for (int i = tid; i < 80 * CH_LDQ / 2; i += NTHREADS) ((LAS unsigned*)Sst)[i] = 0u;
    if (TYPE == 2) for (int i = tid; i < 16 * CH_LDT / 2; i += NTHREADS) { const int r = (2 * i) / CH_LDT; ((LAS unsigned*)(VT + 64 * CH_LDT * 2))[i] = (r == 0) ? 0x3F803F80u : 0u; }
    f32x4 acc_s[3];
#pragma unroll
    for (int t = 0; t < 3; ++t) acc_s[t] = (f32x4){0.f, 0.f, 0.f, 0.f};
    const int dkt = (TYPE == 1) ? (w & 1) : (w & 3);
    const int dvt0 = (TYPE == 1) ? (w >> 1) : (w >> 2) * 2;
    const float r_kd0 = (TYPE == 0) ? exp2f((float)(127 - 2 * qk_tp) * lg) : 1.f, r_kd1 = (TYPE == 0) ? exp2f((float)(126 - 2 * qk_tp) * lg) : 1.f;
    const float r_rsc = (TYPE == 0) ? exp2f((float)(iloc + 1) * lg) : 1.f;
    const float r_dcy = (TYPE == 0) ? exp2f(128.0f * lg) : 1.f;
    float r_wr[4];
#pragma unroll
    for (int r = 0; r < 4; ++r) r_wr[r] = (TYPE == 0) ? exp2f((float)(iloc - 4 * l4 - r) * lg) : 1.f;
    const float r_g16 = (TYPE == 0) ? exp2f(-16.0f * lg) : 1.f;

    bf16x8 pv0, pv1;
    bf16x8 px[2][2];
    f32x4 pcs[2][4];
    f32x4 pgm;
    float pgk[2];
    f32x4 pcm;
#define LD16(base_, off_) (*(const bf16x8*)((const char*)(base_) + (unsigned)(off_)))
#define LDF4(base_, off_) (*(const f32x4*)((const char*)(base_) + (unsigned)(off_)))
#define CH_LOAD(c_) do { const unsigned row0_ = (unsigned)(b * SEQ + (c_) * 128); \
        { const unsigned vo_ = ((row0_ + 2 * vt_tp) * NPROJ + vcol + 8 * vt_pc) * 2u; pv0 = LD16(proj, vo_); pv1 = LD16(proj, vo_ + NPROJ * 2u); } \
        if (TYPE == 0) { const unsigned ro_ = ((row0_ + 2 * qk_tp) * NPROJ + (qk_isq ? qcol : kcol) + 8 * qk_p) * 2u; \
            px[0][0] = LD16(proj, ro_); px[0][1] = LD16(proj, ro_ + 64u); px[1][0] = LD16(proj, ro_ + NPROJ * 2u); px[1][1] = LD16(proj, ro_ + NPROJ * 2u + 64u); \
            const unsigned co_ = (((c_) * 128 + 2 * qk_tp) * 32 + 8 * qk_p) * 4u; \
            pcs[0][0] = LDF4(rcos, co_); pcs[0][1] = LDF4(rcos, co_ + 16u); pcs[0][2] = LDF4(rsin, co_); pcs[0][3] = LDF4(rsin, co_ + 16u); \
            pcs[1][0] = LDF4(rcos, co_ + 128u); pcs[1][1] = LDF4(rcos, co_ + 144u); pcs[1][2] = LDF4(rsin, co_ + 128u); pcs[1][3] = LDF4(rsin, co_ + 144u); } \
        if (TYPE == 1) { const unsigned ro_ = ((row0_ + 2 * qk_tp) * 192 + h * 32 + 8 * qk_p) * 2u; \
            if (qk_isq) { px[0][0] = LD16(GQ, ro_); px[1][0] = LD16(GQ, ro_ + 384u); } \
            else { px[0][0] = LD16(GK, ro_); px[1][0] = LD16(GK, ro_ + 384u); px[0][1] = LD16(GKT, ro_); px[1][1] = LD16(GKT, ro_ + 384u); } \
            pcm = LDF4(GBL, (((unsigned)(b * 6 + h) * 16 + (c_)) * 32 + dkt * 16 + 4 * l4) * 4u); } \
        if (TYPE == 2) { const unsigned ro_ = ((row0_ + 2 * qk_tp) * 512 + (qk_isq ? 0 : 256) + h * 64 + 8 * qk_p) * 2u; \
            px[0][0] = LD16(QKC, ro_); px[0][1] = LD16(QKC, ro_ + 64u); px[1][0] = LD16(QKC, ro_ + 1024u); px[1][1] = LD16(QKC, ro_ + 1024u + 64u); \
            pgm = LDF4(GM, ((unsigned)(b * 4 + h) * SEQ + (c_) * 128 + (tid & 127)) * 16u); \
            pgk[0] = *(const float*)((const char*)GM + ((unsigned)(b * 4 + h) * SEQ + (c_) * 128 + 2 * qk_tp) * 16u + 4u); pgk[1] = *(const float*)((const char*)GM + ((unsigned)(b * 4 + h) * SEQ + (c_) * 128 + 2 * qk_tp + 1) * 16u + 4u); \
            pcm = LDF4(CM, (((unsigned)(b * 4 + h) * 16 + (c_)) * 4) * 4u); } \
    } while (0)
#define GR_LOAD(c_) do { const unsigned go_ = ((unsigned)(b * SEQ + (c_) * 128 + iloc) * NPROJ + gcol + 8 * l4) * 2u; gr[0] = *(const u32x4*)((const char*)proj + go_); gr[1] = *(const u32x4*)((const char*)proj + go_ + 64u); } while (0)
#define SCHED_FENCE() __builtin_amdgcn_sched_barrier(0)
    u32x4 gr[2];
#define CH_PROW(dt_) ((dt_) * 16 + l15)
    float m_last = 0.f;
    CH_LOAD(0);
    __syncthreads();

    for (int c = 0; c < 16; ++c) {
        const int row0 = b * SEQ + c * 128;
        {
            float v1[8], v2[8]; unpack8(pv0, v1); unpack8(pv1, v2);
#pragma unroll
            for (int e = 0; e < 8; ++e) *(LAS unsigned*)(VT + ((size_t)(32 * (vt_pc >> 2) + 16 * (e >> 2) + 4 * (vt_pc & 3) + (e & 3)) * CH_LDT + 2 * vt_tp) * 2) = pk2(v1[e], v2[e]);
        }
        float FL = 0.f, uL = 0.f, m_prev = 0.f;
        f32x4 bl4 = (f32x4){0.f, 0.f, 0.f, 0.f};
        if (TYPE == 1) bl4 = pcm;
        if (TYPE == 2) { FL = pcm[0]; uL = pcm[1]; m_prev = pcm[2]; }
        if (TYPE == 0) {
            float o1[2][8], o2[2][8];
#pragma unroll
            for (int tk = 0; tk < 2; ++tk) {
                const float cv[8] = {pcs[tk][0][0], pcs[tk][0][1], pcs[tk][0][2], pcs[tk][0][3], pcs[tk][1][0], pcs[tk][1][1], pcs[tk][1][2], pcs[tk][1][3]};
                const float sv[8] = {pcs[tk][2][0], pcs[tk][2][1], pcs[tk][2][2], pcs[tk][2][3], pcs[tk][3][0], pcs[tk][3][1], pcs[tk][3][2], pcs[tk][3][3]};
                float x1[8], x2[8]; unpack8(px[tk][0], x1); unpack8(px[tk][1], x2);
                const float sc = qk_isq ? 0.125f : 1.0f;
#pragma unroll
                for (int e = 0; e < 8; ++e) { o1[tk][e] = (x1[e] * cv[e] - x2[e] * sv[e]) * sc; o2[tk][e] = (x1[e] * sv[e] + x2[e] * cv[e]) * sc; }
                LAS unsigned char* dst = (qk_isq ? Qs : Ks) + ((2 * qk_tp + tk) * CH_LDQ + 8 * qk_p) * 2;
                *(LAS u32x4*)dst = pack8(o1[tk]); *(LAS u32x4*)(dst + 64) = pack8(o2[tk]);
            }
            if (!qk_isq) {
#pragma unroll
                for (int e = 0; e < 8; ++e) { o1[0][e] *= r_kd0; o2[0][e] *= r_kd0; o1[1][e] *= r_kd1; o2[1][e] *= r_kd1; }
                store_T2x8(KT, 8 * qk_p, 2 * qk_tp, o1[0], o1[1]); store_T2x8(KT, 32 + 8 * qk_p, 2 * qk_tp, o2[0], o2[1]);
            }
        }
        if (TYPE == 1) {
#pragma unroll
            for (int tk = 0; tk < 2; ++tk) *(LAS bf16x8*)((qk_isq ? Qs : Ks) + ((2 * qk_tp + tk) * CH_LDQ + 8 * qk_p) * 2) = px[tk][0];
            if (!qk_isq) { float k0[8], k1[8]; unpack8(px[0][1], k0); unpack8(px[1][1], k1); store_T2x8(KT, 8 * qk_p, 2 * qk_tp, k0, k1); }
        }
        if (TYPE == 2) {
#pragma unroll
            for (int tk = 0; tk < 2; ++tk) { LAS unsigned char* dst = (qk_isq ? Qs : Ks) + ((2 * qk_tp + tk) * CH_LDQ + 8 * qk_p) * 2; *(LAS bf16x8*)dst = px[tk][0]; *(LAS bf16x8*)(dst + 64) = px[tk][1]; }
            if (!qk_isq) {
                const float wk0 = __expf(pgk[0] - uL), wk1 = __expf(pgk[1] - uL);
                float a0[8], a1[8], c0[8], c1[8]; unpack8(px[0][0], a0); unpack8(px[1][0], a1); unpack8(px[0][1], c0); unpack8(px[1][1], c1);
#pragma unroll
                for (int e = 0; e < 8; ++e) { a0[e] *= wk0; c0[e] *= wk0; a1[e] *= wk1; c1[e] *= wk1; }
                store_T2x8(KT, 8 * qk_p, 2 * qk_tp, a0, a1); store_T2x8(KT, 32 + 8 * qk_p, 2 * qk_tp, c0, c1);
            }
            if (tid < 128) { gF[tid] = pgm[0]; gG[tid] = pgm[1]; gU[tid] = pgm[2]; }
        }
        if (c + 1 < 16 && VAR != 4) CH_LOAD(c + 1);
        __syncthreads();
        GR_LOAD(c);
        bf16x8 yq[KS_DK];
        f32x4 acc_o[NDV];
        float ui = 0.f;
        if (TYPE == 2) ui = gU[iloc];
#pragma unroll
        for (int ks = 0; ks < KS_DK; ++ks) yq[ks] = lfrag(Qs, iloc, CH_LDQ, 32 * ks + 8 * l4);
        {
            bf16x8 fs[NDV][KS_DK];
#pragma unroll
            for (int dt = 0; dt < NDV; ++dt)
#pragma unroll
                for (int ks = 0; ks < KS_DK; ++ks) fs[dt][ks] = lfrag(Sst, CH_PROW(dt), CH_LDQ, 32 * ks + 8 * l4);
            SCHED_FENCE();
#pragma unroll
            for (int dt = 0; dt < NDV; ++dt) {
                acc_o[dt] = (f32x4){0.f, 0.f, 0.f, 0.f};
#pragma unroll
                for (int ks = 0; ks < KS_DK; ++ks) acc_o[dt] = mma16(fs[dt][ks], yq[ks], acc_o[dt]);
            }
            SCHED_FENCE();
        }
        if (TYPE != 1) {
            const float rsc = (TYPE == 0) ? r_rsc : __expf(m_prev - ui);
#pragma unroll
            for (int dt = 0; dt < NDV; ++dt) acc_o[dt] *= rsc;
        }
        {
            float gjt = 1.0f;
#pragma unroll
            for (int jb = 0; jb < 2; ++jb) {
                f32x4 sc[4];
                bf16x8 fk[4][KS_DK];
#pragma unroll
                for (int j4 = 0; j4 < 4; ++j4)
#pragma unroll
                    for (int ks = 0; ks < KS_DK; ++ks) fk[j4][ks] = lfrag(Ks, (jb * 4 + j4) * 16 + l15, CH_LDQ, 32 * ks + 8 * l4);
                SCHED_FENCE();
#pragma unroll
                for (int j4 = 0; j4 < 4; ++j4) {
                    sc[j4] = (f32x4){0.f, 0.f, 0.f, 0.f};
#pragma unroll
                    for (int ks = 0; ks < KS_DK; ++ks) sc[j4] = mma16(fk[j4][ks], yq[ks], sc[j4]);
                }
#pragma unroll
                for (int j4 = 0; j4 < 4; ++j4) {
                    const int jt = jb * 4 + j4, j0 = jt * 16 + 4 * l4;
                    f32x4 gg = (f32x4){0.f, 0.f, 0.f, 0.f};
                    if (TYPE == 2) gg = *(const LAS f32x4*)(gG + j0);
#pragma unroll
                    for (int r = 0; r < 4; ++r) {
                        float wgt = 1.0f;
                        if (TYPE == 0) wgt = r_wr[r] * gjt;
                        if (TYPE == 2) wgt = __expf(fminf(gg[r] - ui, 0.f));
                        sc[j4][r] = (iloc >= j0 + r) ? sc[j4][r] * wgt : 0.f;
                    }
                    u32x2 wv; wv.x = pk2(sc[j4][0], sc[j4][1]); wv.y = pk2(sc[j4][2], sc[j4][3]);
                    *(LAS u32x2*)(Ps + (iloc * CH_LDT + jt * 16 + 4 * l4) * 2) = wv;
                    gjt *= r_g16;
                }
                asm volatile("" ::: "memory");
            }
        }
        asm volatile("s_waitcnt lgkmcnt(0)" ::: "memory");
        constexpr int PVB = 2;
#pragma unroll
        for (int kb = 0; kb < 4 / PVB; ++kb) {
            bf16x8 yp[PVB], fv[PVB][NDV];
#pragma unroll
            for (int k2 = 0; k2 < PVB; ++k2) {
                yp[k2] = lfrag(Ps, iloc, CH_LDT, 32 * (PVB * kb + k2) + 8 * l4);
#pragma unroll
                for (int dt = 0; dt < NDV; ++dt) fv[k2][dt] = lfrag(VT, CH_PROW(dt), CH_LDT, 32 * (PVB * kb + k2) + 8 * l4);
            }
            SCHED_FENCE();
#pragma unroll
            for (int k2 = 0; k2 < PVB; ++k2)
#pragma unroll
                for (int dt = 0; dt < NDV; ++dt) acc_o[dt] = mma16(fv[k2][dt], yp[k2], acc_o[dt]);
            SCHED_FENCE();
        }
        {
            if (TYPE == 2) {
                const float den = __shfl(acc_o[NDV - 1][0], l15);
                const float mt = gF[iloc] + ui;
                const float inv = __builtin_amdgcn_rcpf(fmaxf(fabsf(den), __expf(-mt)));
#pragma unroll
                for (int dt = 0; dt < 4; ++dt) acc_o[dt] *= inv;
            }
            float ss = 0.f;
#pragma unroll
            for (int dt = 0; dt < 4; ++dt) ss += (acc_o[dt][0] * acc_o[dt][0] + acc_o[dt][1] * acc_o[dt][1]) + (acc_o[dt][2] * acc_o[dt][2] + acc_o[dt][3] * acc_o[dt][3]);
            ss += __shfl_xor(ss, 16); ss += __shfl_xor(ss, 32);
            const float rn = rsqrtf(ss * (1.0f / 64.0f) + EPS);
            const unsigned oo = ((unsigned)(row0 + iloc) * DM + ocol + 8 * l4) * 2u;
#pragma unroll
            for (int dp = 0; dp < 2; ++dp) {
                const f32x4 gn0 = *(const LAS f32x4*)(gainl + dp * 32 + 8 * l4), gn1 = *(const LAS f32x4*)(gainl + dp * 32 + 8 * l4 + 4);
                const float ga[8] = {__uint_as_float(gr[dp].x << 16), __uint_as_float(gr[dp].x & 0xffff0000u), __uint_as_float(gr[dp].y << 16), __uint_as_float(gr[dp].y & 0xffff0000u),
                                     __uint_as_float(gr[dp].z << 16), __uint_as_float(gr[dp].z & 0xffff0000u), __uint_as_float(gr[dp].w << 16), __uint_as_float(gr[dp].w & 0xffff0000u)};
                float vv[8];
#pragma unroll
                for (int e = 0; e < 8; ++e) vv[e] = (TYPE == 2) ? fast_sigmoid(ga[e]) : fast_silu(ga[e]);
                u32x4 wv;
                wv.x = pk2(acc_o[2 * dp][0] * rn * gn0[0] * vv[0], acc_o[2 * dp][1] * rn * gn0[1] * vv[1]); wv.y = pk2(acc_o[2 * dp][2] * rn * gn0[2] * vv[2], acc_o[2 * dp][3] * rn * gn0[3] * vv[3]);
                wv.z = pk2(acc_o[2 * dp + 1][0] * rn * gn1[0] * vv[4], acc_o[2 * dp + 1][1] * rn * gn1[1] * vv[5]); wv.w = pk2(acc_o[2 * dp + 1][2] * rn * gn1[2] * vv[6], acc_o[2 * dp + 1][3] * rn * gn1[3] * vv[7]);
                *(u32x4*)((char*)og + oo + dp * 64u) = wv;
            }
        }
        {
            if (TYPE == 0) {
#pragma unroll
                for (int t = 0; t < 2; ++t) acc_s[t] *= r_dcy; }
            if (TYPE == 1) {
#pragma unroll
                for (int r = 0; r < 4; ++r) acc_s[0][r] *= __expf(bl4[r]); }
            if (TYPE == 2) { const float dcy = __expf(m_prev - uL);
#pragma unroll
                for (int t = 0; t < 3; ++t) acc_s[t] *= dcy; }
            constexpr int SB = 2;
#pragma unroll
            for (int kb = 0; kb < 4 / SB; ++kb) {
                bf16x8 fx[SB], f0[SB], f1[SB], f2[SB];
#pragma unroll
                for (int k2 = 0; k2 < SB; ++k2) {
                    const int ks = SB * kb + k2;
                    fx[k2] = lfrag(KT, dkt * 16 + l15, CH_LDT, 32 * ks + 8 * l4);
                    f0[k2] = lfrag(VT, dvt0 * 16 + l15, CH_LDT, 32 * ks + 8 * l4);
                    if (TYPE != 1) f1[k2] = lfrag(VT, (dvt0 + 1) * 16 + l15, CH_LDT, 32 * ks + 8 * l4);
                    if (TYPE == 2) f2[k2] = lfrag(VT, 64 + l15, CH_LDT, 32 * ks + 8 * l4);
                }
                SCHED_FENCE();
#pragma unroll
                for (int k2 = 0; k2 < SB; ++k2) {
                    acc_s[0] = mma16(fx[k2], f0[k2], acc_s[0]);
                    if (TYPE != 1) acc_s[1] = mma16(fx[k2], f1[k2], acc_s[1]);
                    if (TYPE == 2) { if (w < 4) acc_s[2] = mma16(fx[k2], f2[k2], acc_s[2]); }
                }
                SCHED_FENCE();
            }
        }
        if (TYPE == 2) m_last = FL + uL;
        __syncthreads();
        {
            u32x2 wv; wv.x = pk2(acc_s[0][0], acc_s[0][1]); wv.y = pk2(acc_s[0][2], acc_s[0][3]);
            *(LAS u32x2*)(Sst + ((dvt0 * 16 + l15) * CH_LDQ + dkt * 16 + 4 * l4) * 2) = wv;
            if (TYPE != 1) { wv.x = pk2(acc_s[1][0], acc_s[1][1]); wv.y = pk2(acc_s[1][2], acc_s[1][3]);
                *(LAS u32x2*)(Sst + (((dvt0 + 1) * 16 + l15) * CH_LDQ + dkt * 16 + 4 * l4) * 2) = wv; }
            if (TYPE == 2) { if (w < 4) { wv.x = pk2(acc_s[2][0], acc_s[2][1]); wv.y = pk2(acc_s[2][2], acc_s[2][3]);
                *(LAS u32x2*)(Sst + ((64 + l15) * CH_LDQ + dkt * 16 + 4 * l4) * 2) = wv; } }
        }
    }
#undef CH_LOAD
#undef GR_LOAD
#undef LD16
#undef LDF4
#undef SCHED_FENCE
    {
        const int tid = opaque_tid(), lane = tid & 63, w = __builtin_amdgcn_readfirstlane(tid >> 6), l15 = lane & 15, l4 = lane >> 4;
        const int dkt = (TYPE == 1) ? (w & 1) : (w & 3);
        const int dvt0 = (TYPE == 1) ? (w >> 1) : (w >> 2) * 2;
        const int dvl = 8 * (l15 >> 2) + (l15 & 3);
        float* out = P->out;
        if (TYPE == 0) {
            float* sp = out + O_PRET + (((size_t)layer * NB + b) * 6 + h) * 4096;
#pragma unroll
            for (int t = 0; t < 2; ++t)
#pragma unroll
                for (int r = 0; r < 4; ++r) sp[(dkt * 16 + 4 * l4 + r) * 64 + 32 * ((dvt0 + t) >> 1) + 4 * ((dvt0 + t) & 1) + dvl] = acc_s[t][r];
        }
        if (TYPE == 1) {
            float* sp = out + O_PGLA + (((size_t)layer * NB + b) * 6 + h) * 2048;
#pragma unroll
            for (int r = 0; r < 4; ++r) sp[(dkt * 16 + 4 * l4 + r) * 64 + 32 * (dvt0 >> 1) + 4 * (dvt0 & 1) + dvl] = acc_s[0][r];
        }
        if (TYPE == 2) {
            float* sp = out + O_PC + (((size_t)layer * NB + b) * 4 + h) * 4096;
#pragma unroll
            for (int t = 0; t < 2; ++t)
#pragma unroll
                for (int r = 0; r < 4; ++r) sp[(dkt * 16 + 4 * l4 + r) * 64 + 32 * ((dvt0 + t) >> 1) + 4 * ((dvt0 + t) & 1) + dvl] = acc_s[t][r];
            if (w < 4 && l15 == 0) {
                float* np = out + O_PN + (((size_t)layer * NB + b) * 4 + h) * 64;
#pragma unroll
                for (int r = 0; r < 4; ++r) np[dkt * 16 + 4 * l4 + r] = acc_s[2][r];
            }
            if (tid == 0) out[O_PM + ((size_t)layer * NB + b) * 4 + h] = m_last;
            if (tid < 384) {
                const int r = tid >> 7, cc = tid & 127, ch = (cc >> 6) * 256 + h * 64 + (cc & 63);
                out[O_PCONV + (((size_t)layer * NB + b) * 3 + r) * 512 + ch] = bf2f(proj[(size_t)(b * SEQ + SEQ - 3 + r) * NPROJ + C_QKM + ch]);
            }
        }
    }
}
__device__ __forceinline__ void sample_mixer(PP P, const int layer, const int b, const int hh, LAS unsigned char* wl  , const int lane) {
    const bf16* proj = (const bf16*)(P->ws + WS_PROJ);
    const float* projg = (const float*)(P->ws + WS_PROJG);
    bf16* og = (bf16*)(P->ws + WS_O);
    const float* rcos = (const float*)(P->ws + WS_ROPE); const float* rsin = rcos + 2056 * 32;
    LAS float* qs = (LAS float*)wl;
    LAS float* ks = qs + 512;
    LAS float* as = ks + 512;
    LAS float* vl = as + 256;
    LAS float* ol = vl + 512;
    const int row0 = MP + b * DECT;
    if (hh < 6) {
        const int h = hh;
        const float gamma = 1.0f - exp2f(-5.0f - (float)h);
        const int dlo = lane & 31;
#pragma unroll
        for (int t = 0; t < 8; ++t) {
            const bf16* rp = proj + (size_t)(row0 + t) * NPROJ;
            const float cs = rcos[(2048 + t) * 32 + dlo], sn = rsin[(2048 + t) * 32 + dlo];
            const float q1 = bf2f(rp[C_QR + h * 64 + dlo]), q2 = bf2f(rp[C_QR + h * 64 + 32 + dlo]);
            const float k1 = bf2f(rp[C_KR + h * 64 + dlo]), k2 = bf2f(rp[C_KR + h * 64 + 32 + dlo]);
            qs[t * 64 + lane] = ((lane < 32) ? q1 * cs - q2 * sn : q1 * sn + q2 * cs) * 0.125f;
            ks[t * 64 + lane] = (lane < 32) ? k1 * cs - k2 * sn : k1 * sn + k2 * cs;
        }
        asm volatile("s_waitcnt lgkmcnt(0)" ::: "memory");
#pragma unroll
        for (int t = 0; t < 8; ++t) vl[t * 64 + lane] = bf2f(proj[(size_t)(row0 + t) * NPROJ + C_VR + h * 64 + lane]);
#pragma unroll 1
        for (int hf = 0; hf < 2; ++hf) {
            const float* s0 = P->in[I_SRET] + (((size_t)layer * DECB + b) * 6 + h) * 4096 + hf * 2048 + lane;
            float S[32];
#pragma unroll
            for (int d = 0; d < 32; ++d) S[d] = s0[d * 64];
#pragma unroll 1
            for (int t = 0; t < 8; ++t) {
                const float v = vl[t * 64 + lane];
                float o = 0.f;
#pragma unroll
                for (int d4 = 0; d4 < 8; ++d4) {
                    const f32x4 kk = *(const LAS f32x4*)(ks + t * 64 + hf * 32 + 4 * d4), qq = *(const LAS f32x4*)(qs + t * 64 + hf * 32 + 4 * d4);
#pragma unroll
                    for (int e = 0; e < 4; ++e) { S[4 * d4 + e] = gamma * S[4 * d4 + e] + kk[e] * v; o += qq[e] * S[4 * d4 + e]; }
                }
                ol[t * 64 + lane] = hf ? ol[t * 64 + lane] + o : o;
            }
            float* so = P->out + O_SRET + (((size_t)layer * DECB + b) * 6 + h) * 4096 + hf * 2048 + lane;
#pragma unroll
            for (int d = 0; d < 32; ++d) so[d * 64] = S[d];
        }
        const float gn = P->in[I_GRET][layer * 384 + h * 64 + lane];
#pragma unroll 1
        for (int t = 0; t < 8; ++t) {
            const float o = ol[t * 64 + lane];
            const float rn = rsqrtf(wave_sum(o * o) * (1.0f / 64.0f) + EPS);
            const float g = bf2f(proj[(size_t)(row0 + t) * NPROJ + C_GR + h * 64 + lane]);
            og[(size_t)(row0 + t) * DM + h * 64 + lane] = f2bf(o * rn * gn * siluf(g));
        }
    } else if (hh < 12) {
        const int h = hh - 6;
        {
            const int t = lane >> 3, c0 = (lane & 7) * 4;
            const f32x4* ap = (const f32x4*)(projg + (size_t)(row0 + t) * 32);
            const f32x4 a0 = ap[0], a1 = ap[1], a2 = ap[2], a3 = ap[3];
            const float ag[16] = {a0[0], a0[1], a0[2], a0[3], a1[0], a1[1], a1[2], a1[3], a2[0], a2[1], a2[2], a2[3], a3[0], a3[1], a3[2], a3[3]};
#pragma unroll
            for (int cc = 0; cc < 4; ++cc) {
                const int col = h * 32 + c0 + cc;
                float x = P->in[I_BGA][layer * 192 + col];
                const float* wp = P->in[I_WGA2] + (size_t)layer * 16 * 192 + col;
#pragma unroll
                for (int r = 0; r < 16; ++r) x += ag[r] * wp[r * 192];
                as[t * 32 + c0 + cc] = expf(log_sigmoid(x) * (1.0f / 16.0f));
            }
        }
        if (lane < 32) {
#pragma unroll
            for (int t = 0; t < 8; ++t) {
                const bf16* rp = proj + (size_t)(row0 + t) * NPROJ;
                qs[t * 64 + lane] = bf2f(rp[C_QG + h * 32 + lane]) * 0.17677669529663687f;
                ks[t * 64 + lane] = bf2f(rp[C_KG + h * 32 + lane]);
            }
        }
        asm volatile("s_waitcnt lgkmcnt(0)" ::: "memory");
        const float* s0 = P->in[I_SGLA] + (((size_t)layer * DECB + b) * 6 + h) * 2048 + lane;
        float S[32];
#pragma unroll
        for (int d = 0; d < 32; ++d) S[d] = s0[d * 64];
#pragma unroll 1
        for (int t = 0; t < 8; ++t) {
            const bf16* rp = proj + (size_t)(row0 + t) * NPROJ;
            const float v = bf2f(rp[C_VG + h * 64 + lane]);
            float o = 0.f;
#pragma unroll
            for (int d4 = 0; d4 < 8; ++d4) {
                const f32x4 kk = *(const LAS f32x4*)(ks + t * 64 + 4 * d4), qq = *(const LAS f32x4*)(qs + t * 64 + 4 * d4), aa = *(const LAS f32x4*)(as + t * 32 + 4 * d4);
#pragma unroll
                for (int e = 0; e < 4; ++e) { S[4 * d4 + e] = aa[e] * S[4 * d4 + e] + kk[e] * v; o += qq[e] * S[4 * d4 + e]; }
            }
            const float rn = rsqrtf(wave_sum(o * o) * (1.0f / 64.0f) + EPS);
            const float g = bf2f(rp[C_RG + h * 64 + lane]);
            og[(size_t)(row0 + t) * DM + 384 + h * 64 + lane] = f2bf(o * rn * P->in[I_GGLA][layer * 384 + h * 64 + lane] * siluf(g));
        }
        float* so = P->out + O_SGLA + (((size_t)layer * DECB + b) * 6 + h) * 2048 + lane;
#pragma unroll
        for (int d = 0; d < 32; ++d) so[d * 64] = S[d];
    } else {
        const int h = hh - 12;
        {
#pragma unroll
            for (int which = 0; which < 2; ++which) {
                const int ch = which * 256 + h * 64 + lane;
                float up[11];
                const float* cbuf = P->in[I_SCONV] + ((size_t)layer * DECB + b) * 3 * 512 + ch;
#pragma unroll
                for (int r = 0; r < 3; ++r) up[r] = cbuf[r * 512];
#pragma unroll
                for (int t = 0; t < 8; ++t) up[3 + t] = bf2f(proj[(size_t)(row0 + t) * NPROJ + C_QKM + ch]);
                const float* cw = P->in[I_CONVW] + (size_t)layer * 4 * 512 + ch;
                const float w0 = cw[0], w1 = cw[512], w2 = cw[1024], w3 = cw[1536], cb = P->in[I_CONVB][layer * 512 + ch];
#pragma unroll
                for (int t = 0; t < 8; ++t) {
                    const float y = siluf(cb + w0 * up[t] + w1 * up[t + 1] + w2 * up[t + 2] + w3 * up[t + 3]);
                    if (which) ks[t * 64 + lane] = y * 0.125f; else qs[t * 64 + lane] = y;
                }
                float* co = P->out + O_SCONV + ((size_t)layer * DECB + b) * 3 * 512 + ch;
#pragma unroll
                for (int r = 0; r < 3; ++r) co[r * 512] = up[8 + r];
            }
        }
        asm volatile("s_waitcnt lgkmcnt(0)" ::: "memory");
        float nv = P->in[I_SN][(((size_t)layer * DECB + b) * 4 + h) * 64 + lane];
        float mm = P->in[I_SM][((size_t)layer * DECB + b) * 4 + h];
        const float bfv = P->in[I_BF][layer * 4 + h], biv = P->in[I_BI][layer * 4 + h];
        LAS float* fsl = as; LAS float* denl = as + 8; LAS float* emnl = as + 16;
#pragma unroll 1
        for (int t = 0; t < 8; ++t) {
            const float* gp = projg + (size_t)(row0 + t) * 32;
            const float lf = log_sigmoid(gp[20 + h] + bfv), li = gp[16 + h] + biv;
            const float mn = fmaxf(lf + mm, li);
            const float fsv = expf(lf + mm - mn), is = expf(li - mn);
            vl[t * 64 + lane] = bf2f(proj[(size_t)(row0 + t) * NPROJ + C_VM + h * 64 + lane]) * is;
            nv = fsv * nv + is * ks[t * 64 + lane];
            const float dn = wave_sum(qs[t * 64 + lane] * nv);
            if (lane == 0) { fsl[t] = fsv; denl[t] = dn; emnl[t] = expf(-mn); }
            mm = mn;
        }
        asm volatile("s_waitcnt lgkmcnt(0)" ::: "memory");
#pragma unroll 1
        for (int hf = 0; hf < 2; ++hf) {
            const float* c0p = P->in[I_SC] + (((size_t)layer * DECB + b) * 4 + h) * 4096 + hf * 2048 + lane;
            float S[32];
#pragma unroll
            for (int d = 0; d < 32; ++d) S[d] = c0p[d * 64];
#pragma unroll 1
            for (int t = 0; t < 8; ++t) {
                const float v = vl[t * 64 + lane], fsv = fsl[t];
                float o = 0.f;
#pragma unroll
                for (int d4 = 0; d4 < 8; ++d4) {
                    const f32x4 kk = *(const LAS f32x4*)(ks + t * 64 + hf * 32 + 4 * d4), qq = *(const LAS f32x4*)(qs + t * 64 + hf * 32 + 4 * d4);
#pragma unroll
                    for (int e = 0; e < 4; ++e) { S[4 * d4 + e] = fsv * S[4 * d4 + e] + kk[e] * v; o += qq[e] * S[4 * d4 + e]; }
                }
                ol[t * 64 + lane] = hf ? ol[t * 64 + lane] + o : o;
            }
            float* so = P->out + O_SC + (((size_t)layer * DECB + b) * 4 + h) * 4096 + hf * 2048 + lane;
#pragma unroll
            for (int d = 0; d < 32; ++d) so[d * 64] = S[d];
        }
        const float gn = P->in[I_GMLSTM][layer * 256 + h * 64 + lane];
#pragma unroll 1
        for (int t = 0; t < 8; ++t) {
            const float hv = ol[t * 64 + lane] / fmaxf(fabsf(denl[t]), emnl[t]);
            const float rn = rsqrtf(wave_sum(hv * hv) * (1.0f / 64.0f) + EPS);
            const float g = bf2f(proj[(size_t)(row0 + t) * NPROJ + C_OM + h * 64 + lane]);
            og[(size_t)(row0 + t) * DM + 768 + h * 64 + lane] = f2bf(hv * rn * gn * sigmoidf(g));
        }
        P->out[O_SN + (((size_t)layer * DECB + b) * 4 + h) * 64 + lane] = nv;
        if (lane == 0) P->out[O_SM + ((size_t)layer * DECB + b) * 4 + h] = mm;
    }
    asm volatile("s_waitcnt lgkmcnt(0)" ::: "memory");
}
constexpr int AP_BUF = 36864, AP_POFF = 2 * AP_BUF, AP_PW = 8448, AP_END = AP_POFF + 8 * AP_PW;
static_assert(AP_END <= LDS_BYTES - 64, "attention lds");
__device__ __forceinline__ void attn_prompt_tile(const bf16* __restrict__ q, const bf16* __restrict__ memK, const bf16* __restrict__ memVt, bf16* __restrict__ att, const int tile, LAS unsigned char* lds) {
    const int tid = opaque_tid(), lane = tid & 63, w = __builtin_amdgcn_readfirstlane(tid >> 6), l15 = lane & 15, l4 = lane >> 4;
    const int b = tile >> 6, head = (tile >> 4) & 3, tt = tile & 15;
    const int R0 = b * SEQ + tt * 128 + 16 * w;
    const bf16* qrow = q + (size_t)(R0 + l15) * DM + head * 256 + 8 * l4;
    bf16x8 yq[8];
#pragma unroll
    for (int ks = 0; ks < 8; ++ks) yq[ks] = *(const bf16x8*)(qrow + 32 * ks);
    const bf16* kg = memK + ((size_t)b * 256) * 1024 + head * 256;
    const bf16* vg = memVt + (((size_t)b * 4 + head) * 256) * 256;
    u32x4 stA[4], stB[4];
#define AP_LOAD(n, ST) do { _Pragma("unroll") for (int i_ = 0; i_ < 4; ++i_) { const int p_ = tid + 512 * i_; \
        if ((n) < 4) ST[i_] = *(const u32x4*)(kg + (size_t)(64 * (n) + (p_ >> 5)) * 1024 + (p_ & 31) * 8); \
        else ST[i_] = *(const u32x4*)(vg + (size_t)(p_ >> 3) * 256 + 64 * ((n) - 4) + (p_ & 7) * 8); } } while (0)
#define AP_STORE(n, ST) do { LAS unsigned char* bb_ = lds + ((n) & 1) * AP_BUF; _Pragma("unroll") for (int i_ = 0; i_ < 4; ++i_) { const int p_ = tid + 512 * i_; \
        if ((n) < 4) *(LAS u32x4*)(bb_ + ((p_ >> 5) * 264 + (p_ & 31) * 8) * 2) = ST[i_]; \
        else { const int d_ = p_ >> 3, sl_ = (d_ & ~31) | (((d_ >> 2) & 1) << 4) | (((d_ >> 3) & 3) << 2) | (d_ & 3);     \
               *(LAS u32x4*)(bb_ + (sl_ * 72 + (p_ & 7) * 8) * 2) = ST[i_]; } } } while (0)
    AP_LOAD(0, stA); AP_LOAD(1, stB); AP_STORE(0, stA);
    __syncthreads();
    f32x4 s[16];
    f32x4 o[16];
    float inv = 0.f;
    LAS unsigned char* Pw = lds + AP_POFF + w * AP_PW;
#pragma unroll
    for (int n = 0; n < 8; ++n) {
        if (n < 6) { if (n & 1) AP_LOAD(n + 2, stB); else AP_LOAD(n + 2, stA); }
        const LAS unsigned char* bb = lds + (n & 1) * AP_BUF;
        if (n < 4) {
#pragma unroll
            for (int j4 = 0; j4 < 4; ++j4) {
                f32x4 a = (f32x4){0.f, 0.f, 0.f, 0.f};
#pragma unroll
                for (int ks = 0; ks < 8; ++ks) a = mma16(lfrag(bb, 16 * j4 + l15, 264, 32 * ks + 8 * l4), yq[ks], a);
                s[4 * n + j4] = a;
            }
            if (n == 3) {
                float mx = -3.0e38f;
#pragma unroll
                for (int jt = 0; jt < 16; ++jt) mx = fmaxf(mx, fmaxf(fmaxf(s[jt][0], s[jt][1]), fmaxf(s[jt][2], s[jt][3])));
                mx = fmaxf(mx, __shfl_xor(mx, 16)); mx = fmaxf(mx, __shfl_xor(mx, 32));
                float sum = 0.f;
#pragma unroll
                for (int jt = 0; jt < 16; ++jt) {
#pragma unroll
                    for (int r = 0; r < 4; ++r) { const float p = __expf(s[jt][r] - mx); s[jt][r] = p; sum += p; }
                }
                sum += __shfl_xor(sum, 16); sum += __shfl_xor(sum, 32);
                inv = 1.0f / sum;
#pragma unroll
                for (int jt = 0; jt < 16; ++jt) { u32x2 wv; wv.x = pk2(s[jt][0], s[jt][1]); wv.y = pk2(s[jt][2], s[jt][3]); *(LAS u32x2*)(Pw + (l15 * 264 + jt * 16 + 4 * l4) * 2) = wv; }
#pragma unroll
                for (int dt = 0; dt < 16; ++dt) o[dt] = (f32x4){0.f, 0.f, 0.f, 0.f};
                asm volatile("s_waitcnt lgkmcnt(0)" ::: "memory");
            }
        } else {
#pragma unroll
            for (int k2 = 0; k2 < 2; ++k2) {
                const bf16x8 y = lfrag(Pw, l15, 264, 64 * (n - 4) + 32 * k2 + 8 * l4);
#pragma unroll
                for (int dt = 0; dt < 16; ++dt) o[dt] = mma16(lfrag(bb, 16 * dt + l15, 72, 32 * k2 + 8 * l4), y, o[dt]);
            }
        }
        if (n < 7) { if (n & 1) AP_STORE(n + 1, stA); else AP_STORE(n + 1, stB); __syncthreads(); }
    }
#undef AP_LOAD
#undef AP_STORE
    bf16* orow = att + (size_t)(R0 + l15) * DM + head * 256 + 8 * l4;
#pragma unroll
    for (int dp = 0; dp < 8; ++dp) { u32x4 wv; wv.x = pk2(o[2 * dp][0] * inv, o[2 * dp][1] * inv); wv.y = pk2(o[2 * dp][2] * inv, o[2 * dp][3] * inv);
        wv.z = pk2(o[2 * dp + 1][0] * inv, o[2 * dp + 1][1] * inv); wv.w = pk2(o[2 * dp + 1][2] * inv, o[2 * dp + 1][3] * inv); *(u32x4*)(orow + dp * 32) = wv; }
}

constexpr int AS_PT = 0, AS_OP = 16384, AS_MX = 81920, AS_SM = 82944, AS_END = 83968;
__device__ __forceinline__ void attn_sample_tile(const bf16* __restrict__ q, const float* __restrict__ ck, const float* __restrict__ cv, bf16* __restrict__ att, const int tile, LAS unsigned char* lds) {
    const int tid = opaque_tid(), lane = tid & 63, w = __builtin_amdgcn_readfirstlane(tid >> 6), l15 = lane & 15, l4 = lane >> 4;
    const int b = tile >> 1, hl = w >> 2, head = (tile & 1) * 2 + hl, qtr = w & 3;
    const int R0 = MP + b * DECT;
    const bf16* qrow = q + (size_t)(R0 + (l15 & 7)) * DM + head * 256 + 4 * l4;
    bf16x8 yq[8];
#pragma unroll
    for (int ks = 0; ks < 8; ++ks) { const u32x2 qa = *(const u32x2*)(qrow + 32 * ks), qc = *(const u32x2*)(qrow + 32 * ks + 16); u32x4 qw; qw.x = qa.x; qw.y = qa.y; qw.z = qc.x; qw.w = qc.y; yq[ks] = __builtin_bit_cast(bf16x8, qw); }
    const float* kb = ck + (((size_t)b * 256 + 64 * qtr + l15) * 4 + head) * 256 + 4 * l4;
    f32x4 s[4];
    f32x4 ka0[8], kc0[8], ka1[8], kc1[8];
#define AS_KLOAD(KA, KC, jt) do { _Pragma("unroll") for (int ks_ = 0; ks_ < 8; ++ks_) { const f32x4* kp_ = (const f32x4*)(kb + (size_t)(jt) * 16 * 1024 + 32 * ks_); KA[ks_] = __builtin_nontemporal_load(kp_); KC[ks_] = __builtin_nontemporal_load(kp_ + 4); } } while (0)
#define AS_KMMA(KA, KC, jt) do { s[jt] = (f32x4){0.f, 0.f, 0.f, 0.f}; _Pragma("unroll") for (int ks_ = 0; ks_ < 8; ++ks_) { \
        u32x4 xw_; xw_.x = pk2(KA[ks_][0], KA[ks_][1]); xw_.y = pk2(KA[ks_][2], KA[ks_][3]); xw_.z = pk2(KC[ks_][0], KC[ks_][1]); xw_.w = pk2(KC[ks_][2], KC[ks_][3]); \
        s[jt] = mma16(__builtin_bit_cast(bf16x8, xw_), yq[ks_], s[jt]); } } while (0)
    AS_KLOAD(ka0, kc0, 0); AS_KLOAD(ka1, kc1, 1);
    AS_KMMA(ka0, kc0, 0); AS_KLOAD(ka0, kc0, 2);
    AS_KMMA(ka1, kc1, 1); AS_KLOAD(ka1, kc1, 3);
    AS_KMMA(ka0, kc0, 2);
    AS_KMMA(ka1, kc1, 3);
#undef AS_KLOAD
#undef AS_KMMA
    LAS float* MX = (LAS float*)(lds + AS_MX); LAS float* SM = (LAS float*)(lds + AS_SM);
    float mx = -3.0e38f;
#pragma unroll
    for (int jt = 0; jt < 4; ++jt) mx = fmaxf(mx, fmaxf(fmaxf(s[jt][0], s[jt][1]), fmaxf(s[jt][2], s[jt][3])));
    mx = fmaxf(mx, __shfl_xor(mx, 16)); mx = fmaxf(mx, __shfl_xor(mx, 32));
    if (lane < 16) MX[w * 16 + lane] = mx;
    __syncthreads();
    {
        const int wb = hl * 4;
        mx = fmaxf(fmaxf(MX[(wb + 0) * 16 + l15], MX[(wb + 1) * 16 + l15]), fmaxf(MX[(wb + 2) * 16 + l15], MX[(wb + 3) * 16 + l15]));
    }
    float sum = 0.f;
#pragma unroll
    for (int jt = 0; jt < 4; ++jt) {
#pragma unroll
        for (int r = 0; r < 4; ++r) { const float p = __expf(s[jt][r] - mx); s[jt][r] = p; sum += p; }
    }
    sum += __shfl_xor(sum, 16); sum += __shfl_xor(sum, 32);
    if (lane < 16) SM[w * 16 + lane] = sum;
#pragma unroll
    for (int jt = 0; jt < 4; ++jt)
#pragma unroll
        for (int r = 0; r < 4; ++r) { float t_ = s[jt][r]; asm volatile("" : "+v"(t_)); s[jt][r] = t_; }
    float acc[8][4];
#pragma unroll
    for (int t = 0; t < 8; ++t)
#pragma unroll
        for (int e = 0; e < 4; ++e) acc[t][e] = 0.f;
    const float* vb = cv + (((size_t)b * 256 + 64 * qtr) * 4 + head) * 256 + lane * 4;
#pragma unroll
    for (int bi = 0; bi < 4; ++bi) {
        f32x4 v[16];
#pragma unroll
        for (int jj = 0; jj < 16; ++jj) v[jj] = __builtin_nontemporal_load((const f32x4*)(vb + (size_t)(16 * bi + jj) * 1024));
#pragma unroll
        for (int jj = 0; jj < 16; ++jj) {
#pragma unroll
            for (int t = 0; t < 8; ++t) {
                const float p = __shfl(s[bi][jj & 3], 16 * (jj >> 2) + t);
#pragma unroll
                for (int e = 0; e < 4; ++e) acc[t][e] += p * v[jj][e];
            }
        }
    }
    LAS float* OP = (LAS float*)(lds + AS_OP);
#pragma unroll
    for (int t = 0; t < 8; ++t) *(LAS f32x4*)(OP + (w * 8 + t) * 256 + lane * 4) = (f32x4){acc[t][0], acc[t][1], acc[t][2], acc[t][3]};
    __syncthreads();
    {
        const int wb = hl * 4;
#pragma unroll
        for (int tt = 0; tt < 2; ++tt) {
            const int t = 2 * qtr + tt;
            const float tot = (SM[(wb + 0) * 16 + t] + SM[(wb + 1) * 16 + t]) + (SM[(wb + 2) * 16 + t] + SM[(wb + 3) * 16 + t]);
            const float inv = 1.0f / tot;
            f32x4 o = *(const LAS f32x4*)(OP + ((wb + 0) * 8 + t) * 256 + lane * 4);
            o += *(const LAS f32x4*)(OP + ((wb + 1) * 8 + t) * 256 + lane * 4);
            o += *(const LAS f32x4*)(OP + ((wb + 2) * 8 + t) * 256 + lane * 4);
            o += *(const LAS f32x4*)(OP + ((wb + 3) * 8 + t) * 256 + lane * 4);
            u32x2 wv; wv.x = pk2(o[0] * inv, o[1] * inv); wv.y = pk2(o[2] * inv, o[3] * inv);
            *(u32x2*)(att + (size_t)(R0 + t) * DM + head * 256 + lane * 4) = wv;
        }
    }
}
constexpr int N_PHASES = 20;
#ifndef DBG_S_REPS
#define DBG_S_REPS 0
#endif
#ifndef DBG_E_REP
#define DBG_E_REP 0
#endif
#ifndef DBG_GEMM_REPS
#define DBG_GEMM_REPS 1
#endif
#ifndef DBG_SMALL_REPS
#define DBG_SMALL_REPS 1
#endif
#ifndef DBG_UNIT_REPS
#define DBG_UNIT_REPS 1
#endif
#ifndef DBG_EXTRA_BARS
#define DBG_EXTRA_BARS 0
#endif
#ifndef DBG_NOLO
#define DBG_NOLO 0
#endif
#ifndef REP_MASK
#define REP_MASK 0
#endif
__host__ __device__ constexpr bool rep_sub(int s9) { return s9 == 1 ? ((REP_MASK >> 10) & 1) : (s9 == 0 ? (REP_MASK & 1) : (((REP_MASK >> (s9 - 1)) & 1) && (s9 - 1) != 2 && (s9 - 1) != 5 && (s9 - 1) != 7)); }
#ifndef HP_LEVEL
#define HP_LEVEL 0
#endif
#ifndef DBG_VAR
#define DBG_VAR 0
#endif
#ifndef DBG_TYPES
#define DBG_TYPES 7
#endif
#ifndef DBG_REPS
#define DBG_REPS 1
#endif
#ifndef DBG_REP_SAMPLE
#define DBG_REP_SAMPLE 0
#endif
#ifndef USE_CG_SYNC
#define USE_CG_SYNC 0
#endif
#ifndef DBG_STOP
#define DBG_STOP 0
#endif
#define DBG_ONLY 0
#define DBG_SKIP_HELPER 0
#define DBG_EXPR ((i < (size_t)MP * DM && (i % 1024) < 384) ? bf2f(og[i]) : 0.f)
__device__ __forceinline__ void phase_dump(PP P) {
    const size_t n = (size_t)MT * DM;
    const bf16* proj = (const bf16*)(P->ws + WS_PROJ); const bf16* og = (const bf16*)(P->ws + WS_O); const bf16* qb = (const bf16*)(P->ws + WS_Q);
    const bf16* att = (const bf16*)(P->ws + WS_ATT); const bf16* hb = (const bf16*)(P->ws + WS_H); const float* xf = (const float*)(P->ws + WS_XF);
    const bf16* xb = (const bf16*)(P->ws + WS_XB); const float* projg = (const float*)(P->ws + WS_PROJG); const float* rss = (const float*)(P->ws + WS_RSS);
    for (size_t i = (size_t)blockIdx.x * NTHREADS + threadIdx.x; i < n; i += (size_t)gridDim.x * NTHREADS) {
        float v = 0.f;
#if DBG_ONLY
        v = DBG_EXPR;
#elif DBG_STOP >= 1
        v += bf2f(proj[i]) + bf2f(proj[i + n]) + bf2f(proj[i + 2 * n]) + bf2f(proj[(i + 3 * n) % ((size_t)MT * NPROJ)]) + projg[i % ((size_t)MT * 32)] + bf2f(xb[i]) + rss[i % ((size_t)MT * 16)];
#endif
#if DBG_STOP >= 2
        v += bf2f(og[i]);
#endif
#if DBG_STOP >= 3
        v += xf[i];
#endif
#if DBG_STOP >= 4
        v += bf2f(qb[i]);
#endif
#if DBG_STOP >= 5
        v += bf2f(att[i]);
#endif
#if DBG_STOP >= 7
        v += bf2f(hb[i]) + bf2f(hb[i + n]) + bf2f(hb[(i + 2 * n) % ((size_t)MT * DFF)]);
#endif
        P->out[i] = v;
    }
#ifdef DBG_KEEP
    {
        const size_t g0[4] = {O_YP, O_PRET, O_PMK, O_SRET}, g1[4] = {O_PRET, O_PMK, O_SRET, O_END};
#pragma unroll
        for (int k = 0; k < 4; ++k) if (!((DBG_KEEP >> k) & 1)) {
            for (size_t i = g0[k] + (size_t)blockIdx.x * NTHREADS + threadIdx.x; i < g1[k]; i += (size_t)gridDim.x * NTHREADS) P->out[i] = 1.0f; }
    }
#endif
#if DBG_STOP < 10
    {
        const size_t offs[13] = {O_PRET, O_PGLA, O_PC, O_PN, O_PM, O_PCONV, O_PMK, O_SRET, O_SGLA, O_SC, O_SN, O_SM, O_SCONV};
        const size_t ends[13] = {O_PGLA, O_PC, O_PN, O_PM, O_PCONV, O_PMK, O_PMK, O_SGLA, O_SC, O_SN, O_SM, O_SCONV, O_END};
#pragma unroll
        for (int k = 0; k < 13; ++k) { const size_t half = (ends[k] - offs[k]) / 2;
            for (size_t i = (size_t)blockIdx.x * NTHREADS + threadIdx.x; i < half; i += (size_t)gridDim.x * NTHREADS) P->out[offs[k] + half + i] = 1.0f; }
    }
#endif
}

__device__ __forceinline__ void unit_of_block256(const int c, pg8::Unit& u) { const int xcd = c & 7, off = c >> 3; u.pm = 8 * xcd + (off & 7); u.pn = off >> 3; }

__device__ __forceinline__ void finalize_panel(PP P, unsigned* cnt, const unsigned need, const int row0, const int nrows, LAS unsigned char* lds) {
    const int tid = opaque_tid(), lane = tid & 63, wave = __builtin_amdgcn_readfirstlane(tid >> 6);
    volatile LAS unsigned* flag = (volatile LAS unsigned*)(lds + LDS_BYTES - 64) + 8;
    asm volatile("s_waitcnt vmcnt(0)" ::: "memory");
    __syncthreads();
    if (tid == 0) {
        __builtin_amdgcn_fence(__ATOMIC_RELEASE, "agent");
        asm volatile("s_waitcnt vmcnt(0)" ::: "memory");
        flag[0] = __hip_atomic_fetch_add(cnt, 1u, __ATOMIC_RELAXED, __HIP_MEMORY_SCOPE_AGENT);
    }
    __syncthreads();
    const bool last = (flag[0] == need - 1u);
    if (last) {
        if (tid == 0) { __builtin_amdgcn_fence(__ATOMIC_ACQUIRE, "agent"); asm volatile("s_waitcnt vmcnt(0)" ::: "memory"); }
        __syncthreads();
        const float* xf = (const float*)(P->ws + WS_XF); const float* rss = (const float*)(P->ws + WS_RSS); const float* g = P->in[I_GFINAL];
        for (int r = wave; r < nrows; r += 8) {
            const int row = row0 + r;
            const float rs = row_rscale(rss, row);
#pragma unroll
            for (int j = 0; j < 4; ++j) {
                const int c = (lane + 64 * j) * 4;
                const f32x4 v = *(const f32x4*)(xf + (size_t)row * DM + c), gg = *(const f32x4*)(g + c);
                *(f32x4*)(P->out + O_YP + (size_t)row * DM + c) = v * rs * gg;
            }
        }
    }
    __syncthreads();
}

__device__ __forceinline__ void run_phase(PP P, const int ph_in, LAS unsigned char* lds) {
    const int nolo = ph_in >= 100 && ph_in != 199 ? 1 : 0; const int ph = (ph_in >= 100 && ph_in != 199) ? ph_in - 100 : (ph_in == 199 ? 99 : ph_in);
    unsigned char* ws = P->ws;
    bf16* xb = (bf16*)(ws + WS_XB); float* xf = (float*)(ws + WS_XF); float* rss = (float*)(ws + WS_RSS);
    bf16* proj = (bf16*)(ws + WS_PROJ); float* projg = (float*)(ws + WS_PROJG);
    bf16* og = (bf16*)(ws + WS_O); bf16* qb = (bf16*)(ws + WS_Q); bf16* att = (bf16*)(ws + WS_ATT); bf16* hb = (bf16*)(ws + WS_H);
    if (ph == 99) { phase_dump(P); return; }
    if (ph == 0) { phase_prep(P, lds); return; }
    if (ph == N_PHASES - 1) { phase_final(P); return; }
    const int l = (ph - 1) / 9, sub0 = (ph - 1) % 9;
    if (sub0 == 1) { phase_premix(P, l, lds, nolo ? DBG_PM_MASK : 7); return; }
    const int sub = sub0 == 0 ? 0 : sub0 - 1;
    const int G = gridDim.x, bx = blockIdx.x;
    switch (sub) {
    case 0: {
        pg8::Gemm g{xb, (const bf16*)(ws + WS_WIN) + (size_t)l * NPROJ * DM, MT, NPROJ, DM};
        pg8::StaticOrder S; S.init(MT, NPROJ, G, bx);
        EpiScaleBf16 E{proj, NPROJ, rss, 1.0f, projg, 14, nolo};
        pg8::gemm_phase<EpiScaleBf16, pg8::StaticOrder, true, true>(lds, g, S, E);
    } break;
    case 1: {
        const bool hp = (G == 256) && (HP_LEVEL > 0);
        const int otid0 = opaque_tid();
        HlpBarrier hbar; hbar.bar = nullptr; hbar.x = 0; hbar.st = nullptr;
        if (hp && bx >= 128) {
            volatile LAS unsigned* hst = (volatile LAS unsigned*)(lds + LDS_BYTES - 64) + 2;
            if (otid0 == 0) { hst[0] = 0u; hst[1] = 0u; }
            __syncthreads();
            hbar = hlp_barrier_post((unsigned*)(ws + WS_CTL) + (1 + l) * 4096, hst);
        }
        for (int task = bx; task < 256; task += G) {
            __syncthreads();
            if (task < 128) {
                const int b = task >> 4, hh = task & 15;
#if DBG_VAR
                for (int rep = 0; rep < DBG_REPS; ++rep) {
                if (hh < 6) { if (DBG_TYPES & 1) mixer_chain<0, DBG_VAR>(P, l, b, hh, lds); }
                else if (hh < 12) { if (DBG_TYPES & 2) mixer_chain<1, DBG_VAR>(P, l, b, hh - 6, lds); }
                else { if (DBG_TYPES & 4) mixer_chain<2, DBG_VAR>(P, l, b, hh - 12, lds); }
                __syncthreads(); }
#endif
                if (hh < 6) mixer_chain<0>(P, l, b, hh, lds);
                else if (hh < 12) mixer_chain<1>(P, l, b, hh - 6, lds);
                else mixer_chain<2>(P, l, b, hh - 12, lds);
            } else {
                const int hidx = task - 128;
                if (hidx < 64) {
                    const int lay = l, un = hidx;
                    pg8::Gemm g{(const bf16*)(ws + WS_MEMB), (const bf16*)(ws + WS_WXKV) + (size_t)lay * 2048 * DM, 2048, 2048, DM};
                    ListOrder S{un, un + 1, 1, 8};
                    EpiMemKV E{P->out + O_PMK + (size_t)lay * 2048 * 1024, P->out + O_PMV + (size_t)lay * 2048 * 1024,
                               (bf16*)(ws + WS_MEMK) + (size_t)lay * 2048 * 1024, (bf16*)(ws + WS_MEMVT) + (size_t)lay * 2048 * 1024, (const float*)(ws + WS_RMEM)};
                    pg8::gemm_phase<EpiMemKV, ListOrder, true, true>(lds, g, S, E);
                    __syncthreads();
                }
                const int otid = opaque_tid(); const int lane = otid & 63, wave = __builtin_amdgcn_readfirstlane(otid >> 6);
                {
                    const int nk = (hidx < 64) ? 1 : 3;
                    const int base = (hidx < 64) ? hidx * 8 + wave : 512 + ((hidx - 64) * 8 + wave) * 3;
                    for (int k = 0; k < nk * (1 + DBG_REP_SAMPLE); ++k) {
                        const int wt = base + (k % nk);
                        sample_mixer(P, l, wt >> 4, wt & 15, lds + wave * 10240, lane);
                    }
                }
                if (hp) {
                    hlp_barrier(hbar);
                    { EpiResid E{xb, rss};
                      for (int t = hidx; t < 256; t += 128) small_gemm_tile(og, (const bf16*)(ws + WS_WOUT) + (size_t)l * DM * DM, DM, MP + 64 * (t >> 4), 64 * (t & 15), E, lds); }
                    hlp_barrier(hbar);
                    { EpiScaleBf16 E{qb, DM, rss, 0.0625f, nullptr, -1};
                      for (int t = hidx; t < 256; t += 128) small_gemm_tile(xb, (const bf16*)(ws + WS_WXQ) + (size_t)l * DM * DM, DM, MP + 64 * (t >> 4), 64 * (t & 15), E, lds); }
#if HP_LEVEL >= 4
                    hlp_barrier(hbar);
                    { const float* ck = P->in[I_CK] + (size_t)l * DECB * 256 * 1024; const float* cv = P->in[I_CV] + (size_t)l * DECB * 256 * 1024;
                      for (int t = hidx; t < 256; t += 128) { __syncthreads(); attn_sample_tile(qb, ck, cv, att, t, lds); } }
                    hlp_barrier(hbar);
                    { EpiResid E{xb, rss};
                      for (int t = hidx; t < 256; t += 128) small_gemm_tile(att, (const bf16*)(ws + WS_WXO) + (size_t)l * DM * DM, DM, MP + 64 * (t >> 4), 64 * (t & 15), E, lds); }
#endif
                }
            }
        }
    } break;
    case 2: {
        pg8::Gemm g{og, (const bf16*)(ws + WS_WOUT) + (size_t)l * DM * DM, MP, DM, DM};
        pg8::StaticOrder S; S.init(MP, DM, G, bx);
        EpiResid E{xb, rss};
        if (G == 256) pg8::gemm_phase<EpiResid, pg8::StaticOrder, true, true, true>(lds, g, S, E);
        else { pg8::gemm_phase<EpiResid, pg8::StaticOrder, true, true>(lds, g, S, E);
               for (int t = bx; t < 256; t += G) small_gemm_tile(g.A, g.Bt, DM, MP + 64 * (t >> 4), 64 * (t & 15), E, lds); }
    } break;
    case 3: {
        pg8::Gemm g{xb, (const bf16*)(ws + WS_WXQ) + (size_t)l * DM * DM, MP, DM, DM};
        pg8::StaticOrder S; S.init(MP, DM, G, bx);
        EpiScaleBf16 E{qb, DM, rss, 0.0625f, nullptr, -1};
        if (G == 256) pg8::gemm_phase<EpiScaleBf16, pg8::StaticOrder, true, true, true>(lds, g, S, E);
        else { pg8::gemm_phase<EpiScaleBf16, pg8::StaticOrder, true, true>(lds, g, S, E);
               for (int t = bx; t < 256; t += G) small_gemm_tile(g.A, g.Bt, DM, MP + 64 * (t >> 4), 64 * (t & 15), E, lds); }
    } break;
    case 4: {
        const bf16* memK = (const bf16*)(ws + WS_MEMK) + (size_t)l * 2048 * 1024; const bf16* memVt = (const bf16*)(ws + WS_MEMVT) + (size_t)l * 2048 * 1024;
        const float* ck = P->in[I_CK] + (size_t)l * DECB * 256 * 1024; const float* cv = P->in[I_CV] + (size_t)l * DECB * 256 * 1024;
        if (G == 256 && HP_LEVEL < 4) {
            pg8::Unit u; unit_of_block256(bx, u);
            const int pt0 = (u.pm >> 3) * 64 + u.pn * 16 + 2 * (u.pm & 7), st = 4 * u.pm + u.pn;
            for (int i = 0; i < 3; ++i) {
                const int idx = (bx & 1) ? (i == 2 ? 0 : i + 1) : i;
                __syncthreads();
                if (idx == 0) { attn_sample_tile(qb, ck, cv, att, st, lds); for (int r_ = 0; r_ < DBG_S_REPS; ++r_) { __syncthreads(); attn_sample_tile(qb, ck, cv, att, st, lds); } }
                else { attn_prompt_tile(qb, memK, memVt, att, pt0 + idx - 1, lds); if (DBG_E_REP & 2) { __syncthreads(); attn_prompt_tile(qb, memK, memVt, att, pt0 + idx - 1, lds); } }
            }
        } else
        for (int task = ((G == 256 && HP_LEVEL >= 4) ? 256 + bx : bx); task < 256 + 512; task += G) {
            __syncthreads();
            if (task < 256) attn_sample_tile(qb, ck, cv, att, task, lds);
            else attn_prompt_tile(qb, memK, memVt, att, task - 256, lds);
        }
    } break;
    case 5: {
        pg8::Gemm g{att, (const bf16*)(ws + WS_WXO) + (size_t)l * DM * DM, MP, DM, DM};
        pg8::StaticOrder S; S.init(MP, DM, G, bx);
        EpiResid E{xb, rss};
        if (G == 256) pg8::gemm_phase<EpiResid, pg8::StaticOrder, true, true, true>(lds, g, S, E);
        else { pg8::gemm_phase<EpiResid, pg8::StaticOrder, true, true>(lds, g, S, E);
               for (int t = bx; t < 256; t += G) small_gemm_tile(g.A, g.Bt, DM, MP + 64 * (t >> 4), 64 * (t & 15), E, lds); }
    } break;
    case 6: {
        pg8::Gemm g{xb, (const bf16*)(ws + WS_WGU) + (size_t)l * NGU * DM, MT, NGU, DM};
        pg8::StaticOrder S; S.init(MT, NGU, G, bx);
        EpiGU E{hb, rss, nolo};
        pg8::gemm_phase<EpiGU, pg8::StaticOrder, true, true>(lds, g, S, E);
    } break;
    case 7: {
        pg8::Gemm g{hb, (const bf16*)(ws + WS_WDN) + (size_t)l * DM * DFF, MP, DM, DFF};
        pg8::StaticOrder S; S.init(MP, DM, G, bx);
        if (l == DEPTH - 1 && G == 256) {
            unsigned* fcnt = (unsigned*)(ws + WS_CTL) + 16384;
            EpiResidFinal E{xb, rss, fcnt, P->in[I_GFINAL], P->out + O_YP, ((volatile LAS unsigned*)(lds + LDS_BYTES - 64))[14] == 2u ? 1 : 0};
            pg8::gemm_phase<EpiResidFinal, pg8::StaticOrder, true, true, true>(lds, g, S, E);
        } else {
            EpiResid E{xb, rss};
            if (G == 256) pg8::gemm_phase<EpiResid, pg8::StaticOrder, true, true, true>(lds, g, S, E);
            else { pg8::gemm_phase<EpiResid, pg8::StaticOrder, true, true>(lds, g, S, E);
                   for (int t = bx; t < 256; t += G) small_gemm_tile(g.A, g.Bt, DFF, MP + 64 * (t >> 4), 64 * (t & 15), E, lds); }
        }
    } break;
    }
}

__device__ __forceinline__ void group_meet(PP P, const unsigned seq, LAS unsigned char* lds) {
    pg8::Unit u; unit_of_block256(blockIdx.x, u);
    unsigned* ctl = (unsigned*)(P->ws + WS_CTL);
    volatile LAS unsigned* gf = (volatile LAS unsigned*)(lds + LDS_BYTES - 64) + 14;
    unsigned f = gf[0];
    if (f == 0u) {
        __syncthreads();
        if (threadIdx.x == 0) { const unsigned mk = xb_ld(ctl + 31744 + u.pm); gf[0] = (mk != 0u && (mk & (mk - 1u)) == 0u) ? 2u : 3u; }
        __syncthreads();
        f = gf[0];
    }
    panel_meet(ctl + 25600 + 64 * u.pm, 4u * seq, f == 2u);
}

__global__ void __launch_bounds__(NTHREADS, 2) k_run(Params Pval) {
    PP P = get_params();
    extern __shared__ __attribute__((aligned(16))) unsigned char lds_raw[];
    LAS unsigned char* lds = (LAS unsigned char*)lds_raw;
    const int lo = P->ph_lo, hi = P->ph_hi;
#if USE_CG_SYNC
    cg::grid_group grid = cg::this_grid();
#define SEAM() grid.sync()
#else
    volatile LAS unsigned* bst = (volatile LAS unsigned*)(lds + LDS_BYTES - 64);
    if (threadIdx.x < 16) bst[threadIdx.x] = 0u;
    __syncthreads();
    XcdBarrier bar = xcd_barrier_post((unsigned*)(P->ws + WS_CTL), bst);
    if (threadIdx.x == 0 && gridDim.x == 256) { pg8::Unit u0; unit_of_block256(blockIdx.x, u0);
        (void)__hip_atomic_fetch_or((unsigned*)(P->ws + WS_CTL) + 31744 + u0.pm, 1u << xb_xcc_id(), __ATOMIC_RELAXED, __HIP_MEMORY_SCOPE_AGENT); }
#define SEAM() xcd_barrier(bar)
#endif
#ifndef REP_MASK
#define REP_MASK 0
#endif
#define GROUP_SEAM(k) ((k) == 4 ? 1 : (k) == 5 ? 2 : (k) == 6 ? 3 : (k) == 13 ? 4 : (k) == 14 ? 5 : (k) == 15 ? 6 : 0)
#define REPEAT(k) (((k) == 0 && (REP_MASK & 256)) || ((k) == 4 && (REP_MASK & 512)) || ((k) >= 1 && (k) <= 18 && rep_sub(((k) - 1) % 9)))
#ifndef DBG_PREFIX_K
#define DBG_PREFIX_K (-1)
#endif
#define N_PRE_MEETS ((4 < DBG_PREFIX_K) + (5 < DBG_PREFIX_K) + (6 < DBG_PREFIX_K) + (13 < DBG_PREFIX_K) + (14 < DBG_PREFIX_K) + (15 < DBG_PREFIX_K))
#define PREPASS(k) if ((k) <= DBG_PREFIX_K) { run_phase(get_params(), (k), lds); \
    if (((k) == 3 || (k) == 12) && gridDim.x == 256) { __syncthreads(); deferred_items(get_params(), (k) == 12 ? 1 : 0, lds, 1, 0); deferred_items(get_params(), (k) == 12 ? 1 : 0, lds, 1, 1); } \
    if (GROUP_SEAM(k) && gridDim.x == 256 && (k) < DBG_PREFIX_K) group_meet(get_params(), GROUP_SEAM(k), lds); else SEAM(); }
#define PHASE(k) if (lo <= (k) && (k) < hi) { if (REPEAT(k)) { run_phase(get_params(), (k) + (DBG_NOLO ? 100 : 0), lds); SEAM(); } \
    if (((k) == 3 || ((k) == 12 && DEFER_L1)) && gridDim.x == 256 && DEFER_ON && DEFER_SPLIT && blockIdx.x >= 128) { deferred_items(get_params(), (k) == 12 ? 1 : 0, lds, 0, 0); __syncthreads(); } \
    run_phase(get_params(), (k), lds); \
    if (((k) == 3 || ((k) == 12 && DEFER_L1)) && gridDim.x == 256 && DEFER_ON && !(blockIdx.x < 128 && (blockIdx.x & 15) >= 12)) { __syncthreads(); deferred_items(get_params(), (k) == 12 ? 1 : 0, lds, 0, 1); }         \
    if ((k) + 1 < hi) { if (GROUP_SEAM(k) && gridDim.x == 256) group_meet(get_params(), GROUP_SEAM(k) + N_PRE_MEETS, lds); else SEAM(); } }
#if DBG_PREFIX_K >= 0
    PREPASS(0) PREPASS(1) PREPASS(2) PREPASS(3) PREPASS(4) PREPASS(5) PREPASS(6) PREPASS(7) PREPASS(8) PREPASS(9) PREPASS(10) PREPASS(11) PREPASS(12) PREPASS(13) PREPASS(14) PREPASS(15) PREPASS(16) PREPASS(17)
#endif
    PHASE(0) PHASE(1) PHASE(2) PHASE(3) PHASE(4) PHASE(5) PHASE(6) PHASE(7) PHASE(8) PHASE(9) PHASE(10) PHASE(11) PHASE(12) PHASE(13) PHASE(14) PHASE(15) PHASE(16) PHASE(17) PHASE(18) PHASE(19)
#if DBG_EXTRA_BARS
    for (int i_ = 0; i_ < DBG_EXTRA_BARS; ++i_) SEAM();
#endif
#undef PHASE
#undef SEAM
    if (lo == 99) run_phase(get_params(), 199, lds);
}

#ifndef ONE_LAUNCH
#define ONE_LAUNCH 1
#endif

extern "C" void kernel_launch(void* const* d_in, const int* in_sizes, int n_in, void* d_out, int out_size, void* d_ws, size_t ws_size, hipStream_t stream) {
    static int grid = 0;
    if (grid == 0) {
        if (n_in != N_IN || (size_t)out_size != O_END || ws_size < WS_END) { fprintf(stderr, "kernel_launch: unexpected shapes n_in %d out %d ws %zu\n", n_in, out_size, ws_size); grid = -1; return; }
        int dev = 0, cus = 0, per_cu = 0;
        if (hipGetDevice(&dev) != hipSuccess || hipDeviceGetAttribute(&cus, hipDeviceAttributeMultiprocessorCount, dev) != hipSuccess) { grid = -1; return; }
        if (hipFuncSetAttribute((const void*)k_run, hipFuncAttributeMaxDynamicSharedMemorySize, LDS_BYTES) != hipSuccess) { fprintf(stderr, "kernel_launch: hipFuncSetAttribute failed\n"); grid = -1; return; }
        if (hipOccupancyMaxActiveBlocksPerMultiprocessor(&per_cu, (const void*)k_run, NTHREADS, LDS_BYTES) != hipSuccess || per_cu < 1) { fprintf(stderr, "kernel_launch: occupancy query says %d\n", per_cu); (void)hipGetLastError(); grid = -1; return; }
        grid = cus;
    }
    if (grid < 0) return;
    if (hipMemsetAsync((char*)d_ws + WS_CTL, 0, 131072, stream) != hipSuccess) { fprintf(stderr, "kernel_launch: memset failed\n"); return; }
    Params p{};
    for (int i = 0; i < N_IN; ++i) p.in[i] = (const float*)d_in[i];
    p.out = (float*)d_out; p.ws = (unsigned char*)d_ws;
#if ONE_LAUNCH
    p.ph_lo = 0; p.ph_hi = (grid == 256) ? N_PHASES - 1 : N_PHASES;
    void* args[] = {&p};
    hipError_t e = hipLaunchCooperativeKernel((const void*)k_run, dim3(grid), dim3(NTHREADS), args, LDS_BYTES, stream);
    if (e != hipSuccess) fprintf(stderr, "cooperative launch failed: %s (grid %d)\n", hipGetErrorString(e), grid);
#else
    for (int ph = 0; ph < (DBG_STOP ? DBG_STOP + 2 : N_PHASES); ++ph) {
        p.ph_lo = ph; p.ph_hi = ph + 1;
        if (DBG_STOP && ph == DBG_STOP + 1) { p.ph_lo = 99; p.ph_hi = 100; }
        hipLaunchKernelGGL(k_run, dim3(grid), dim3(NTHREADS), LDS_BYTES, stream, p);
    }
#endif
}
```

```cpp
#include <hip/hip_runtime.h>
#include <hip/hip_cooperative_groups.h>
#include <cstdio>
#include <cstdint>
namespace cg = cooperative_groups;
__device__ __forceinline__ int opaque_tid() { int t = threadIdx.x; asm volatile("" : "+v"(t)); return t; }
#define DBG_CHAIN 0
#define REP_MASK 0
#define DBG_REP_SAMPLE 0
#define DBG_DUP 0
#define DBG_VAR 0
#define DBG_TYPES 7
#define DBG_REPS 1
#define DBG_NOLO 0
#define DBG_EXTRA_BARS 0
#define DBG_UNIT_REPS 1
#ifndef DBG_SMALL_MODE
#define DBG_SMALL_MODE 0
#endif

namespace pg8 {
#define PG8_LAS __attribute__((address_space(3)))
typedef unsigned short bf16_t;
typedef short bf16x8 __attribute__((ext_vector_type(8)));
typedef float f32x4 __attribute__((ext_vector_type(4)));
typedef unsigned u32x4 __attribute__((ext_vector_type(4)));
constexpr int BM = 256, BK = 64, HALF = 128, HTB = HALF * BK * 2  , STAGE_BYTES = 8 * HTB, NXCD = 8, WGM = 8;

__host__ __device__ __forceinline__ int lds_byte(int r, int c) { const int st = (r >> 4) * 2 + (c >> 5), rr = r & 15, cc = c & 31, ob = rr * 64 + cc * 2; return st * 1024 + (ob ^ (((ob >> 9) & 1) << 5)); }
__host__ __device__ __forceinline__ void stage_rc(int b, int& R, int& C) { const int st = b / 1024, sb = b % 1024, swz = sb ^ (((sb >> 9) & 1) << 5); R = (st >> 1) * 16 + swz / 64; C = (st & 1) * 32 + (swz % 64) / 2; }
__host__ __device__ __forceinline__ int perm32(int rho) { const int n = rho >> 4, i = rho & 15; return 8 * (i >> 2) + 4 * n + (i & 3); }

struct Unit { int pm, pn; };
struct Gemm { const bf16_t* A; const bf16_t* Bt; int M, N, K; };

struct StaticOrder {
    int nM, nN, nwg, G, c;
    __host__ __device__ void init(int M, int N, int G_, int c_) { nM = M / BM; nN = N / BM; nwg = nM * nN; G = G_; c = c_; }
    __host__ __device__ bool next(int i, Unit& u) const {
        const long L = (long)i * G + c; if (L >= nwg) return false;
        int wgid = (int)L; { const int q = nwg / NXCD, r = nwg % NXCD, xcd = wgid % NXCD, off = wgid / NXCD; wgid = (xcd < r ? xcd * (q + 1) : r * (q + 1) + (xcd - r) * q) + off; }
        const int nig = WGM * nN, gid = wgid / nig, fm = gid * WGM, gsz = (nM - fm) < WGM ? (nM - fm) : WGM;
        u.pm = fm + ((wgid % nig) % gsz); u.pn = (wgid % nig) / gsz; return true;
    }
    __device__ __forceinline__ void a_ready(const Unit&) const {}
    __device__ __forceinline__ void done(const Unit&) const {}
};
template <class Epi, class Sched, bool ALIGN_EPI = false, bool SP2 = false, bool SROWS = false>
__device__ __forceinline__ void gemm_phase(PG8_LAS unsigned char* lds, const Gemm g, const Sched& S, const Epi& E) {
    const int tid = opaque_tid(), wid = __builtin_amdgcn_readfirstlane(tid >> 6), lane = tid & 63, wr = wid >> 2, wc = wid & 3, fr = lane & 15, fq = lane >> 4;
    const int K = g.K, nt = K / BK;
    unsigned voffA[2], voffB[2];
#pragma unroll
    for (int i = 0; i < 2; ++i) { int R, C; stage_rc(tid * 16 + i * 8192, R, C); const int Rb = Epi::PERM ? ((R & ~31) + perm32(R & 31)) : R;
        voffA[i] = (unsigned)(R * K + C) * 2u; voffB[i] = (unsigned)(Rb * K + C) * 2u; }
    const size_t kstep = (size_t)(BK * 2);
    const size_t hstep = (size_t)HALF * K * 2;
    const size_t tstep = 2 * hstep;
    const unsigned ldsw = (unsigned)wid * 1024u;
    const int aoff = lds_byte(wr * 64 + fr, fq * 8), boff = lds_byte(wc * 32 + fr, fq * 8);
#define PG8_SA(b, h) (((b) * 2 + (h)) * HTB)
#define PG8_SB(b, h) ((4 + (b) * 2 + (h)) * HTB)
#define PG8_STAGE(bufoff, gbase, voff) do { _Pragma("unroll") for (int _i = 0; _i < 2; ++_i) \
        __builtin_amdgcn_global_load_lds((const unsigned*)((const char*)(gbase) + (voff)[_i]), (PG8_LAS unsigned*)(lds + (bufoff) + ldsw + _i * 8192), 16, 0, 0); } while (0)
#define PG8_LDA(dst, b, h) do { _Pragma("unroll") for (int m = 0; m < 4; ++m) _Pragma("unroll") for (int k = 0; k < 2; ++k) dst[m][k] = *(const PG8_LAS bf16x8*)(lds + PG8_SA(b, h) + aoff + m * 2048 + k * 1024); } while (0)
#define PG8_LDB(dst, b, h) do { _Pragma("unroll") for (int n = 0; n < 2; ++n) _Pragma("unroll") for (int k = 0; k < 2; ++k) dst[n][k] = *(const PG8_LAS bf16x8*)(lds + PG8_SB(b, h) + boff + n * 2048 + k * 1024); } while (0)
#define PG8_MMA(ai, bj, At, Bt) do { __builtin_amdgcn_s_setprio(1); _Pragma("unroll") for (int m = 0; m < 4; ++m) _Pragma("unroll") for (int n = 0; n < 2; ++n) _Pragma("unroll") for (int k = 0; k < 2; ++k) \
        acc[ai][bj][m][n] = __builtin_amdgcn_mfma_f32_16x16x32_bf16(Bt[n][k], At[m][k], acc[ai][bj][m][n], 0, 0, 0); __builtin_amdgcn_s_setprio(0); } while (0)
#define PG8_WAIT_V(n) asm volatile("s_waitcnt vmcnt(" #n ")" ::: "memory")
#define PG8_WAIT_L(n) asm volatile("s_waitcnt lgkmcnt(" #n ")" ::: "memory")
#define PG8_BAR __builtin_amdgcn_s_barrier()
#define PG8_SCHED __builtin_amdgcn_sched_barrier(0)
    Unit cur, nxt; int ui = 0;
    if (!S.next(0, cur)) return;
    f32x4 acc[2][2][4][2];
#pragma unroll
    for (int a = 0; a < 2; ++a)
#pragma unroll
        for (int b = 0; b < 2; ++b)
#pragma unroll
            for (int m = 0; m < 4; ++m)
#pragma unroll
                for (int n = 0; n < 2; ++n) acc[a][b][m][n] = (f32x4){0.f, 0.f, 0.f, 0.f};
    bf16x8 At[4][2], B0[2][2], B1[2][2];
    f32x4 accS[2]; bf16x8 AsS[2]; const char* sA = (const char*)g.A; unsigned voffS = 0u;
    accS[0] = (f32x4){0.f, 0.f, 0.f, 0.f}; accS[1] = (f32x4){0.f, 0.f, 0.f, 0.f};
    AsS[0] = (bf16x8){0, 0, 0, 0, 0, 0, 0, 0}; AsS[1] = AsS[0];
#define PG8_SLOAD(tn) do { const char* pt_ = sA + (size_t)(tn) * 128; \
        asm volatile("global_load_dwordx4 %0, %1, %2" : "+v"(AsS[0]) : "v"(voffS), "s"(pt_) : "memory"); \
        asm volatile("global_load_dwordx4 %0, %1, %2 offset:64" : "+v"(AsS[1]) : "v"(voffS), "s"(pt_) : "memory"); } while (0)
#define PG8_SFENCE() do { if constexpr (SROWS) asm volatile("" : "+v"(AsS[0]), "+v"(AsS[1])); } while (0)
    if constexpr (SROWS) {
        static_assert(SP2, "SROWS needs the SP2 loop");
        sA = (const char*)g.A + (size_t)(g.M + 16 * cur.pm) * K * 2; voffS = (unsigned)(fr * K + fq * 8) * 2u;
        PG8_SLOAD(0);
    }
#define PG8_SMMA(tn) do { if constexpr (SROWS) { __builtin_amdgcn_s_setprio(1); \
        if (wr == 0) { _Pragma("unroll") for (int n = 0; n < 2; ++n) _Pragma("unroll") for (int k = 0; k < 2; ++k) accS[n] = __builtin_amdgcn_mfma_f32_16x16x32_bf16(B0[n][k], AsS[k], accS[n], 0, 0, 0); } \
        else         { _Pragma("unroll") for (int n = 0; n < 2; ++n) _Pragma("unroll") for (int k = 0; k < 2; ++k) accS[n] = __builtin_amdgcn_mfma_f32_16x16x32_bf16(B1[n][k], AsS[k], accS[n], 0, 0, 0); } \
        __builtin_amdgcn_s_setprio(0); \
        if ((tn) < nt) PG8_SLOAD(tn); } } while (0)
#define PG8_WAIT_V2(tn) do { if constexpr (SROWS) { if ((tn) < nt) PG8_WAIT_V(10); else PG8_WAIT_V(8); } else PG8_WAIT_V(8); } while (0)
    const char* cA = (const char*)g.A + (size_t)cur.pm * tstep; const char* cB = (const char*)g.Bt + (size_t)cur.pn * tstep;
    S.a_ready(cur);
    if constexpr (SP2) {
        PG8_STAGE(PG8_SB(0, 0), cB, voffB); PG8_STAGE(PG8_SB(0, 1), cB + hstep, voffB); PG8_STAGE(PG8_SA(0, 0), cA, voffA); PG8_STAGE(PG8_SA(0, 1), cA + hstep, voffA);
        if (wr == 1) PG8_BAR;
        PG8_WAIT_V(2); PG8_BAR;
        PG8_STAGE(PG8_SB(1, 0), cB + kstep, voffB); PG8_STAGE(PG8_SA(1, 0), cA + kstep, voffA); PG8_STAGE(PG8_SB(1, 1), cB + hstep + kstep, voffB);
        PG8_WAIT_V(6); PG8_BAR;
    } else {
        PG8_STAGE(PG8_SB(0, 0), cB, voffB); PG8_STAGE(PG8_SA(0, 0), cA, voffA); PG8_STAGE(PG8_SB(0, 1), cB + hstep, voffB); PG8_STAGE(PG8_SA(0, 1), cA + hstep, voffA);
        if (wr == 1) PG8_BAR;
        PG8_WAIT_V(4); PG8_BAR;
        PG8_STAGE(PG8_SB(1, 0), cB + kstep, voffB); PG8_STAGE(PG8_SA(1, 0), cA + kstep, voffA); PG8_STAGE(PG8_SB(1, 1), cB + hstep + kstep, voffB);
        PG8_WAIT_V(6); PG8_BAR;
    }
    for (;;) {
        const bool has_next = S.next(ui + 1, nxt);
        const char* nA = has_next ? (const char*)g.A + (size_t)nxt.pm * tstep : cA; const char* nB = has_next ? (const char*)g.Bt + (size_t)nxt.pn * tstep : cB;
        for (int t = 0; t < nt; t += 2) {
            const bool last = (t == nt - 2);
            const char* a1 = cA + (size_t)(t + 1) * kstep;
            const char* a2 = last ? nA : cA + (size_t)(t + 2) * kstep; const char* b2 = last ? nB : cB + (size_t)(t + 2) * kstep;
            const char* a3 = a2 + kstep; const char* b3 = b2 + kstep;
            if (last && has_next) S.a_ready(nxt);
            if constexpr (SP2) {
            PG8_LDB(B0, 0, 0); PG8_LDB(B1, 0, 1); PG8_SCHED; PG8_LDA(At, 0, 0); PG8_STAGE(PG8_SA(1, 1), a1 + hstep, voffA);
            PG8_WAIT_V(8); PG8_WAIT_L(0); PG8_BAR; PG8_SFENCE(); PG8_MMA(0, 0, At, B0); PG8_MMA(0, 1, At, B1); PG8_SMMA(t + 1); PG8_BAR; PG8_SCHED;
            PG8_LDA(At, 0, 1); PG8_STAGE(PG8_SB(0, 0), b2, voffB); PG8_STAGE(PG8_SB(0, 1), b2 + hstep, voffB); PG8_STAGE(PG8_SA(0, 0), a2, voffA);
            PG8_WAIT_V2(t + 1); PG8_WAIT_L(0); PG8_BAR; PG8_MMA(1, 0, At, B0); PG8_MMA(1, 1, At, B1); PG8_BAR; PG8_SCHED;
            PG8_LDB(B0, 1, 0); PG8_LDB(B1, 1, 1); PG8_SCHED; PG8_LDA(At, 1, 0); PG8_STAGE(PG8_SA(0, 1), a2 + hstep, voffA);
            PG8_WAIT_V(8); PG8_WAIT_L(0); PG8_BAR; PG8_SFENCE(); PG8_MMA(0, 0, At, B0); PG8_MMA(0, 1, At, B1); PG8_SMMA(t + 2); PG8_BAR; PG8_SCHED;
            PG8_LDA(At, 1, 1); PG8_STAGE(PG8_SB(1, 0), b3, voffB); PG8_STAGE(PG8_SB(1, 1), b3 + hstep, voffB); PG8_STAGE(PG8_SA(1, 0), a3, voffA);
            PG8_WAIT_V2(t + 2); PG8_WAIT_L(0); PG8_BAR; PG8_MMA(1, 0, At, B0); PG8_MMA(1, 1, At, B1); PG8_BAR; PG8_SCHED;
            } else {
            PG8_LDB(B0, 0, 0); PG8_SCHED; PG8_LDA(At, 0, 0); PG8_STAGE(PG8_SA(1, 1), a1 + hstep, voffA);
            PG8_WAIT_L(8); PG8_BAR; PG8_WAIT_L(0); PG8_MMA(0, 0, At, B0); PG8_BAR; PG8_SCHED;
            PG8_LDB(B1, 0, 1); PG8_STAGE(PG8_SB(0, 0), b2, voffB);
            PG8_BAR; PG8_WAIT_L(0); PG8_MMA(0, 1, At, B1); PG8_BAR;
            PG8_LDA(At, 0, 1); PG8_STAGE(PG8_SA(0, 0), a2, voffA);
            PG8_BAR; PG8_WAIT_L(0); PG8_MMA(1, 0, At, B0); PG8_BAR; PG8_SCHED;
            PG8_STAGE(PG8_SB(0, 1), b2 + hstep, voffB);
            PG8_WAIT_V(6); PG8_BAR; PG8_MMA(1, 1, At, B1); PG8_BAR;
            PG8_LDB(B0, 1, 0); PG8_SCHED; PG8_LDA(At, 1, 0); PG8_STAGE(PG8_SA(0, 1), a2 + hstep, voffA);
            PG8_WAIT_L(8); PG8_BAR; PG8_WAIT_L(0); PG8_MMA(0, 0, At, B0); PG8_BAR; PG8_SCHED;
            PG8_LDB(B1, 1, 1); PG8_STAGE(PG8_SB(1, 0), b3, voffB);
            PG8_BAR; PG8_WAIT_L(0); PG8_MMA(0, 1, At, B1); PG8_BAR;
            PG8_LDA(At, 1, 1); PG8_STAGE(PG8_SA(1, 0), a3, voffA);
            PG8_BAR; PG8_WAIT_L(0); PG8_MMA(1, 0, At, B0); PG8_BAR; PG8_SCHED;
            PG8_STAGE(PG8_SB(1, 1), b3 + hstep, voffB);
            PG8_WAIT_V(6); PG8_BAR; PG8_MMA(1, 1, At, B1); PG8_BAR;
            }
        }
        if constexpr (ALIGN_EPI) { if (wr == 0) PG8_BAR; }
        if constexpr (!Epi::AFTER_DRAIN) { E(acc, cur, wr, wc, fr, fq); S.done(cur); }
        if (!has_next) break;
#pragma unroll
        for (int a = 0; a < 2; ++a)
#pragma unroll
            for (int b = 0; b < 2; ++b)
#pragma unroll
                for (int m = 0; m < 4; ++m)
#pragma unroll
                    for (int n = 0; n < 2; ++n) acc[a][b][m][n] = (f32x4){0.f, 0.f, 0.f, 0.f};
        cur = nxt; cA = nA; cB = nB; ++ui;
        if constexpr (ALIGN_EPI) { if (wr == 1) PG8_BAR; }
    }
    PG8_WAIT_V(0);
    if constexpr (!ALIGN_EPI) { if (wr == 0) PG8_BAR; }
    PG8_BAR;
    if constexpr (Epi::AFTER_DRAIN) { E.fused(acc, accS, SROWS, cur, wr, wc, fr, fq, lds, wid, lane); S.done(cur); }
    else if constexpr (SROWS) E.sample16(accS, cur, wr, wc, fr, fq, lds, wid);
#undef PG8_SMMA
#undef PG8_SLOAD
#undef PG8_SFENCE
#undef PG8_WAIT_V2
#undef PG8_SA
#undef PG8_SB
#undef PG8_STAGE
#undef PG8_LDA
#undef PG8_LDB
#undef PG8_MMA
#undef PG8_WAIT_V
#undef PG8_WAIT_L
#undef PG8_BAR
#undef PG8_SCHED
}
}
#define LAS __attribute__((address_space(3)))
typedef unsigned short bf16;
typedef short bf16x8 __attribute__((ext_vector_type(8)));
typedef float f32x4 __attribute__((ext_vector_type(4)));
typedef unsigned u32x4 __attribute__((ext_vector_type(4)));
typedef unsigned u32x2 __attribute__((ext_vector_type(2)));

constexpr int DM = 1024, NB = 8, SEQ = 2048, DEPTH = 2, DECB = 128, DECT = 8;
constexpr int MP = NB * SEQ, MS = DECB * DECT, MT = MP + MS;
constexpr int NPROJ = 3840;
constexpr int DFF = 2816, NGU = 2 * DFF;
constexpr int NMEM = 256, XH = 4, XHD = 256;
constexpr float EPS = 1e-6f;
constexpr int C_QR = 0, C_KR = 384, C_VR = 768, C_GR = 1152, C_QG = 1536, C_KG = 1728, C_VG = 1920, C_RG = 2304;
constexpr int C_QKM = 2688, C_VM = 3200, C_OM = 3456, C_GATES = 3712;
enum { I_XP = 0, I_XS, I_SRET, I_SGLA, I_SC, I_SN, I_SM, I_SCONV, I_CK, I_CV, I_MEMP, I_GMIX, I_WIN, I_WGA2, I_BGA, I_CONVW, I_CONVB, I_BI, I_BF,
       I_GRET, I_GGLA, I_GMLSTM, I_WOUT, I_GXATTN, I_GMEM, I_WXQ, I_WXK, I_WXV, I_WXO, I_GFFN, I_WGATE, I_WUP, I_WDOWN, I_GFINAL, N_IN };
constexpr size_t O_YP = 0, O_YS = O_YP + (size_t)MP * DM, O_PRET = O_YS + (size_t)MS * DM, O_PGLA = O_PRET + 2 * 8 * 6 * 64 * 64,
                 O_PC = O_PGLA + 2 * 8 * 6 * 32 * 64, O_PN = O_PC + 2 * 8 * 4 * 64 * 64, O_PM = O_PN + 2 * 8 * 4 * 64, O_PCONV = O_PM + 2 * 8 * 4,
                 O_PMK = O_PCONV + 2 * 8 * 3 * 512, O_PMV = O_PMK + (size_t)2 * 8 * 256 * 1024, O_SRET = O_PMV + (size_t)2 * 8 * 256 * 1024,
                 O_SGLA = O_SRET + (size_t)2 * 128 * 6 * 64 * 64, O_SC = O_SGLA + (size_t)2 * 128 * 6 * 32 * 64, O_SN = O_SC + (size_t)2 * 128 * 4 * 64 * 64,
                 O_SM = O_SN + 2 * 128 * 4 * 64, O_SCONV = O_SM + 2 * 128 * 4, O_END = O_SCONV + 2 * 128 * 3 * 512;
constexpr size_t MiB = 1u << 20;
constexpr size_t WS_CTL = 0, CTL_BYTES = 1 * MiB;
constexpr size_t WS_WIN = 1 * MiB, WS_WOUT = 16 * MiB, WS_WXQ = 20 * MiB, WS_WXO = 24 * MiB, WS_WXKV = 28 * MiB, WS_WGU = 36 * MiB, WS_WDN = 58 * MiB;
constexpr size_t WS_ROPE = 69 * MiB, WS_RSS = 70 * MiB, WS_RMEM = 72 * MiB, WS_MEMB = 73 * MiB, WS_MEMK = 77 * MiB, WS_MEMVT = 85 * MiB, WS_PROJG = 93 * MiB;
constexpr size_t WS_XB = 96 * MiB, WS_XF = 130 * MiB, WS_PROJ = 198 * MiB, WS_O = 326 * MiB, WS_Q = 360 * MiB, WS_ATT = 394 * MiB, WS_H = 428 * MiB;
constexpr size_t WS_QKC = 522 * MiB, WS_GM = 538 * MiB, WS_CM = 539 * MiB, WS_GQ = 540 * MiB, WS_GK = 546 * MiB, WS_GKT = 552 * MiB, WS_GBL = 558 * MiB, WS_END = 559 * MiB;
static_assert(WS_WIN + (size_t)2 * NPROJ * DM * 2 <= WS_WOUT && WS_WGU + (size_t)2 * NGU * DM * 2 <= WS_WDN && WS_WDN + (size_t)2 * DM * DFF * 2 <= WS_ROPE, "ws map");
static_assert(WS_XB + (size_t)MT * DM * 2 <= WS_XF && WS_XF + (size_t)MT * DM * 4 <= WS_PROJ && WS_PROJ + (size_t)MT * NPROJ * 2 <= WS_O && WS_H + (size_t)MT * DFF * 2 <= WS_QKC, "ws map 2");
constexpr int LDS_BYTES = 147456;
constexpr int NTHREADS = 512;

struct Params { const float* in[N_IN]; float* out; unsigned char* ws; int ph_lo, ph_hi; };
typedef const __attribute__((address_space(4))) Params* PP;
__device__ __forceinline__ PP get_params() { PP p = (PP)__builtin_amdgcn_kernarg_segment_ptr(); asm volatile("" : "+s"(p)); return p; }

__device__ __forceinline__ float bf2f(unsigned short b) { return __uint_as_float(((unsigned)b) << 16); }
typedef __bf16 bf16x2_t __attribute__((ext_vector_type(2)));
__device__ __forceinline__ unsigned pk2(float lo, float hi) { bf16x2_t v = {(__bf16)lo, (__bf16)hi}; return __builtin_bit_cast(unsigned, v); }
__device__ __forceinline__ unsigned short f2bf(float f) { return __builtin_bit_cast(unsigned short, (__bf16)f); }
__device__ __forceinline__ float wave_sum(float v) {
#pragma unroll
    for (int o = 1; o < 64; o <<= 1) v += __shfl_xor(v, o);
    return v;
}
template <int CTRL, int ROW_MASK>
__device__ __forceinline__ float dpp_f(float oldv, float src) {
    return __builtin_bit_cast(float, __builtin_amdgcn_update_dpp(__builtin_bit_cast(int, oldv), __builtin_bit_cast(int, src), CTRL, ROW_MASK, 0xf, false));
}
__device__ __forceinline__ float scan_sum(float v, int lane) {
    (void)lane;
    v += dpp_f<0x111, 0xf>(0.f, v); v += dpp_f<0x112, 0xf>(0.f, v); v += dpp_f<0x114, 0xf>(0.f, v); v += dpp_f<0x118, 0xf>(0.f, v);
    v += dpp_f<0x142, 0xa>(0.f, v); v += dpp_f<0x143, 0xc>(0.f, v);
    return v;
}
__device__ __forceinline__ float scan_max(float v, int lane) {
    (void)lane;
    const float ninf = -3.0e38f;
    v = fmaxf(v, dpp_f<0x111, 0xf>(ninf, v)); v = fmaxf(v, dpp_f<0x112, 0xf>(ninf, v)); v = fmaxf(v, dpp_f<0x114, 0xf>(ninf, v)); v = fmaxf(v, dpp_f<0x118, 0xf>(ninf, v));
    v = fmaxf(v, dpp_f<0x142, 0xa>(ninf, v)); v = fmaxf(v, dpp_f<0x143, 0xc>(ninf, v));
    return v;
}
__device__ __forceinline__ float log_sigmoid(float x) { return fminf(x, 0.f) - log1pf(expf(-fabsf(x))); }
__device__ __forceinline__ float sigmoidf(float x) { return 1.f / (1.f + expf(-x)); }
__device__ __forceinline__ float siluf(float x) { return x / (1.f + expf(-x)); }
__device__ __forceinline__ f32x4 mma16(bf16x8 x, bf16x8 y, f32x4 c) { return __builtin_amdgcn_mfma_f32_16x16x32_bf16(x, y, c, 0, 0, 0); }
__device__ __forceinline__ bf16x8 lfrag(const LAS unsigned char* base, int row, int ld, int k) { return *(const LAS bf16x8*)(base + ((size_t)row * ld + k) * 2); }
#define XB_TMO      128
#define XB_XCNT(j)  (256  + 64 * (j))
#define XB_XSUB(j)  (1280 + 64 * (j))
#define XB_XGEN(j)  (2304 + 64 * (j))
#define XB_TOP      3328
#define XB_TOPGEN   3392
#define XCD_BAR_WORDS 3456
#define XB_SPIN_CAP (1u << 18)

__device__ __forceinline__ unsigned xb_ld(unsigned* p)              { return __hip_atomic_load(p, __ATOMIC_RELAXED, __HIP_MEMORY_SCOPE_AGENT); }
__device__ __forceinline__ unsigned xb_add(unsigned* p, unsigned v) { return __hip_atomic_fetch_add(p, v, __ATOMIC_RELAXED, __HIP_MEMORY_SCOPE_AGENT); }
__device__ __forceinline__ unsigned xb_xcc_id() { return (unsigned)__builtin_amdgcn_s_getreg((3 << 11) | 20) & 0xFu; }
#define XB_SPIN(cond, bar) do { unsigned _sp = 0; while (cond) { __builtin_amdgcn_s_sleep(1); \
    if ((++_sp & 255u) == 0u) { if (xb_ld(&(bar)[XB_TMO])) break; if (_sp > XB_SPIN_CAP) { atomicAdd(&(bar)[XB_TMO], 1u); break; } } } } while (0)

struct XcdBarrier {
    unsigned* bar; unsigned x;
    volatile LAS unsigned* st;
};

__device__ __forceinline__ XcdBarrier xcd_barrier_post(unsigned* bar, volatile LAS unsigned* st) {
    XcdBarrier b; b.bar = bar; b.x = xb_xcc_id(); b.st = st;
    if (threadIdx.x == 0) (void)xb_add(&bar[XB_XCNT(b.x)], 1u);
    return b;
}
__device__ __forceinline__ void xcd_barrier_complete(unsigned* bar, unsigned x, unsigned& nloc, unsigned& nx) {
    const unsigned G = gridDim.x * gridDim.y * gridDim.z;
    unsigned sum, cnt, mine, sp = 0u;
    for (;;) {
        sum = 0u; cnt = 0u; mine = 0u;
#pragma unroll
        for (unsigned j = 0; j < 16; ++j) { const unsigned c = xb_ld(&bar[XB_XCNT(j)]); sum += c; cnt += (c > 0u) ? 1u : 0u; mine = (j == x) ? c : mine; }
        if (sum == G) break;
        __builtin_amdgcn_s_sleep(1);
        if ((++sp & 255u) == 0u) { if (xb_ld(&bar[XB_TMO])) break; if (sp > XB_SPIN_CAP) { atomicAdd(&bar[XB_TMO], 1u); break; } }
    }
    nloc = mine > 0u ? mine : 1u; nx = cnt > 0u ? cnt : 1u;
}

__device__ __forceinline__ void xcd_barrier(const XcdBarrier& b) {
    asm volatile("s_waitcnt vmcnt(0)" ::: "memory");
    __syncthreads();
    if (threadIdx.x == 0) {
        unsigned* bar = b.bar;
        __builtin_amdgcn_s_waitcnt(0);
        unsigned nloc = b.st[0], nx = b.st[1];
        if (nloc == 0u) { xcd_barrier_complete(bar, b.x, nloc, nx); b.st[0] = nloc; b.st[1] = nx; }
        const unsigned old = xb_add(&bar[XB_XSUB(b.x)], 1u);
        const unsigned gen = old / nloc;
        if (old + 1u == (gen + 1u) * nloc) {
            __builtin_amdgcn_fence(__ATOMIC_RELEASE, "agent");
            asm volatile("s_waitcnt vmcnt(0)" ::: "memory");
            const unsigned og = xb_add(&bar[XB_TOP], 1u);
            const unsigned tg = og / nx;
            if (og + 1u == (tg + 1u) * nx) xb_add(&bar[XB_TOPGEN], 1u);
            else XB_SPIN(xb_ld(&bar[XB_TOPGEN]) == tg, bar);
            __builtin_amdgcn_fence(__ATOMIC_ACQUIRE, "agent");
            xb_add(&bar[XB_XGEN(b.x)], 1u);
            asm volatile("s_waitcnt vmcnt(0)" ::: "memory");
        } else {
            XB_SPIN(xb_ld(&bar[XB_XGEN(b.x)]) == gen, bar);
            __builtin_amdgcn_fence(__ATOMIC_ACQUIRE, "agent");
            asm volatile("s_waitcnt vmcnt(0)" ::: "memory");
        }
    }
    __syncthreads();
}
#define HLP_PARTS 128u
#define HB_SPIN_CAP (1u << 18)

__device__ __forceinline__ unsigned hb_ld(unsigned* p)              { return __hip_atomic_load(p, __ATOMIC_RELAXED, __HIP_MEMORY_SCOPE_AGENT); }
__device__ __forceinline__ unsigned hb_add(unsigned* p, unsigned v) { return __hip_atomic_fetch_add(p, v, __ATOMIC_RELAXED, __HIP_MEMORY_SCOPE_AGENT); }
__device__ __forceinline__ unsigned hb_xcc_id() { return (unsigned)__builtin_amdgcn_s_getreg((3 << 11) | 20) & 0xFu; }
#define HB_SPIN(cond, bar) do { unsigned _sp = 0; while (cond) { __builtin_amdgcn_s_sleep(1); \
    if ((++_sp & 255u) == 0u) { if (hb_ld(&(bar)[XB_TMO])) break; if (_sp > HB_SPIN_CAP) { atomicAdd(&(bar)[XB_TMO], 1u); break; } } } } while (0)

struct HlpBarrier {
    unsigned* bar; unsigned x;
    volatile LAS unsigned* st;
};

__device__ __forceinline__ HlpBarrier hlp_barrier_post(unsigned* bar, volatile LAS unsigned* st) {
    HlpBarrier b; b.bar = bar; b.x = hb_xcc_id(); b.st = st;
    if (threadIdx.x == 0) (void)hb_add(&bar[XB_XCNT(b.x)], 1u);
    return b;
}
__device__ __forceinline__ void hlp_barrier_complete(unsigned* bar, unsigned x, unsigned& nloc, unsigned& nx) {
    const unsigned G = HLP_PARTS;
    unsigned sum, cnt, mine, sp = 0u;
    for (;;) {
        sum = 0u; cnt = 0u; mine = 0u;
#pragma unroll
        for (unsigned j = 0; j < 16; ++j) { const unsigned c = hb_ld(&bar[XB_XCNT(j)]); sum += c; cnt += (c > 0u) ? 1u : 0u; mine = (j == x) ? c : mine; }
        if (sum == G) break;
        __builtin_amdgcn_s_sleep(1);
        if ((++sp & 255u) == 0u) { if (hb_ld(&bar[XB_TMO])) break; if (sp > HB_SPIN_CAP) { atomicAdd(&bar[XB_TMO], 1u); break; } }
    }
    nloc = mine > 0u ? mine : 1u; nx = cnt > 0u ? cnt : 1u;
}

__device__ __forceinline__ void hlp_barrier(const HlpBarrier& b) {
    asm volatile("s_waitcnt vmcnt(0)" ::: "memory");
    __syncthreads();
    if (threadIdx.x == 0) {
        unsigned* bar = b.bar;
        __builtin_amdgcn_s_waitcnt(0);
        unsigned nloc = b.st[0], nx = b.st[1];
        if (nloc == 0u) { hlp_barrier_complete(bar, b.x, nloc, nx); b.st[0] = nloc; b.st[1] = nx; }
        const unsigned old = hb_add(&bar[XB_XSUB(b.x)], 1u);
        const unsigned gen = old / nloc;
        if (old + 1u == (gen + 1u) * nloc) {
            __builtin_amdgcn_fence(__ATOMIC_RELEASE, "agent");
            asm volatile("s_waitcnt vmcnt(0)" ::: "memory");
            const unsigned og = hb_add(&bar[XB_TOP], 1u);
            const unsigned tg = og / nx;
            if (og + 1u == (tg + 1u) * nx) hb_add(&bar[XB_TOPGEN], 1u);
            else HB_SPIN(hb_ld(&bar[XB_TOPGEN]) == tg, bar);
            __builtin_amdgcn_fence(__ATOMIC_ACQUIRE, "agent");
            hb_add(&bar[XB_XGEN(b.x)], 1u);
            asm volatile("s_waitcnt vmcnt(0)" ::: "memory");
        } else {
            HB_SPIN(hb_ld(&bar[XB_XGEN(b.x)]) == gen, bar);
            __builtin_amdgcn_fence(__ATOMIC_ACQUIRE, "agent");
            asm volatile("s_waitcnt vmcnt(0)" ::: "memory");
        }
    }
    __syncthreads();
}
struct SmallPre { f32x4 v[4]; };
__device__ __forceinline__ float row_rscale(const float* rss, int row) {
    const f32x4* p = (const f32x4*)(rss + (size_t)row * 16);
    const f32x4 a = p[0], b = p[1], c = p[2], d = p[3];
    const float s = (((a.x + a.y) + (a.z + a.w)) + ((b.x + b.y) + (b.z + b.w))) + (((c.x + c.y) + (c.z + c.w)) + ((d.x + d.y) + (d.z + d.w)));
    return rsqrtf(s * (1.0f / 1024.0f) + EPS);
}
__device__ __forceinline__ void rows_rscale8(const float* rss, int row0, int fq, float (&r)[2][4]) {
    f32x4 p[2][4];
#pragma unroll
    for (int ai = 0; ai < 2; ++ai)
#pragma unroll
        for (int m = 0; m < 4; ++m) p[ai][m] = *(const f32x4*)(rss + (size_t)(row0 + ai * 128 + m * 16) * 16 + 4 * fq);
#pragma unroll
    for (int ai = 0; ai < 2; ++ai)
#pragma unroll
        for (int m = 0; m < 4; ++m) {
            float s = (p[ai][m][0] + p[ai][m][1]) + (p[ai][m][2] + p[ai][m][3]);
            s += __shfl_xor(s, 16); s += __shfl_xor(s, 32);
            r[ai][m] = rsqrtf(s * (1.0f / 1024.0f) + EPS);
        }
}
struct ListOrder {
    int first, end, stride, nN;
    __device__ __forceinline__ bool next(int i, pg8::Unit& u) const { const int idx = first + i * stride; if (idx >= end) return false; u.pm = idx / nN; u.pn = idx % nN; return true; }
    __device__ __forceinline__ void a_ready(const pg8::Unit&) const {}
    __device__ __forceinline__ void done(const pg8::Unit&) const {}
};
template <int REPS> struct RepeatOrder {
    pg8::StaticOrder S;
    __device__ __forceinline__ bool next(int i, pg8::Unit& u) const { return S.next(i / REPS, u); }
    __device__ __forceinline__ void a_ready(const pg8::Unit&) const {}
    __device__ __forceinline__ void done(const pg8::Unit&) const {}
};
struct EpiScaleBf16 {
    static constexpr bool PERM = true, AFTER_DRAIN = false;
    bf16* O; int ldc; const float* rss; float mul; float* projg; int gate_pn; int nolo = 0;
    __device__ __forceinline__ void operator()(const f32x4 (&acc)[2][2][4][2], const pg8::Unit& u, int wr, int wc, int fr, int fq) const {
        const int row0 = u.pm * 256 + wr * 64 + fr, col0 = u.pn * 256 + wc * 32 + 8 * fq;
        const bool gates = (u.pn == gate_pn) && (wc == 0);
        float rr[2][4];
        if (nolo) {
#pragma unroll
            for (int a = 0; a < 2; ++a)
#pragma unroll
                for (int b = 0; b < 4; ++b) rr[a][b] = 1.f; }
        else rows_rscale8(rss, row0, fq, rr);
#pragma unroll
        for (int ai = 0; ai < 2; ++ai)
#pragma unroll
            for (int m = 0; m < 4; ++m) {
                const int row = row0 + ai * 128 + m * 16;
                const float r = rr[ai][m] * mul;
                bf16* rowp = O + (size_t)row * ldc + col0;
#pragma unroll
                for (int bj = 0; bj < 2; ++bj) {
                    const f32x4 v0 = acc[ai][bj][m][0] * r, v1 = acc[ai][bj][m][1] * r;
                    u32x4 w; w.x = pk2(v0[0], v0[1]); w.y = pk2(v0[2], v0[3]); w.z = pk2(v1[0], v1[1]); w.w = pk2(v1[2], v1[3]);
                    *(u32x4*)(rowp + bj * 128) = w;
                    if (bj == 1 && gates) { float* gp = projg + (size_t)row * 32 + 8 * fq; *(f32x4*)gp = v0; *(f32x4*)(gp + 4) = v1; }
                }
            }
    }
    __device__ __forceinline__ void sample16(const f32x4 (&accS)[2], const pg8::Unit& u, int wr, int wc, int fr, int fq, LAS unsigned char*, int) const {
        const int row = MP + 16 * u.pm + fr, col0 = u.pn * 256 + wr * 128 + wc * 32 + 8 * fq;
        const f32x4 p = *(const f32x4*)(rss + (size_t)row * 16 + 4 * fq);
        float s = (p[0] + p[1]) + (p[2] + p[3]);
        s += __shfl_xor(s, 16); s += __shfl_xor(s, 32);
        const float r = rsqrtf(s * (1.0f / 1024.0f) + EPS) * mul;
        const f32x4 v0 = accS[0] * r, v1 = accS[1] * r;
        u32x4 w; w.x = pk2(v0[0], v0[1]); w.y = pk2(v0[2], v0[3]); w.z = pk2(v1[0], v1[1]); w.w = pk2(v1[2], v1[3]);
        *(u32x4*)(O + (size_t)row * ldc + col0) = w;
    }
    __device__ __forceinline__ void small_load(SmallPre& pre, int row, int, int) const {
        const f32x4* p = (const f32x4*)(rss + (size_t)row * 16);
#pragma unroll
        for (int i = 0; i < 4; ++i) pre.v[i] = p[i];
    }
    __device__ __forceinline__ void small(const f32x4 (&acc)[4], const SmallPre& pre, int row, int n0, int l4) const {
        const f32x4 a = pre.v[0], b = pre.v[1], c = pre.v[2], d = pre.v[3];
        const float s = (((a.x + a.y) + (a.z + a.w)) + ((b.x + b.y) + (b.z + b.w))) + (((c.x + c.y) + (c.z + c.w)) + ((d.x + d.y) + (d.z + d.w)));
        const float r = rsqrtf(s * (1.0f / 1024.0f) + EPS) * mul;
#pragma unroll
        for (int t = 0; t < 4; ++t) { const f32x4 v = acc[t] * r; u32x2 w; w.x = pk2(v[0], v[1]); w.y = pk2(v[2], v[3]); *(u32x2*)(O + (size_t)row * ldc + n0 + 16 * t + 4 * l4) = w; }
    }
};
__device__ __forceinline__ f32x4 bf4_to_f32(const u32x2 w) { return (f32x4){__uint_as_float(w.x << 16), __uint_as_float(w.x & 0xffff0000u), __uint_as_float(w.y << 16), __uint_as_float(w.y & 0xffff0000u)}; }
struct EpiResid {
    static constexpr bool PERM = true, AFTER_DRAIN = false;
    bf16* xb; float* rss;
    __device__ __forceinline__ void operator()(const f32x4 (&acc)[2][2][4][2], const pg8::Unit& u, int wr, int wc, int fr, int fq) const {
        const int row0 = u.pm * 256 + wr * 64 + fr, col0 = u.pn * 256 + wc * 32 + 8 * fq;
#pragma unroll
        for (int ai = 0; ai < 2; ++ai) {
            u32x4 bv[4][2];
#pragma unroll
            for (int m = 0; m < 4; ++m) {
                const bf16* bp = xb + (size_t)(row0 + ai * 128 + m * 16) * DM + col0;
#pragma unroll
                for (int bj = 0; bj < 2; ++bj) bv[m][bj] = *(const u32x4*)(bp + bj * 128);
            }
            asm volatile("" ::: "memory");
#pragma unroll
            for (int m = 0; m < 4; ++m) {
                const int row = row0 + ai * 128 + m * 16;
                bf16* bbp = xb + (size_t)row * DM + col0;
                float ss = 0.f;
#pragma unroll
                for (int bj = 0; bj < 2; ++bj) {
                    u32x2 lo; lo.x = bv[m][bj].x; lo.y = bv[m][bj].y; u32x2 hi; hi.x = bv[m][bj].z; hi.y = bv[m][bj].w;
                    const f32x4 v0 = bf4_to_f32(lo) + acc[ai][bj][m][0], v1 = bf4_to_f32(hi) + acc[ai][bj][m][1];
                    u32x4 w; w.x = pk2(v0[0], v0[1]); w.y = pk2(v0[2], v0[3]); w.z = pk2(v1[0], v1[1]); w.w = pk2(v1[2], v1[3]);
                    *(u32x4*)(bbp + bj * 128) = w;
                    ss += ((v0[0] * v0[0] + v0[1] * v0[1]) + (v0[2] * v0[2] + v0[3] * v0[3])) + ((v1[0] * v1[0] + v1[1] * v1[1]) + (v1[2] * v1[2] + v1[3] * v1[3]));
                }
                ss += __shfl_xor(ss, 16); ss += __shfl_xor(ss, 32);
                if (fq == 0) rss[(size_t)row * 16 + u.pn * 4 + wc] = ss;
            }
            asm volatile("" ::: "memory");
        }
    }
    __device__ __forceinline__ void sample16(const f32x4 (&accS)[2], const pg8::Unit& u, int wr, int wc, int fr, int fq, LAS unsigned char* lds, int wid) const {
        const int row = MP + 16 * u.pm + fr, col0 = u.pn * 256 + wr * 128 + wc * 32 + 8 * fq;
        bf16* bbp = xb + (size_t)row * DM + col0;
        const u32x4 bw = *(const u32x4*)bbp;
        u32x2 lo; lo.x = bw.x; lo.y = bw.y; u32x2 hi; hi.x = bw.z; hi.y = bw.w;
        const f32x4 v0 = bf4_to_f32(lo) + accS[0], v1 = bf4_to_f32(hi) + accS[1];
        { u32x4 w; w.x = pk2(v0[0], v0[1]); w.y = pk2(v0[2], v0[3]); w.z = pk2(v1[0], v1[1]); w.w = pk2(v1[2], v1[3]); *(u32x4*)bbp = w; }
        float ss = ((v0[0] * v0[0] + v0[1] * v0[1]) + (v0[2] * v0[2] + v0[3] * v0[3])) + ((v1[0] * v1[0] + v1[1] * v1[1]) + (v1[2] * v1[2] + v1[3] * v1[3]));
        ss += __shfl_xor(ss, 16); ss += __shfl_xor(ss, 32);
        LAS float* sred = (LAS float*)lds;
        if (fq == 0) sred[wid * 16 + fr] = ss;
        __syncthreads();
        if (wr == 0 && fq == 0) rss[(size_t)row * 16 + u.pn * 4 + wc] = ss + sred[(4 + wc) * 16 + fr];
    }
    __device__ __forceinline__ void small_load(SmallPre& pre, int row, int n0, int l4) const {
        const bf16* bp = xb + (size_t)row * DM + n0 + 4 * l4;
#pragma unroll
        for (int t = 0; t < 4; ++t) pre.v[t] = bf4_to_f32(*(const u32x2*)(bp + 16 * t));
    }
    __device__ __forceinline__ void small(const f32x4 (&acc)[4], const SmallPre& pre, int row, int n0, int l4) const {
        float ss = 0.f;
#pragma unroll
        for (int t = 0; t < 4; ++t) {
            const f32x4 v = pre.v[t] + acc[t];
            u32x2 w; w.x = pk2(v[0], v[1]); w.y = pk2(v[2], v[3]); *(u32x2*)(xb + (size_t)row * DM + n0 + 16 * t + 4 * l4) = w;
            ss += (v[0] * v[0] + v[1] * v[1]) + (v[2] * v[2] + v[3] * v[3]);
        }
        ss += __shfl_xor(ss, 16); ss += __shfl_xor(ss, 32);
        if (l4 == 0) rss[(size_t)row * 16 + (n0 >> 6)] = ss;
    }
};
__device__ __forceinline__ void panel_meet(unsigned* cnt, const unsigned need, const bool same_l2 = false) {
    asm volatile("s_waitcnt vmcnt(0)" ::: "memory");
    __syncthreads();
    if (threadIdx.x == 0) {
        if (!same_l2) __builtin_amdgcn_fence(__ATOMIC_RELEASE, "agent");
        asm volatile("s_waitcnt vmcnt(0)" ::: "memory");
        (void)xb_add(cnt, 1u);
        unsigned sp = 0u;
        while (xb_ld(cnt) < need) { __builtin_amdgcn_s_sleep(1); if (++sp > (1u << 21)) break; }
        __builtin_amdgcn_fence(__ATOMIC_ACQUIRE, "agent");
        asm volatile("s_waitcnt vmcnt(0)" ::: "memory");
    }
    __syncthreads();
}
struct EpiResidFinal {
    static constexpr bool PERM = true, AFTER_DRAIN = true;
    const bf16* xb; float* rss; unsigned* cnt; const float* gfin; float* y; int same_l2 = 0;
    __device__ __forceinline__ void fused(f32x4 (&acc)[2][2][4][2], f32x4 (&accS)[2], const bool srows, const pg8::Unit& u, int wr, int wc, int fr, int fq, LAS unsigned char* lds, int wid, int) const {
        const int row0 = u.pm * 256 + wr * 64 + fr, col0 = u.pn * 256 + wc * 32 + 8 * fq;
        const int srow = MP + 16 * u.pm + fr, scol0 = u.pn * 256 + wr * 128 + wc * 32 + 8 * fq;
        if (srows) {
            const u32x4 bw = *(const u32x4*)(xb + (size_t)srow * DM + scol0);
            u32x2 lo; lo.x = bw.x; lo.y = bw.y; u32x2 hi; hi.x = bw.z; hi.y = bw.w;
            const f32x4 v0 = bf4_to_f32(lo) + accS[0], v1 = bf4_to_f32(hi) + accS[1];
            accS[0] = v0; accS[1] = v1;
            float ss = ((v0[0] * v0[0] + v0[1] * v0[1]) + (v0[2] * v0[2] + v0[3] * v0[3])) + ((v1[0] * v1[0] + v1[1] * v1[1]) + (v1[2] * v1[2] + v1[3] * v1[3]));
            ss += __shfl_xor(ss, 16); ss += __shfl_xor(ss, 32);
            LAS float* sred = (LAS float*)lds;
            if (fq == 0) sred[wid * 16 + fr] = ss;
            __syncthreads();
            if (wr == 0 && fq == 0) rss[(size_t)srow * 16 + u.pn * 4 + wc] = ss + sred[(4 + wc) * 16 + fr];
        }
#pragma unroll
        for (int ai = 0; ai < 2; ++ai) {
            u32x4 bv[4][2];
#pragma unroll
            for (int m = 0; m < 4; ++m) {
                const bf16* bp = xb + (size_t)(row0 + ai * 128 + m * 16) * DM + col0;
#pragma unroll
                for (int bj = 0; bj < 2; ++bj) bv[m][bj] = *(const u32x4*)(bp + bj * 128);
            }
            asm volatile("" ::: "memory");
#pragma unroll
            for (int m = 0; m < 4; ++m) {
                const int row = row0 + ai * 128 + m * 16;
                float ss = 0.f;
#pragma unroll
                for (int bj = 0; bj < 2; ++bj) {
                    u32x2 lo; lo.x = bv[m][bj].x; lo.y = bv[m][bj].y; u32x2 hi; hi.x = bv[m][bj].z; hi.y = bv[m][bj].w;
                    const f32x4 v0 = bf4_to_f32(lo) + acc[ai][bj][m][0], v1 = bf4_to_f32(hi) + acc[ai][bj][m][1];
                    acc[ai][bj][m][0] = v0; acc[ai][bj][m][1] = v1;
                    ss += ((v0[0] * v0[0] + v0[1] * v0[1]) + (v0[2] * v0[2] + v0[3] * v0[3])) + ((v1[0] * v1[0] + v1[1] * v1[1]) + (v1[2] * v1[2] + v1[3] * v1[3]));
                }
                ss += __shfl_xor(ss, 16); ss += __shfl_xor(ss, 32);
                if (fq == 0) rss[(size_t)row * 16 + u.pn * 4 + wc] = ss;
            }
            asm volatile("" ::: "memory");
        }
        panel_meet(cnt + 64 * u.pm, 4u, same_l2 != 0);
        float rr[2][4];
        rows_rscale8(rss, row0, fq, rr);
        f32x4 gg[2][2];
#pragma unroll
        for (int bj = 0; bj < 2; ++bj)
#pragma unroll
            for (int n = 0; n < 2; ++n) gg[bj][n] = *(const f32x4*)(gfin + col0 + bj * 128 + n * 4);
#pragma unroll
        for (int ai = 0; ai < 2; ++ai)
#pragma unroll
            for (int m = 0; m < 4; ++m) {
                float* yp = y + (size_t)(row0 + ai * 128 + m * 16) * DM + col0;
                const float r = rr[ai][m];
#pragma unroll
                for (int bj = 0; bj < 2; ++bj)
#pragma unroll
                    for (int n = 0; n < 2; ++n) *(f32x4*)(yp + bj * 128 + n * 4) = acc[ai][bj][m][n] * r * gg[bj][n];
            }
        if (srows) {
            const f32x4 p = *(const f32x4*)(rss + (size_t)srow * 16 + 4 * fq);
            float s = (p[0] + p[1]) + (p[2] + p[3]);
            s += __shfl_xor(s, 16); s += __shfl_xor(s, 32);
            const float r = rsqrtf(s * (1.0f / 1024.0f) + EPS);
            float* yp = y + (size_t)srow * DM + scol0;
            *(f32x4*)yp = accS[0] * r * *(const f32x4*)(gfin + scol0); *(f32x4*)(yp + 4) = accS[1] * r * *(const f32x4*)(gfin + scol0 + 4);
        }
    }
    __device__ __forceinline__ void small_load(SmallPre& pre, int row, int n0, int l4) const {
        const bf16* bp = xb + (size_t)row * DM + n0 + 4 * l4;
#pragma unroll
        for (int t = 0; t < 4; ++t) pre.v[t] = bf4_to_f32(*(const u32x2*)(bp + 16 * t));
    }
    __device__ __forceinline__ void small_pre(f32x4 (&acc)[4], const SmallPre& pre, int row, int n0, int l4) const {
        float ss = 0.f;
#pragma unroll
        for (int t = 0; t < 4; ++t) { const f32x4 v = pre.v[t] + acc[t]; acc[t] = v; ss += (v[0] * v[0] + v[1] * v[1]) + (v[2] * v[2] + v[3] * v[3]); }
        ss += __shfl_xor(ss, 16); ss += __shfl_xor(ss, 32);
        if (l4 == 0) rss[(size_t)row * 16 + (n0 >> 6)] = ss;
    }
    __device__ __forceinline__ void small_meet(int m0) const { panel_meet(cnt + 64 * (68 + ((m0 - MP) >> 6)), 16u); }
    __device__ __forceinline__ void small_post(const f32x4 (&acc)[4], int row, int n0, int l4) const {
        const float r = row_rscale(rss, row);
#pragma unroll
        for (int t = 0; t < 4; ++t) { const f32x4 gg = *(const f32x4*)(gfin + n0 + 16 * t + 4 * l4); *(f32x4*)(y + (size_t)row * DM + n0 + 16 * t + 4 * l4) = acc[t] * r * gg; }
    }
};
struct EpiGU {
    static constexpr bool PERM = true, AFTER_DRAIN = false;
    bf16* H; const float* rss; int nolo = 0;
    __device__ __forceinline__ void operator()(const f32x4 (&acc)[2][2][4][2], const pg8::Unit& u, int wr, int wc, int fr, int fq) const {
        const int row0 = u.pm * 256 + wr * 64 + fr, col0 = u.pn * 128 + wc * 32 + 8 * fq;
        float rr[2][4];
        if (nolo) {
#pragma unroll
            for (int a = 0; a < 2; ++a)
#pragma unroll
                for (int b = 0; b < 4; ++b) rr[a][b] = 1.f; }
        else rows_rscale8(rss, row0, fq, rr);
#pragma unroll
        for (int ai = 0; ai < 2; ++ai)
#pragma unroll
            for (int m = 0; m < 4; ++m) {
                const int row = row0 + ai * 128 + m * 16;
                const float r = rr[ai][m];
                float hv[8];
#pragma unroll
                for (int n = 0; n < 2; ++n)
#pragma unroll
                    for (int j = 0; j < 4; ++j) { const float g = acc[ai][0][m][n][j] * r, up = acc[ai][1][m][n][j] * r; hv[n * 4 + j] = g * __builtin_amdgcn_rcpf(1.f + __expf(-g)) * up; }
                u32x4 w; w.x = pk2(hv[0], hv[1]); w.y = pk2(hv[2], hv[3]); w.z = pk2(hv[4], hv[5]); w.w = pk2(hv[6], hv[7]);
                *(u32x4*)(H + (size_t)row * DFF + col0) = w;
            }
    }
};
struct EpiMemKV {
    static constexpr bool PERM = false, AFTER_DRAIN = false;
    float* outk; float* outv; bf16* memK; bf16* memVt; const float* rmem;
    __device__ __forceinline__ void operator()(const f32x4 (&acc)[2][2][4][2], const pg8::Unit& u, int wr, int wc, int fr, int fq) const {
        const int row0 = u.pm * 256 + wr * 64 + fr, col0 = u.pn * 256 + wc * 32 + 4 * fq;
#pragma unroll
        for (int ai = 0; ai < 2; ++ai)
#pragma unroll
            for (int m = 0; m < 4; ++m) {
                const int row = row0 + ai * 128 + m * 16;
                const float r = rmem[row];
#pragma unroll
                for (int bj = 0; bj < 2; ++bj)
#pragma unroll
                    for (int n = 0; n < 2; ++n) {
                        const int c = col0 + bj * 128 + n * 16;
                        const f32x4 v = acc[ai][bj][m][n] * r;
                        if (u.pn < 4) {
                            *(f32x4*)(outk + (size_t)row * 1024 + c) = v;
                            u32x2 w; w.x = pk2(v[0], v[1]); w.y = pk2(v[2], v[3]);
                            *(u32x2*)(memK + (size_t)row * 1024 + c) = w;
                        } else {
                            const int cc = c - 1024;
                            *(f32x4*)(outv + (size_t)row * 1024 + cc) = v;
                            const int b = row >> 8, mm = row & 255, hh = cc >> 8, d = cc & 255;
                            bf16* tp = memVt + (((size_t)b * 4 + hh) * 256 + d) * 256 + mm;
                            tp[0] = f2bf(v[0]); tp[256] = f2bf(v[1]); tp[512] = f2bf(v[2]); tp[768] = f2bf(v[3]);
                        }
                    }
            }
    }
};

template <class Epi>
__device__ __forceinline__ void small_gemm_tile(const bf16* __restrict__ A, const bf16* __restrict__ Bt, const int K, const int m0, const int n0, const Epi& E, LAS unsigned char* lds, const int dbg_mode = 0) {
    const int tid = opaque_tid(), lane = tid & 63, w = __builtin_amdgcn_readfirstlane(tid >> 6), l15 = lane & 15, l4 = lane >> 4;
    const int klen = K >> 3;
    const bf16* ap = A + (size_t)(m0 + l15) * K + w * klen + 8 * l4;
    const bf16* bp = Bt + (size_t)(n0 + l15) * K + w * klen + 8 * l4;
    const int erow = m0 + 16 * (w & 3) + l15;
    SmallPre pre;
#pragma unroll
    for (int i = 0; i < 4; ++i) pre.v[i] = (f32x4){0.f, 0.f, 0.f, 0.f};
    if (w < 4) E.small_load(pre, erow, n0, l4);
    f32x4 acc[4][4];
#pragma unroll
    for (int r = 0; r < 4; ++r)
#pragma unroll
        for (int t = 0; t < 4; ++t) acc[r][t] = (f32x4){0.f, 0.f, 0.f, 0.f};
    const int nsteps = klen >> 5;
    for (int s0 = 0; s0 < nsteps; s0 += 4) {
        bf16x8 ya[4][4], xb[4][4];
#pragma unroll
        for (int s = 0; s < 4; ++s) {
            const int k = (s0 + s < nsteps ? s0 + s : nsteps - 1) * 32;
#pragma unroll
            for (int r = 0; r < 4; ++r) ya[s][r] = *(const bf16x8*)(ap + (size_t)r * 16 * K + k);
#pragma unroll
            for (int t = 0; t < 4; ++t) xb[s][t] = *(const bf16x8*)(bp + (size_t)t * 16 * K + k);
        }
        __builtin_amdgcn_sched_barrier(0);
#pragma unroll
        for (int s = 0; s < 4; ++s) if (s0 + s < nsteps) {
#pragma unroll
            for (int r = 0; r < 4; ++r)
#pragma unroll
                for (int t = 0; t < 4; ++t) acc[r][t] = mma16(xb[s][t], ya[s][r], acc[r][t]);
        }
    }
    LAS f32x4* red = (LAS f32x4*)lds;
#if DBG_SMALL_MODE
    if (dbg_mode == 1) { red[tid] = acc[0][0] + acc[1][1] + acc[2][2] + acc[3][3] + pre.v[0]; __syncthreads(); return; }
#endif
#pragma unroll
    for (int r = 0; r < 4; ++r)
#pragma unroll
        for (int t = 0; t < 4; ++t) red[((w * 4 + r) * 4 + t) * 64 + lane] = acc[r][t];
    __syncthreads();
    f32x4 o[4];
    if (w < 4) {
#pragma unroll
        for (int t = 0; t < 4; ++t) {
            f32x4 a = red[((0 * 4 + w) * 4 + t) * 64 + lane] + red[((1 * 4 + w) * 4 + t) * 64 + lane];
            f32x4 b = red[((2 * 4 + w) * 4 + t) * 64 + lane] + red[((3 * 4 + w) * 4 + t) * 64 + lane];
            f32x4 c = red[((4 * 4 + w) * 4 + t) * 64 + lane] + red[((5 * 4 + w) * 4 + t) * 64 + lane];
            f32x4 d = red[((6 * 4 + w) * 4 + t) * 64 + lane] + red[((7 * 4 + w) * 4 + t) * 64 + lane];
            o[t] = (a + b) + (c + d);
        }
    }
    if constexpr (Epi::AFTER_DRAIN) {
        if (w < 4) E.small_pre(o, pre, erow, n0, l4);
        E.small_meet(m0);
        if (w < 4) E.small_post(o, erow, n0, l4);
    } else {
        if (w < 4) E.small(o, pre, erow, n0, l4);
    }
    __syncthreads();
}
struct TItem { const float* W; const float* gain; bf16* WT; int ldw, k0, src0, ncols, K, dst0; };
__device__ __forceinline__ TItem decode_item(PP P, unsigned char* ws, const int it) {
    constexpr int IT_IN = 118 * 16, IT_SQ = 32 * 16, IT_FF = 88 * 16;
    constexpr int IT_LAYER = IT_IN + 5 * IT_SQ + 3 * IT_FF;
    TItem t; t.gain = nullptr; t.ncols = 32;
    const int l = it / IT_LAYER; int r = it % IT_LAYER;
    if (r < IT_IN) {
        const int kb = r / 118, g = r % 118;
        if (g < 84) { t.src0 = 32 * g; t.dst0 = 32 * g; }
        else if (g < 116) { t.src0 = 2704 + 32 * (g - 84); t.dst0 = 2688 + 32 * (g - 84); }
        else if (g == 116) { t.src0 = 2688; t.dst0 = 3712; t.ncols = 16; }
        else { t.src0 = 3728; t.dst0 = 3728; t.ncols = 8; }
        t.W = P->in[I_WIN] + (size_t)l * DM * 3736; t.ldw = 3736; t.gain = P->in[I_GMIX] + l * DM; t.k0 = kb * 64; t.WT = (bf16*)(ws + WS_WIN) + (size_t)l * NPROJ * DM; t.K = DM;
        return t;
    }
    r -= IT_IN;
    if (r < 5 * IT_SQ) {
        const int which = r / IT_SQ, rr = r % IT_SQ, kb = rr / 32, g = rr % 32;
        t.dst0 = 32 * g; t.src0 = 32 * g; t.ldw = DM; t.k0 = kb * 64; t.K = DM;
        if (which == 0) { t.W = P->in[I_WOUT]; t.WT = (bf16*)(ws + WS_WOUT) + (size_t)l * DM * DM; }
        else if (which == 1) { t.W = P->in[I_WXQ]; t.gain = P->in[I_GXATTN] + l * DM; t.WT = (bf16*)(ws + WS_WXQ) + (size_t)l * DM * DM; }
        else if (which == 2) { t.W = P->in[I_WXO]; t.WT = (bf16*)(ws + WS_WXO) + (size_t)l * DM * DM; }
        else if (which == 3) { t.W = P->in[I_WXK]; t.gain = P->in[I_GMEM] + l * DM; t.WT = (bf16*)(ws + WS_WXKV) + (size_t)l * 2048 * DM; }
        else { t.W = P->in[I_WXV]; t.gain = P->in[I_GMEM] + l * DM; t.WT = (bf16*)(ws + WS_WXKV) + (size_t)l * 2048 * DM; t.dst0 += 1024; }
        t.W += (size_t)l * DM * DM;
        return t;
    }
    r -= 5 * IT_SQ;
    if (r < 2 * IT_FF) {
        const int which = r / IT_FF, rr = r % IT_FF, kb = rr / 88, g = rr % 88;
        t.src0 = 32 * g; t.dst0 = (t.src0 >> 7) * 256 + (t.src0 & 127) + which * 128;
        t.W = P->in[which ? I_WUP : I_WGATE] + (size_t)l * DM * DFF; t.ldw = DFF; t.gain = P->in[I_GFFN] + l * DM; t.k0 = kb * 64; t.WT = (bf16*)(ws + WS_WGU) + (size_t)l * NGU * DM; t.K = DM;
        return t;
    }
    r -= 2 * IT_FF;
    { const int kb = r / 32, g = r % 32;
      t.W = P->in[I_WDOWN] + (size_t)l * DFF * DM; t.ldw = DM; t.k0 = kb * 64; t.src0 = 32 * g; t.dst0 = 32 * g; t.WT = (bf16*)(ws + WS_WDN) + (size_t)l * DM * DFF; t.K = DFF; }
    return t;
}
__device__ __forceinline__ void item_load(const TItem& t, const int lane, f32x4 (&v)[8], float (&g)[8]) {
    const int c4 = 4 * (lane & 7), rr = lane >> 3;
#pragma unroll
    for (int i = 0; i < 8; ++i) {
        const int kk = rr + 8 * i;
        if (c4 < t.ncols) v[i] = *(const f32x4*)(t.W + (size_t)(t.k0 + kk) * t.ldw + t.src0 + c4); else v[i] = (f32x4){0.f, 0.f, 0.f, 0.f};
        g[i] = t.gain ? t.gain[t.k0 + kk] : 1.0f;
    }
}
__device__ __forceinline__ void item_finish(const TItem& t, const int lane, const f32x4 (&v)[8], const float (&g)[8], LAS float* scr) {
    const int c4 = 4 * (lane & 7), rr = lane >> 3;
#pragma unroll
    for (int i = 0; i < 8; ++i) {
        const int kk = rr + 8 * i;
        const f32x4 x = v[i] * g[i];
        scr[kk * 33 + c4] = x[0]; scr[kk * 33 + c4 + 1] = x[1]; scr[kk * 33 + c4 + 2] = x[2]; scr[kk * 33 + c4 + 3] = x[3];
    }
    asm volatile("s_waitcnt lgkmcnt(0)" ::: "memory");
    const int c8 = lane & 7;
#pragma unroll
    for (int j = 0; j < 4; ++j) {
        const int n = (lane >> 3) + 8 * j;
        const LAS float* s = scr + (8 * c8) * 33 + n;
        u32x4 o; o.x = pk2(s[0 * 33], s[1 * 33]); o.y = pk2(s[2 * 33], s[3 * 33]); o.z = pk2(s[4 * 33], s[5 * 33]); o.w = pk2(s[6 * 33], s[7 * 33]);
        if (n < t.ncols) *(u32x4*)(t.WT + (size_t)(t.dst0 + n) * t.K + t.k0 + 8 * c8) = o;
    }
    asm volatile("s_waitcnt lgkmcnt(0)" ::: "memory");
}
#ifndef DEFER_ON
#define DEFER_ON 1
#endif
constexpr int ITM_IN = 118 * 16, ITM_SQ = 32 * 16, ITM_FF = 88 * 16, ITM_LAYER = ITM_IN + 5 * ITM_SQ + 3 * ITM_FF, ITM_EARLY = ITM_IN + 2 * ITM_SQ, ITM_REST = ITM_LAYER - ITM_EARLY;
__device__ __forceinline__ int item_early(int l, int j) { return l * ITM_LAYER + (j < ITM_IN ? j : 3 * ITM_SQ + j); }
__device__ __forceinline__ int item_rest(int l, int j) { return l * ITM_LAYER + ITM_IN + (j < 3 * ITM_SQ ? j : 2 * ITM_SQ + j); }
#ifndef DEFER_SPLIT
#define DEFER_SPLIT 0
#endif
#ifndef DEFER_L1
#define DEFER_L1 1
#endif
__device__ __forceinline__ int item_map(int set, int j) { return set == 0 ? (j < ITM_EARLY ? item_early(0, j) : item_rest(1, j - ITM_EARLY)) : set == 1 ? (j < ITM_REST ? item_rest(0, j) : item_early(1, j - ITM_REST)) : item_rest(1, j); }
static_assert(ITM_REST % 4 == 0 && (ITM_REST + ITM_EARLY) % 4 == 0, "per-wave groups of 4 items");
__device__ __forceinline__ float wave_total(float v, int lane) { return __shfl(scan_sum(v, lane), 63); }

__device__ __forceinline__ void phase_prep(PP P, LAS unsigned char* lds) {
    const int tid = opaque_tid(), lane = tid & 63, wave = __builtin_amdgcn_readfirstlane(tid >> 6);
    const int gw = blockIdx.x * 8 + wave, NGW = gridDim.x * 8;
    unsigned char* ws = P->ws;
    LAS float* scrA = (LAS float*)(lds + wave * 17408); LAS float* scrB = scrA + 64 * 33;
    const bool defer = gridDim.x == 256 && DEFER_ON;
    const int N_ITEMS = defer ? (DEFER_L1 ? ITM_EARLY : ITM_EARLY + ITM_REST) : 2 * ITM_LAYER;
    for (int it = gw; it < N_ITEMS; it += 2 * NGW) {
        const bool hasB = it + NGW < N_ITEMS;
        const TItem A = decode_item(P, ws, defer ? item_map(0, it) : it), B = decode_item(P, ws, defer ? item_map(0, hasB ? it + NGW : it) : (hasB ? it + NGW : it));
        f32x4 va[8], vb[8]; float ga[8], gb[8];
        item_load(A, lane, va, ga); item_load(B, lane, vb, gb);
        item_finish(A, lane, va, ga, scrA);
        if (hasB) item_finish(B, lane, vb, gb, scrB);
    }
    {
        const int gt = blockIdx.x * NTHREADS + tid, NGT = gridDim.x * NTHREADS;
        constexpr int PER = 104 * DM * 2 / 16;
        for (int i = gt; i < 2 * PER; i += NGT) {
            const int l = i / PER, j = i % PER;
            u32x4 z; z.x = 0; z.y = 0; z.z = 0; z.w = 0;
            *(u32x4*)(ws + WS_WIN + ((size_t)l * NPROJ + 3736) * DM * 2 + (size_t)j * 16) = z;
        }
        float* rc = (float*)(ws + WS_ROPE); float* rs = rc + 2056 * 32;
        for (int i = gt; i < 2056 * 32; i += NGT) {
            const int pi = i >> 5, k = i & 31;
            const float pos = (float)(pi < 2048 ? pi : 16384 + (pi - 2048));
            const float inv = powf(10000.0f, -(float)k * 2.0f / 64.0f);
            const float ang = pos * inv;
            rc[i] = (float)cos((double)ang); rs[i] = (float)sin((double)ang);
        }
    }
    bf16* xb = (bf16*)(ws + WS_XB); float* rss = (float*)(ws + WS_RSS);
    bf16* memb = (bf16*)(ws + WS_MEMB); float* rmem = (float*)(ws + WS_RMEM);
    for (int row0 = gw * 4; row0 < MT + 2048; row0 += NGW * 4) {
        f32x4 v[4][4];
#pragma unroll
        for (int r = 0; r < 4; ++r) {
            const int row = row0 + r;
            const float* src = (row < MP) ? P->in[I_XP] + (size_t)row * DM : (row < MT) ? P->in[I_XS] + (size_t)(row - MP) * DM : P->in[I_MEMP] + (size_t)(row - MT) * DM;
#pragma unroll
            for (int j = 0; j < 4; ++j) v[r][j] = *(const f32x4*)(src + (lane + 64 * j) * 4);
        }
#pragma unroll
        for (int r = 0; r < 4; ++r) {
            const int row = row0 + r;
            bf16* dst = (row < MT) ? xb + (size_t)row * DM : memb + (size_t)(row - MT) * DM;
            float ss = 0.f;
#pragma unroll
            for (int j = 0; j < 4; ++j) {
                const f32x4 x = v[r][j];
                ss += (x[0] * x[0] + x[1] * x[1]) + (x[2] * x[2] + x[3] * x[3]);
                u32x2 w; w.x = pk2(x[0], x[1]); w.y = pk2(x[2], x[3]);
                *(u32x2*)(dst + (lane + 64 * j) * 4) = w;
            }
            ss = wave_total(ss, lane);
            if (row < MT) { if (lane < 16) rss[(size_t)row * 16 + lane] = (lane == 0) ? ss : 0.f; }
            else if (lane == 0) rmem[row - MT] = rsqrtf(ss * (1.0f / 1024.0f) + EPS);
        }
    }
}

__device__ __forceinline__ void deferred_items(PP P, const int l, LAS unsigned char* lds, const int pass = 0, const int half = 0) {
    const int tid = opaque_tid(), lane = tid & 63, wave = __builtin_amdgcn_readfirstlane(tid >> 6);
    unsigned char* ws = P->ws;
    unsigned* ctr = (unsigned*)(ws + WS_CTL) + 24576 + 64 * l + 128 * pass + 16 * half;
    LAS float* scrA = (LAS float*)(lds + wave * 17408); LAS float* scrB = scrA + 64 * 33;
    volatile LAS int* tkt = (volatile LAS int*)(lds + LDS_BYTES - 64) + 12;
    const int nall = l == 0 ? ITM_REST + ITM_EARLY : ITM_REST, set = 1 + l;
    const int nfirst = DEFER_SPLIT ? (((nall / 2) + 63) & ~63) : 0, base = half ? nfirst : 0, n = half ? nall - nfirst : nfirst;
    int nt = 0;
    constexpr int TK = 32, PW = TK / 8;
    if (tid == 0) { nt = (int)__hip_atomic_fetch_add(ctr, (unsigned)TK, __ATOMIC_RELAXED, __HIP_MEMORY_SCOPE_AGENT); tkt[0] = nt; }
    __syncthreads();
    int j = tkt[0];
    while (j < n) {
        if (tid == 0) nt = (int)__hip_atomic_fetch_add(ctr, (unsigned)TK, __ATOMIC_RELAXED, __HIP_MEMORY_SCOPE_AGENT);
        const int j0 = base + j + PW * wave;
        if (j + PW * wave < n) {
#pragma unroll 1
            for (int i = 0; i < PW; i += 2) {
                const TItem A = decode_item(P, ws, item_map(set, j0 + i)), B = decode_item(P, ws, item_map(set, j0 + i + 1));
                f32x4 va[8], vb[8]; float ga[8], gb[8];
                item_load(A, lane, va, ga); item_load(B, lane, vb, gb);
                item_finish(A, lane, va, ga, scrA);
                item_finish(B, lane, vb, gb, scrB);
            }
        }
        __syncthreads();
        if (tid == 0) tkt[0] = nt;
        __syncthreads();
        j = tkt[0];
    }
}

__device__ __forceinline__ void phase_final(PP P) {
    const int tid = opaque_tid(), lane = tid & 63, wave = tid >> 6;
    const int gw = blockIdx.x * 8 + wave, NGW = gridDim.x * 8;
    const bf16* xb = (const bf16*)(P->ws + WS_XB); const float* rss = (const float*)(P->ws + WS_RSS); const float* g = P->in[I_GFINAL];
    for (int row = gw; row < MT; row += NGW) {
        const float r = row_rscale(rss, row);
#pragma unroll
        for (int j = 0; j < 4; ++j) {
            const int c = (lane + 64 * j) * 4;
            const u32x2 xw = *(const u32x2*)(xb + (size_t)row * DM + c);
            const f32x4 v = (f32x4){__uint_as_float(xw.x << 16), __uint_as_float(xw.x & 0xffff0000u), __uint_as_float(xw.y << 16), __uint_as_float(xw.y & 0xffff0000u)}, gg = *(const f32x4*)(g + c);
            *(f32x4*)(P->out + O_YP + (size_t)row * DM + c) = v * r * gg;
        }
    }
}
#ifndef DBG_CHAIN
#define DBG_CHAIN 0
#endif
constexpr int CH_LDQ = 72, CH_LDT = 136;
constexpr int CH_OFF_Q = 0, CH_OFF_K = 18432, CH_OFF_KT = 36864, CH_OFF_VT = 54272, CH_OFF_P = 76032, CH_OFF_S = 110848, CH_OFF_B = 122368, CH_END = 140800;
static_assert(CH_END + 256 + 2304 <= LDS_BYTES - 64, "chain lds");
constexpr int CH_BS = 36;

__device__ __forceinline__ float fast_log_sigmoid(float x) { return fminf(x, 0.f) - __logf(1.0f + __expf(-fabsf(x))); }
__device__ __forceinline__ float fast_sigmoid(float x) { return __builtin_amdgcn_rcpf(1.0f + __expf(-x)); }
__device__ __forceinline__ float fast_silu(float x) { return x * __builtin_amdgcn_rcpf(1.0f + __expf(-x)); }

__device__ __forceinline__ void store_T2x8(LAS unsigned char* XT, const int ch0, const int t0, const float (&a)[8], const float (&b)[8]) {
#pragma unroll
    for (int e = 0; e < 8; ++e) *(LAS unsigned*)(XT + ((size_t)(ch0 + e) * CH_LDT + t0) * 2) = pk2(a[e], b[e]);
}
__device__ __forceinline__ void unpack8(const bf16x8 a, float (&x)[8]) {
#pragma unroll
    for (int e = 0; e < 8; ++e) x[e] = bf2f((unsigned short)a[e]);
}
__device__ __forceinline__ u32x4 pack8(const float (&x)[8]) { u32x4 w; w.x = pk2(x[0], x[1]); w.y = pk2(x[2], x[3]); w.z = pk2(x[4], x[5]); w.w = pk2(x[6], x[7]); return w; }

__device__ __forceinline__ void pm_mlstm_gates(PP P, const int layer, const int b, const int h, LAS unsigned char* lds) {
    const int tid = opaque_tid(), lane = tid & 63, w = __builtin_amdgcn_readfirstlane(tid >> 6);
    const float* projg = (const float*)(P->ws + WS_PROJG);
    float* GM = (float*)(P->ws + WS_GM); float* CM = (float*)(P->ws + WS_CM);
    LAS float* lF = (LAS float*)lds; LAS float* lG = lF + 2048; LAS float* lP = lG + 2048; LAS float* lc = lP + 2048;
    const float bfv = P->in[I_BF][layer * 4 + h], biv = P->in[I_BI][layer * 4 + h];
#pragma unroll
    for (int cc = 0; cc < 2; ++cc) {
        const int c = 2 * w + cc, t0 = c * 128;
        const float* g0 = projg + (size_t)(b * SEQ + t0 + lane) * 32; const float* g1 = g0 + 64 * 32;
        const float lf0 = log_sigmoid(g0[20 + h] + bfv), li0 = g0[16 + h] + biv;
        const float lf1 = log_sigmoid(g1[20 + h] + bfv), li1 = g1[16 + h] + biv;
        const float F0 = scan_sum(lf0, lane); const float F1 = scan_sum(lf1, lane) + __shfl(F0, 63);
        const float gg0 = li0 - F0, gg1 = li1 - F1;
        const float pm0 = scan_max(gg0, lane); const float pm1 = fmaxf(scan_max(gg1, lane), __shfl(pm0, 63));
        lF[t0 + lane] = F0; lF[t0 + 64 + lane] = F1; lG[t0 + lane] = gg0; lG[t0 + 64 + lane] = gg1; lP[t0 + lane] = pm0; lP[t0 + 64 + lane] = pm1;
        if (lane == 63) { lc[c] = F1; lc[16 + c] = pm1; }
    }
    __syncthreads();
    if (tid == 0) {
        float m = 0.f;
        for (int c = 0; c < 16; ++c) { const float uL = fmaxf(m, lc[16 + c]); lc[32 + c] = m; lc[48 + c] = uL; m = lc[c] + uL; }
    }
    __syncthreads();
    for (int t = tid; t < 2048; t += NTHREADS) {
        const int c = t >> 7;
        const float u = fmaxf(lc[32 + c], lP[t]);
        *(f32x4*)(GM + ((size_t)(b * 4 + h) * SEQ + t) * 4) = (f32x4){lF[t], lG[t], u, 0.f};
    }
    if (tid < 16) *(f32x4*)(CM + ((size_t)(b * 4 + h) * 16 + tid) * 4) = (f32x4){lc[tid], lc[48 + tid], lc[32 + tid], 0.f};
}
struct ConvPre { bf16x8 u[7]; f32x4 w0[2], w1[2], w2[2], w3[2], bb[2]; };
__device__ __forceinline__ void pm_conv_load(PP P, const int layer, const int b, const int c, const int h, ConvPre& pre) {
    const int tid = opaque_tid();
    const bf16* proj = (const bf16*)(P->ws + WS_PROJ);
    const int which = tid >> 8, cp = tid & 7, rg = (tid >> 3) & 31, chan0 = which * 256 + h * 64 + 8 * cp;
#pragma unroll
    for (int r = 0; r < 7; ++r) { const int tok = c * 128 + 4 * rg - 3 + r;
        if (tok >= 0) pre.u[r] = *(const bf16x8*)((const char*)proj + ((unsigned)(b * SEQ + tok) * NPROJ + C_QKM + chan0) * 2u); else pre.u[r] = (bf16x8){0, 0, 0, 0, 0, 0, 0, 0}; }
    const float* cwp = P->in[I_CONVW] + (size_t)layer * 4 * 512 + chan0; const float* cbp = P->in[I_CONVB] + layer * 512 + chan0;
#pragma unroll
    for (int e4 = 0; e4 < 2; ++e4) { pre.w0[e4] = *(const f32x4*)(cwp + 4 * e4); pre.w1[e4] = *(const f32x4*)(cwp + 512 + 4 * e4); pre.w2[e4] = *(const f32x4*)(cwp + 1024 + 4 * e4);
        pre.w3[e4] = *(const f32x4*)(cwp + 1536 + 4 * e4); pre.bb[e4] = *(const f32x4*)(cbp + 4 * e4); }
}
__device__ __forceinline__ void pm_conv_compute(PP P, const int b, const int c, const int h, const ConvPre& pre) {
    const int tid = opaque_tid();
    bf16* QKC = (bf16*)(P->ws + WS_QKC);
    const int which = tid >> 8, cp = tid & 7, rg = (tid >> 3) & 31, chan0 = which * 256 + h * 64 + 8 * cp;
    float y[4][8];
#pragma unroll
    for (int e4 = 0; e4 < 2; ++e4) {
        const f32x4 w0 = pre.w0[e4], w1 = pre.w1[e4], w2 = pre.w2[e4], w3 = pre.w3[e4], bb = pre.bb[e4];
#pragma unroll
        for (int e1 = 0; e1 < 4; ++e1) {
            const int e = 4 * e4 + e1;
#pragma unroll
            for (int tt = 0; tt < 4; ++tt) {
                const float a = bb[e1] + w0[e1] * bf2f((unsigned short)pre.u[tt][e]) + w1[e1] * bf2f((unsigned short)pre.u[tt + 1][e]) + w2[e1] * bf2f((unsigned short)pre.u[tt + 2][e]) + w3[e1] * bf2f((unsigned short)pre.u[tt + 3][e]);
                y[tt][e] = fast_silu(a) * (which ? 0.125f : 1.0f);
            }
        }
    }
#pragma unroll
    for (int tt = 0; tt < 4; ++tt) *(u32x4*)((char*)QKC + ((unsigned)(b * SEQ + c * 128 + 4 * rg + tt) * 512 + chan0) * 2u) = pack8(y[tt]);
}
__device__ __forceinline__ void pm_mlstm_conv(PP P, const int layer, const int b, const int c, const int h) { ConvPre pre; pm_conv_load(P, layer, b, c, h, pre); pm_conv_compute(P, b, c, h, pre); }
#define PM_GLA_DECL(S) f32x4 S##a0, S##a1, S##a2, S##a3, S##b0, S##b1, S##b2, S##b3; bf16x8 S##x0, S##x1; float S##wg, S##bg
#define PM_GLA_LOAD(S, b_, c_, h_) do { const int tid_ = opaque_tid(), lane_ = tid_ & 63; const int bb_ = (b_), cc_ = (c_), hh_ = (h_); \
    const bf16* proj_ = (const bf16*)(P->ws + WS_PROJ); const float* projg_ = (const float*)(P->ws + WS_PROJG); \
    S##wg = P->in[I_WGA2][(size_t)layer * 16 * 192 + (tid_ & 15) * 192 + hh_ * 32 + (tid_ >> 4)]; S##bg = P->in[I_BGA][layer * 192 + hh_ * 32 + (tid_ & 31)]; \
    const int row0_ = bb_ * SEQ + cc_ * 128; \
    { const f32x4* ap_ = (const f32x4*)(projg_ + (size_t)(row0_ + lane_) * 32); S##a0 = ap_[0]; S##a1 = ap_[1]; S##a2 = ap_[2]; S##a3 = ap_[3]; } \
    { const f32x4* ap_ = (const f32x4*)(projg_ + (size_t)(row0_ + 64 + lane_) * 32); S##b0 = ap_[0]; S##b1 = ap_[1]; S##b2 = ap_[2]; S##b3 = ap_[3]; } \
    const int isq_ = tid_ >> 8, tp_ = (tid_ >> 2) & 63, p_ = tid_ & 3; \
    const unsigned ro_ = ((unsigned)(row0_ + 2 * tp_) * NPROJ + (isq_ ? C_QG : C_KG) + hh_ * 32 + 8 * p_) * 2u; \
    S##x0 = *(const bf16x8*)((const char*)proj_ + ro_); S##x1 = *(const bf16x8*)((const char*)proj_ + ro_ + NPROJ * 2u); } while (0)
#define PM_GLA_VALS(S) S##a0, S##a1, S##a2, S##a3, S##b0, S##b1, S##b2, S##b3, S##x0, S##x1, S##wg, S##bg
__device__ __forceinline__ void pm_gla_compute(PP P, const int b, const int c, const int h, const f32x4 qa0, const f32x4 qa1, const f32x4 qa2, const f32x4 qa3, const f32x4 qb0, const f32x4 qb1, const f32x4 qb2, const f32x4 qb3,
                                               const bf16x8 x0, const bf16x8 x1, const float pwg, const float pbg, LAS unsigned char* lds) {
    const int tid = opaque_tid(), lane = tid & 63, w = __builtin_amdgcn_readfirstlane(tid >> 6);
    LAS float* Bs = (LAS float*)lds;
    LAS float* wgl = Bs + 128 * CH_BS;
    wgl[tid] = pwg; if (tid < 32) wgl[512 + tid] = pbg;
    const int row0 = b * SEQ + c * 128;
    const int isq = tid >> 8, tp = (tid >> 2) & 63, p = tid & 3;
    f32x4 pa[2][4];
    pa[0][0] = qa0; pa[0][1] = qa1; pa[0][2] = qa2; pa[0][3] = qa3; pa[1][0] = qb0; pa[1][1] = qb1; pa[1][2] = qb2; pa[1][3] = qb3;
    __syncthreads();
    {
        float carry[4];
#pragma unroll
        for (int hh = 0; hh < 2; ++hh) {
            const int t = hh * 64 + lane;
            const float ag[16] = {pa[hh][0][0], pa[hh][0][1], pa[hh][0][2], pa[hh][0][3], pa[hh][1][0], pa[hh][1][1], pa[hh][1][2], pa[hh][1][3],
                                  pa[hh][2][0], pa[hh][2][1], pa[hh][2][2], pa[hh][2][3], pa[hh][3][0], pa[hh][3][1], pa[hh][3][2], pa[hh][3][3]};
#pragma unroll
            for (int cc = 0; cc < 4; ++cc) {
                const int ch = 4 * w + cc;
                float x = wgl[512 + ch];
#pragma unroll
                for (int r4 = 0; r4 < 4; ++r4) { const f32x4 wv = *(const LAS f32x4*)(wgl + ch * 16 + 4 * r4);
                    x += ag[4 * r4] * wv[0] + ag[4 * r4 + 1] * wv[1] + ag[4 * r4 + 2] * wv[2] + ag[4 * r4 + 3] * wv[3]; }
                float v = scan_sum(fast_log_sigmoid(x) * (1.0f / 16.0f), lane);
                if (hh == 0) carry[cc] = __shfl(v, 63); else v += carry[cc];
                Bs[t * CH_BS + ch] = v;
            }
        }
    }
    __syncthreads();
    {
        bf16* dq = (bf16*)(P->ws + (isq ? WS_GQ : WS_GK)); bf16* dkt = (bf16*)(P->ws + WS_GKT);
        const f32x4 l0 = *(const LAS f32x4*)(Bs + 127 * CH_BS + 8 * p), l1 = *(const LAS f32x4*)(Bs + 127 * CH_BS + 8 * p + 4);
        const float blv[8] = {l0[0], l0[1], l0[2], l0[3], l1[0], l1[1], l1[2], l1[3]};
#pragma unroll
        for (int tk = 0; tk < 2; ++tk) {
            const int t = 2 * tp + tk;
            float x[8], xo[8], kt[8]; unpack8(tk ? x1 : x0, x);
            const f32x4 b0 = *(const LAS f32x4*)(Bs + t * CH_BS + 8 * p), b1 = *(const LAS f32x4*)(Bs + t * CH_BS + 8 * p + 4);
            const float btv[8] = {b0[0], b0[1], b0[2], b0[3], b1[0], b1[1], b1[2], b1[3]};
#pragma unroll
            for (int e = 0; e < 8; ++e) {
                if (isq) { xo[e] = x[e] * 0.17677669529663687f * __expf(btv[e]); kt[e] = 0.f; }
                else { xo[e] = x[e] * __expf(-btv[e]); kt[e] = x[e] * __expf(blv[e] - btv[e]); }
            }
            const unsigned oo = ((unsigned)(row0 + t) * 192 + h * 32 + 8 * p) * 2u;
            *(u32x4*)((char*)dq + oo) = pack8(xo);
            if (!isq) *(u32x4*)((char*)dkt + oo) = pack8(kt);
        }
        if (tid < 32) ((float*)(P->ws + WS_GBL))[((size_t)(b * 6 + h) * 16 + c) * 32 + tid] = Bs[127 * CH_BS + tid];
    }
}
#ifndef DBG_PM_MASK
#define DBG_PM_MASK 7
#endif
__device__ __forceinline__ void phase_premix(PP P, const int layer, LAS unsigned char* lds, const int pmask = 7) {
    const int G = gridDim.x;
    int task = blockIdx.x;
    if (task < 32) { if (pmask & 1) pm_mlstm_gates(P, layer, task >> 2, task & 3, lds); task += G; }
#define PM_GLA_ARGS(tk_) ((tk_) - 32) / 96, ((((tk_) - 32) / 6) & 15), ((tk_) - 32) % 6
#define PM_CONV_ARGS(tk_) ((tk_) - 800) >> 6, ((((tk_) - 800) >> 2) & 15), ((tk_) - 800) & 3
    if (G == 256) {
        const int t0 = task, t1 = task + 256, t2 = task + 512, t3 = task + 768, t4 = task + 1024;
        PM_GLA_DECL(A); PM_GLA_DECL(B);
        ConvPre C, D;
        if (pmask & 4) { pm_conv_load(P, layer, PM_CONV_ARGS(t3), C); pm_conv_load(P, layer, PM_CONV_ARGS(t4), D); }
        if (pmask & 2) {
        PM_GLA_LOAD(A, (t0 - 32) / 96, ((t0 - 32) / 6) & 15, (t0 - 32) % 6);
        PM_GLA_LOAD(B, (t1 - 32) / 96, ((t1 - 32) / 6) & 15, (t1 - 32) % 6);
        __syncthreads();
        pm_gla_compute(P, PM_GLA_ARGS(t0), PM_GLA_VALS(A), lds);
        PM_GLA_LOAD(A, (t2 - 32) / 96, ((t2 - 32) / 6) & 15, (t2 - 32) % 6);
        __syncthreads();
        pm_gla_compute(P, PM_GLA_ARGS(t1), PM_GLA_VALS(B), lds);
        __syncthreads();
        pm_gla_compute(P, PM_GLA_ARGS(t2), PM_GLA_VALS(A), lds);
        }
        if (pmask & 4) { pm_conv_compute(P, PM_CONV_ARGS(t3), C); pm_conv_compute(P, PM_CONV_ARGS(t4), D); }
    } else {
        for (; task < 800; task += G) { PM_GLA_DECL(A); PM_GLA_LOAD(A, (task - 32) / 96, ((task - 32) / 6) & 15, (task - 32) % 6); __syncthreads(); pm_gla_compute(P, PM_GLA_ARGS(task), PM_GLA_VALS(A), lds); }
        for (; task < 1312; task += G) pm_mlstm_conv(P, layer, PM_CONV_ARGS(task));
    }
#undef PM_GLA_ARGS
#undef PM_GLA_DECL
#undef PM_GLA_LOAD
#undef PM_GLA_VALS
#undef PM_CONV_ARGS
}
template <int TYPE, int VAR = 0>
__device__ __forceinline__ void mixer_chain(PP P, const int layer, const int b, const int h, LAS unsigned char* lds) {
    constexpr int DK = (TYPE == 1) ? 32 : 64, NDV = (TYPE == 2) ? 5 : 4, KS_DK = DK / 32;
    const int tid = opaque_tid(), lane = tid & 63, w = __builtin_amdgcn_readfirstlane(tid >> 6), l15 = lane & 15, l4 = lane >> 4;
    const bf16* proj = (const bf16*)(P->ws + WS_PROJ);
    bf16* og = (bf16*)(P->ws + WS_O);
    const float* rcos = (const float*)(P->ws + WS_ROPE); const float* rsin = rcos + 2056 * 32;
    const bf16* QKC = (const bf16*)(P->ws + WS_QKC); const float* GM = (const float*)(P->ws + WS_GM); const float* CM = (const float*)(P->ws + WS_CM);
    const bf16* GQ = (const bf16*)(P->ws + WS_GQ); const bf16* GK = (const bf16*)(P->ws + WS_GK); const bf16* GKT = (const bf16*)(P->ws + WS_GKT); const float* GBL = (const float*)(P->ws + WS_GBL);
    LAS unsigned char* Qs = lds + CH_OFF_Q; LAS unsigned char* Ks = lds + CH_OFF_K; LAS unsigned char* KT = lds + CH_OFF_KT;
    LAS unsigned char* VT = lds + CH_OFF_VT; LAS unsigned char* Ps = lds + CH_OFF_P; LAS unsigned char* Sst = lds + CH_OFF_S;
    LAS float* Bs = (LAS float*)(lds + CH_OFF_B);
    LAS float* gainl = (LAS float*)(lds + CH_END);
    LAS float* gF = Bs; LAS float* gG = Bs + 128; LAS float* gU = Bs + 256;
    const int qcol = (TYPE == 0) ? C_QR + h * 64 : 0;
    const int kcol = (TYPE == 0) ? C_KR + h * 64 : 0;
    const int vcol = (TYPE == 0) ? C_VR + h * 64 : (TYPE == 1) ? C_VG + h * 64 : C_VM + h * 64;
    const int gcol = (TYPE == 0) ? C_GR + h * 64 : (TYPE == 1) ? C_RG + h * 64 : C_OM + h * 64;
    const int ocol = (TYPE == 0) ? h * 64 : (TYPE == 1) ? 384 + h * 64 : 768 + h * 64;
    const float* gain = (TYPE == 0) ? P->in[I_GRET] + layer * 384 + h * 64 : (TYPE == 1) ? P->in[I_GGLA] + layer * 384 + h * 64 : P->in[I_GMLSTM] + layer * 256 + h * 64;
    const float lg = (TYPE == 0) ? log2f(1.0f - exp2f(-5.0f - (float)h)) : 0.f;
    const int iloc = 16 * w + l15;
    const int vt_tp = tid >> 3, vt_pc = tid & 7;
    const int qk_isq = tid >> 8, qk_tp = (tid >> 2) & 63, qk_p = tid & 3;

    if (tid < 64) gainl[tid] = gain[tid];
    for (int i = tid; i < 80 * CH_LDQ / 2; i += NTHREADS) ((LAS unsigned*)Sst)[i] = 0u;
    if (TYPE == 2) for (int i = tid; i < 16 * CH_LDT / 2; i += NTHREADS) { const int r = (2 * i) / CH_LDT; ((LAS unsigned*)(VT + 64 * CH_LDT * 2))[i] = (r == 0) ? 0x3F803F80u : 0u; }
    f32x4 acc_s[3];
#pragma unroll
    for (int t = 0; t < 3; ++t) acc_s[t] = (f32x4){0.f, 0.f, 0.f, 0.f};
    const int dkt = (TYPE == 1) ? (w & 1) : (w & 3);
    const int dvt0 = (TYPE == 1) ? (w >> 1) : (w >> 2) * 2;
    const float r_kd0 = (TYPE == 0) ? exp2f((float)(127 - 2 * qk_tp) * lg) : 1.f, r_kd1 = (TYPE == 0) ? exp2f((float)(126 - 2 * qk_tp) * lg) : 1.f;
    const float r_rsc = (TYPE == 0) ? exp2f((float)(iloc + 1) * lg) : 1.f;
    const float r_dcy = (TYPE == 0) ? exp2f(128.0f * lg) : 1.f;
    float r_wr[4];
#pragma unroll
    for (int r = 0; r < 4; ++r) r_wr[r] = (TYPE == 0) ? exp2f((float)(iloc - 4 * l4 - r) * lg) : 1.f;
    const float r_g16 = (TYPE == 0) ? exp2f(-16.0f * lg) : 1.f;

    bf16x8 pv0, pv1;
    bf16x8 px[2][2];
    f32x4 pcs[2][4];
    f32x4 pgm;
    float pgk[2];
    f32x4 pcm;
#define LD16(base_, off_) (*(const bf16x8*)((const char*)(base_) + (unsigned)(off_)))
#define LDF4(base_, off_) (*(const f32x4*)((const char*)(base_) + (unsigned)(off_)))
#define CH_LOAD(c_) do { const unsigned row0_ = (unsigned)(b * SEQ + (c_) * 128); \
        { const unsigned vo_ = ((row0_ + 2 * vt_tp) * NPROJ + vcol + 8 * vt_pc) * 2u; pv0 = LD16(proj, vo_); pv1 = LD16(proj, vo_ + NPROJ * 2u); } \
        if (TYPE == 0) { const unsigned ro_ = ((row0_ + 2 * qk_tp) * NPROJ + (qk_isq ? qcol : kcol) + 8 * qk_p) * 2u; \
            px[0][0] = LD16(proj, ro_); px[0][1] = LD16(proj, ro_ + 64u); px[1][0] = LD16(proj, ro_ + NPROJ * 2u); px[1][1] = LD16(proj, ro_ + NPROJ * 2u + 64u); \
            const unsigned co_ = (((c_) * 128 + 2 * qk_tp) * 32 + 8 * qk_p) * 4u; \
            pcs[0][0] = LDF4(rcos, co_); pcs[0][1] = LDF4(rcos, co_ + 16u); pcs[0][2] = LDF4(rsin, co_); pcs[0][3] = LDF4(rsin, co_ + 16u); \
            pcs[1][0] = LDF4(rcos, co_ + 128u); pcs[1][1] = LDF4(rcos, co_ + 144u); pcs[1][2] = LDF4(rsin, co_ + 128u); pcs[1][3] = LDF4(rsin, co_ + 144u); } \
        if (TYPE == 1) { const unsigned ro_ = ((row0_ + 2 * qk_tp) * 192 + h * 32 + 8 * qk_p) * 2u; \
            if (qk_isq) { px[0][0] = LD16(GQ, ro_); px[1][0] = LD16(GQ, ro_ + 384u); } \
            else { px[0][0] = LD16(GK, ro_); px[1][0] = LD16(GK, ro_ + 384u); px[0][1] = LD16(GKT, ro_); px[1][1] = LD16(GKT, ro_ + 384u); } \
            pcm = LDF4(GBL, (((unsigned)(b * 6 + h) * 16 + (c_)) * 32 + dkt * 16 + 4 * l4) * 4u); } \
        if (TYPE == 2) { const unsigned ro_ = ((row0_ + 2 * qk_tp) * 512 + (qk_isq ? 0 : 256) + h * 64 + 8 * qk_p) * 2u; \
            px[0][0] = LD16(QKC, ro_); px[0][1] = LD16(QKC, ro_ + 64u); px[1][0] = LD16(QKC, ro_ + 1024u); px[1][1] = LD16(QKC, ro_ + 1024u + 64u); \
            pgm = LDF4(GM, ((unsigned)(b * 4 + h) * SEQ + (c_) * 128 + (tid & 127)) * 16u); \
            pgk[0] = *(const float*)((const char*)GM + ((unsigned)(b * 4 + h) * SEQ + (c_) * 128 + 2 * qk_tp) * 16u + 4u); pgk[1] = *(const float*)((const char*)GM + ((unsigned)(b * 4 + h) * SEQ + (c_) * 128 + 2 * qk_tp + 1) * 16u + 4u); \
            pcm = LDF4(CM, (((unsigned)(b * 4 + h) * 16 + (c_)) * 4) * 4u); } \
    } while (0)
#define GR_LOAD(c_) do { const unsigned go_ = ((unsigned)(b * SEQ + (c_) * 128 + iloc) * NPROJ + gcol + 8 * l4) * 2u; gr[0] = *(const u32x4*)((const char*)proj + go_); gr[1] = *(const u32x4*)((const char*)proj + go_ + 64u); } while (0)
#define SCHED_FENCE() __builtin_amdgcn_sched_barrier(0)
    u32x4 gr[2];
#define CH_PROW(dt_) ((dt_) * 16 + l15)
    float m_last = 0.f;
    CH_LOAD(0);
    __syncthreads();

    for (int c = 0; c < 16; ++c) {
        const int row0 = b * SEQ + c * 128;
        {
            float v1[8], v2[8]; unpack8(pv0, v1); unpack8(pv1, v2);
#pragma unroll
            for (int e = 0; e < 8; ++e) *(LAS unsigned*)(VT + ((size_t)(32 * (vt_pc >> 2) + 16 * (e >> 2) + 4 * (vt_pc & 3) + (e & 3)) * CH_LDT + 2 * vt_tp) * 2) = pk2(v1[e], v2[e]);
        }
        float FL = 0.f, uL = 0.f, m_prev = 0.f;
        f32x4 bl4 = (f32x4){0.f, 0.f, 0.f, 0.f};
        if (TYPE == 1) bl4 = pcm;
        if (TYPE == 2) { FL = pcm[0]; uL = pcm[1]; m_prev = pcm[2]; }
        if (TYPE == 0) {
            float o1[2][8], o2[2][8];
#pragma unroll
            for (int tk = 0; tk < 2; ++tk) {
                const float cv[8] = {pcs[tk][0][0], pcs[tk][0][1], pcs[tk][0][2], pcs[tk][0][3], pcs[tk][1][0], pcs[tk][1][1], pcs[tk][1][2], pcs[tk][1][3]};
                const float sv[8] = {pcs[tk][2][0], pcs[tk][2][1], pcs[tk][2][2], pcs[tk][2][3], pcs[tk][3][0], pcs[tk][3][1], pcs[tk][3][2], pcs[tk][3][3]};
                float x1[8], x2[8]; unpack8(px[tk][0], x1); unpack8(px[tk][1], x2);
                const float sc = qk_isq ? 0.125f : 1.0f;
#pragma unroll
                for (int e = 0; e < 8; ++e) { o1[tk][e] = (x1[e] * cv[e] - x2[e] * sv[e]) * sc; o2[tk][e] = (x1[e] * sv[e] + x2[e] * cv[e]) * sc; }
                LAS unsigned char* dst = (qk_isq ? Qs : Ks) + ((2 * qk_tp + tk) * CH_LDQ + 8 * qk_p) * 2;
                *(LAS u32x4*)dst = pack8(o1[tk]); *(LAS u32x4*)(dst + 64) = pack8(o2[tk]);
            }
            if (!qk_isq) {
#pragma unroll
                for (int e = 0; e < 8; ++e) { o1[0][e] *= r_kd0; o2[0][e] *= r_kd0; o1[1][e] *= r_kd1; o2[1][e] *= r_kd1; }
                store_T2x8(KT, 8 * qk_p, 2 * qk_tp, o1[0], o1[1]); store_T2x8(KT, 32 + 8 * qk_p, 2 * qk_tp, o2[0], o2[1]);
            }
        }
        if (TYPE == 1) {
#pragma unroll
            for (int tk = 0; tk < 2; ++tk) *(LAS bf16x8*)((qk_isq ? Qs : Ks) + ((2 * qk_tp + tk) * CH_LDQ + 8 * qk_p) * 2) = px[tk][0];
            if (!qk_isq) { float k0[8], k1[8]; unpack8(px[0][1], k0); unpack8(px[1][1], k1); store_T2x8(KT, 8 * qk_p, 2 * qk_tp, k0, k1); }
        }
        if (TYPE == 2) {
#pragma unroll
            for (int tk = 0; tk < 2; ++tk) { LAS unsigned char* dst = (qk_isq ? Qs : Ks) + ((2 * qk_tp + tk) * CH_LDQ + 8 * qk_p) * 2; *(LAS bf16x8*)dst = px[tk][0]; *(LAS bf16x8*)(dst + 64) = px[tk][1]; }
            if (!qk_isq) {
                const float wk0 = __expf(pgk[0] - uL), wk1 = __expf(pgk[1] - uL);
                float a0[8], a1[8], c0[8], c1[8]; unpack8(px[0][0], a0); unpack8(px[1][0], a1); unpack8(px[0][1], c0); unpack8(px[1][1], c1);
#pragma unroll
                for (int e = 0; e < 8; ++e) { a0[e] *= wk0; c0[e] *= wk0; a1[e] *= wk1; c1[e] *= wk1; }
                store_T2x8(KT, 8 * qk_p, 2 * qk_tp, a0, a1); store_T2x8(KT, 32 + 8 * qk_p, 2 * qk_tp, c0, c1);
            }
            if (tid < 128) { gF[tid] = pgm[0]; gG[tid] = pgm[1]; gU[tid] = pgm[2]; }
        }
        if (c + 1 < 16 && VAR != 4) CH_LOAD(c + 1);
        __syncthreads();
        GR_LOAD(c);
        bf16x8 yq[KS_DK];
        f32x4 acc_o[NDV];
        float ui = 0.f;
        if (TYPE == 2) ui = gU[iloc];
#pragma unroll
        for (int ks = 0; ks < KS_DK; ++ks) yq[ks] = lfrag(Qs, iloc, CH_LDQ, 32 * ks + 8 * l4);
        {
            bf16x8 fs[NDV][KS_DK];
#pragma unroll
            for (int dt = 0; dt < NDV; ++dt)
#pragma unroll
                for (int ks = 0; ks < KS_DK; ++ks) fs[dt][ks] = lfrag(Sst, CH_PROW(dt), CH_LDQ, 32 * ks + 8 * l4);
            SCHED_FENCE();
#pragma unroll
            for (int dt = 0; dt < NDV; ++dt) {
                acc_o[dt] = (f32x4){0.f, 0.f, 0.f, 0.f};
#pragma unroll
                for (int ks = 0; ks < KS_DK; ++ks) acc_o[dt] = mma16(fs[dt][ks], yq[ks], acc_o[dt]);
            }
            SCHED_FENCE();
        }
        if (TYPE != 1) {
            const float rsc = (TYPE == 0) ? r_rsc : __expf(m_prev - ui);
#pragma unroll
            for (int dt = 0; dt < NDV; ++dt) acc_o[dt] *= rsc;
        }
        {
            float gjt = 1.0f;
#pragma unroll
            for (int jb = 0; jb < 2; ++jb) {
                f32x4 sc[4];
                bf16x8 fk[4][KS_DK];
#pragma unroll
                for (int j4 = 0; j4 < 4; ++j4)
#pragma unroll
                    for (int ks = 0; ks < KS_DK; ++ks) fk[j4][ks] = lfrag(Ks, (jb * 4 + j4) * 16 + l15, CH_LDQ, 32 * ks + 8 * l4);
                SCHED_FENCE();
#pragma unroll
                for (int j4 = 0; j4 < 4; ++j4) {
                    sc[j4] = (f32x4){0.f, 0.f, 0.f, 0.f};
#pragma unroll
                    for (int ks = 0; ks < KS_DK; ++ks) sc[j4] = mma16(fk[j4][ks], yq[ks], sc[j4]);
                }
#pragma unroll
                for (int j4 = 0; j4 < 4; ++j4) {
                    const int jt = jb * 4 + j4, j0 = jt * 16 + 4 * l4;
                    f32x4 gg = (f32x4){0.f, 0.f, 0.f, 0.f};
                    if (TYPE == 2) gg = *(const LAS f32x4*)(gG + j0);
#pragma unroll
                    for (int r = 0; r < 4; ++r) {
                        float wgt = 1.0f;
                        if (TYPE == 0) wgt = r_wr[r] * gjt;
                        if (TYPE == 2) wgt = __expf(fminf(gg[r] - ui, 0.f));
                        sc[j4][r] = (iloc >= j0 + r) ? sc[j4][r] * wgt : 0.f;
                    }
                    u32x2 wv; wv.x = pk2(sc[j4][0], sc[j4][1]); wv.y = pk2(sc[j4][2], sc[j4][3]);
                    *(LAS u32x2*)(Ps + (iloc * CH_LDT + jt * 16 + 4 * l4) * 2) = wv;
                    gjt *= r_g16;
                }
                asm volatile("" ::: "memory");
            }
        }
        asm volatile("s_waitcnt lgkmcnt(0)" ::: "memory");
        constexpr int PVB = 2;
#pragma unroll
        for (int kb = 0; kb < 4 / PVB; ++kb) {
            bf16x8 yp[PVB], fv[PVB][NDV];
#pragma unroll
            for (int k2 = 0; k2 < PVB; ++k2) {
                yp[k2] = lfrag(Ps, iloc, CH_LDT, 32 * (PVB * kb + k2) + 8 * l4);
#pragma unroll
                for (int dt = 0; dt < NDV; ++dt) fv[k2][dt] = lfrag(VT, CH_PROW(dt), CH_LDT, 32 * (PVB * kb + k2) + 8 * l4);
            }
            SCHED_FENCE();
#pragma unroll
            for (int k2 = 0; k2 < PVB; ++k2)
#pragma unroll
                for (int dt = 0; dt < NDV; ++dt) acc_o[dt] = mma16(fv[k2][dt], yp[k2], acc_o[dt]);
            SCHED_FENCE();
        }
        {
            if (TYPE == 2) {
                const float den = __shfl(acc_o[NDV - 1][0], l15);
                const float mt = gF[iloc] + ui;
                const float inv = __builtin_amdgcn_rcpf(fmaxf(fabsf(den), __expf(-mt)));
#pragma unroll
                for (int dt = 0; dt < 4; ++dt) acc_o[dt] *= inv;
            }
            float ss = 0.f;
#pragma unroll
            for (int dt = 0; dt < 4; ++dt) ss += (acc_o[dt][0] * acc_o[dt][0] + acc_o[dt][1] * acc_o[dt][1]) + (acc_o[dt][2] * acc_o[dt][2] + acc_o[dt][3] * acc_o[dt][3]);
            ss += __shfl_xor(ss, 16); ss += __shfl_xor(ss, 32);
            const float rn = rsqrtf(ss * (1.0f / 64.0f) + EPS);
            const unsigned oo = ((unsigned)(row0 + iloc) * DM + ocol + 8 * l4) * 2u;
#pragma unroll
            for (int dp = 0; dp < 2; ++dp) {
                const f32x4 gn0 = *(const LAS f32x4*)(gainl + dp * 32 + 8 * l4), gn1 = *(const LAS f32x4*)(gainl + dp * 32 + 8 * l4 + 4);
                const float ga[8] = {__uint_as_float(gr[dp].x << 16), __uint_as_float(gr[dp].x & 0xffff0000u), __uint_as_float(gr[dp].y << 16), __uint_as_float(gr[dp].y & 0xffff0000u),
                                     __uint_as_float(gr[dp].z << 16), __uint_as_float(gr[dp].z & 0xffff0000u), __uint_as_float(gr[dp].w << 16), __uint_as_float(gr[dp].w & 0xffff0000u)};
                float vv[8];
#pragma unroll
                for (int e = 0; e < 8; ++e) vv[e] = (TYPE == 2) ? fast_sigmoid(ga[e]) : fast_silu(ga[e]);
                u32x4 wv;
                wv.x = pk2(acc_o[2 * dp][0] * rn * gn0[0] * vv[0], acc_o[2 * dp][1] * rn * gn0[1] * vv[1]); wv.y = pk2(acc_o[2 * dp][2] * rn * gn0[2] * vv[2], acc_o[2 * dp][3] * rn * gn0[3] * vv[3]);
                wv.z = pk2(acc_o[2 * dp + 1][0] * rn * gn1[0] * vv[4], acc_o[2 * dp + 1][1] * rn * gn1[1] * vv[5]); wv.w = pk2(acc_o[2 * dp + 1][2] * rn * gn1[2] * vv[6], acc_o[2 * dp + 1][3] * rn * gn1[3] * vv[7]);
                *(u32x4*)((char*)og + oo + dp * 64u) = wv;
            }
        }
        {
            if (TYPE == 0) {
#pragma unroll
                for (int t = 0; t < 2; ++t) acc_s[t] *= r_dcy; }
            if (TYPE == 1) {
#pragma unroll
                for (int r = 0; r < 4; ++r) acc_s[0][r] *= __expf(bl4[r]); }
            if (TYPE == 2) { const float dcy = __expf(m_prev - uL);
#pragma unroll
                for (int t = 0; t < 3; ++t) acc_s[t] *= dcy; }
            constexpr int SB = 2;
#pragma unroll
            for (int kb = 0; kb < 4 / SB; ++kb) {
                bf16x8 fx[SB], f0[SB], f1[SB], f2[SB];
#pragma unroll
                for (int k2 = 0; k2 < SB; ++k2) {
                    const int ks = SB * kb + k2;
                    fx[k2] = lfrag(KT, dkt * 16 + l15, CH_LDT, 32 * ks + 8 * l4);
                    f0[k2] = lfrag(VT, dvt0 * 16 + l15, CH_LDT, 32 * ks + 8 * l4);
                    if (TYPE != 1) f1[k2] = lfrag(VT, (dvt0 + 1) * 16 + l15, CH_LDT, 32 * ks + 8 * l4);
                    if (TYPE == 2) f2[k2] = lfrag(VT, 64 + l15, CH_LDT, 32 * ks + 8 * l4);
                }
                SCHED_FENCE();
#pragma unroll
                for (int k2 = 0; k2 < SB; ++k2) {
                    acc_s[0] = mma16(fx[k2], f0[k2], acc_s[0]);
                    if (TYPE != 1) acc_s[1] = mma16(fx[k2], f1[k2], acc_s[1]);
                    if (TYPE == 2) { if (w < 4) acc_s[2] = mma16(fx[k2], f2[k2], acc_s[2]); }
                }
                SCHED_FENCE();
            }
        }
        if (TYPE == 2) m_last = FL + uL;
        __syncthreads();
        {
            u32x2 wv; wv.x = pk2(acc_s[0][0], acc_s[0][1]); wv.y = pk2(acc_s[0][2], acc_s[0][3]);
            *(LAS u32x2*)(Sst + ((dvt0 * 16 + l15) * CH_LDQ + dkt * 16 + 4 * l4) * 2) = wv;
            if (TYPE != 1) { wv.x = pk2(acc_s[1][0], acc_s[1][1]); wv.y = pk2(acc_s[1][2], acc_s[1][3]);
                *(LAS u32x2*)(Sst + (((dvt0 + 1) * 16 + l15) * CH_LDQ + dkt * 16 + 4 * l4) * 2) = wv; }
            if (TYPE == 2) { if (w < 4) { wv.x = pk2(acc_s[2][0], acc_s[2][1]); wv.y = pk2(acc_s[2][2], acc_s[2][3]);
                *(LAS u32x2*)(Sst + ((64 + l15) * CH_LDQ + dkt * 16 + 4 * l4) * 2) = wv; } }
        }
    }
#undef CH_LOAD
#undef GR_LOAD
#undef LD16
#undef LDF4
#undef SCHED_FENCE
    {
        const int tid = opaque_tid(), lane = tid & 63, w = __builtin_amdgcn_readfirstlane(tid >> 6), l15 = lane & 15, l4 = lane >> 4;
        const int dkt = (TYPE == 1) ? (w & 1) : (w & 3);
        const int dvt0 = (TYPE == 1) ? (w >> 1) : (w >> 2) * 2;
        const int dvl = 8 * (l15 >> 2) + (l15 & 3);
        float* out = P->out;
        if (TYPE == 0) {
            float* sp = out + O_PRET + (((size_t)layer * NB + b) * 6 + h) * 4096;
#pragma unroll
            for (int t = 0; t < 2; ++t)
#pragma unroll
                for (int r = 0; r < 4; ++r) sp[(dkt * 16 + 4 * l4 + r) * 64 + 32 * ((dvt0 + t) >> 1) + 4 * ((dvt0 + t) & 1) + dvl] = acc_s[t][r];
        }
        if (TYPE == 1) {
            float* sp = out + O_PGLA + (((size_t)layer * NB + b) * 6 + h) * 2048;
#pragma unroll
            for (int r = 0; r < 4; ++r) sp[(dkt * 16 + 4 * l4 + r) * 64 + 32 * (dvt0 >> 1) + 4 * (dvt0 & 1) + dvl] = acc_s[0][r];
        }
        if (TYPE == 2) {
            float* sp = out + O_PC + (((size_t)layer * NB + b) * 4 + h) * 4096;
#pragma unroll
            for (int t = 0; t < 2; ++t)
#pragma unroll
                for (int r = 0; r < 4; ++r) sp[(dkt * 16 + 4 * l4 + r) * 64 + 32 * ((dvt0 + t) >> 1) + 4 * ((dvt0 + t) & 1) + dvl] = acc_s[t][r];
            if (w < 4 && l15 == 0) {
                float* np = out + O_PN + (((size_t)layer * NB + b) * 4 + h) * 64;
#pragma unroll
                for (int r = 0; r < 4; ++r) np[dkt * 16 + 4 * l4 + r] = acc_s[2][r];
            }
            if (tid == 0) out[O_PM + ((size_t)layer * NB + b) * 4 + h] = m_last;
            if (tid < 384) {
                const int r = tid >> 7, cc = tid & 127, ch = (cc >> 6) * 256 + h * 64 + (cc & 63);
                out[O_PCONV + (((size_t)layer * NB + b) * 3 + r) * 512 + ch] = bf2f(proj[(size_t)(b * SEQ + SEQ - 3 + r) * NPROJ + C_QKM + ch]);
            }
        }
    }
}
__device__ __forceinline__ void sample_mixer(PP P, const int layer, const int b, const int hh, LAS unsigned char* wl  , const int lane) {
    const bf16* proj = (const bf16*)(P->ws + WS_PROJ);
    const float* projg = (const float*)(P->ws + WS_PROJG);
    bf16* og = (bf16*)(P->ws + WS_O);
    const float* rcos = (const float*)(P->ws + WS_ROPE); const float* rsin = rcos + 2056 * 32;
    LAS float* qs = (LAS float*)wl;
    LAS float* ks = qs + 512;
    LAS float* as = ks + 512;
    LAS float* vl = as + 256;
    LAS float* ol = vl + 512;
    const int row0 = MP + b * DECT;
    if (hh < 6) {
        const int h = hh;
        const float gamma = 1.0f - exp2f(-5.0f - (float)h);
        const int dlo = lane & 31;
#pragma unroll
        for (int t = 0; t < 8; ++t) {
            const bf16* rp = proj + (size_t)(row0 + t) * NPROJ;
            const float cs = rcos[(2048 + t) * 32 + dlo], sn = rsin[(2048 + t) * 32 + dlo];
            const float q1 = bf2f(rp[C_QR + h * 64 + dlo]), q2 = bf2f(rp[C_QR + h * 64 + 32 + dlo]);
            const float k1 = bf2f(rp[C_KR + h * 64 + dlo]), k2 = bf2f(rp[C_KR + h * 64 + 32 + dlo]);
            qs[t * 64 + lane] = ((lane < 32) ? q1 * cs - q2 * sn : q1 * sn + q2 * cs) * 0.125f;
            ks[t * 64 + lane] = (lane < 32) ? k1 * cs - k2 * sn : k1 * sn + k2 * cs;
        }
        asm volatile("s_waitcnt lgkmcnt(0)" ::: "memory");
#pragma unroll
        for (int t = 0; t < 8; ++t) vl[t * 64 + lane] = bf2f(proj[(size_t)(row0 + t) * NPROJ + C_VR + h * 64 + lane]);
#pragma unroll 1
        for (int hf = 0; hf < 2; ++hf) {
            const float* s0 = P->in[I_SRET] + (((size_t)layer * DECB + b) * 6 + h) * 4096 + hf * 2048 + lane;
            float S[32];
#pragma unroll
            for (int d = 0; d < 32; ++d) S[d] = s0[d * 64];
#pragma unroll 1
            for (int t = 0; t < 8; ++t) {
                const float v = vl[t * 64 + lane];
                float o = 0.f;
#pragma unroll
                for (int d4 = 0; d4 < 8; ++d4) {
                    const f32x4 kk = *(const LAS f32x4*)(ks + t * 64 + hf * 32 + 4 * d4), qq = *(const LAS f32x4*)(qs + t * 64 + hf * 32 + 4 * d4);
#pragma unroll
                    for (int e = 0; e < 4; ++e) { S[4 * d4 + e] = gamma * S[4 * d4 + e] + kk[e] * v; o += qq[e] * S[4 * d4 + e]; }
                }
                ol[t * 64 + lane] = hf ? ol[t * 64 + lane] + o : o;
            }
            float* so = P->out + O_SRET + (((size_t)layer * DECB + b) * 6 + h) * 4096 + hf * 2048 + lane;
#pragma unroll
            for (int d = 0; d < 32; ++d) so[d * 64] = S[d];
        }
        const float gn = P->in[I_GRET][layer * 384 + h * 64 + lane];
#pragma unroll 1
        for (int t = 0; t < 8; ++t) {
            const float o = ol[t * 64 + lane];
            const float rn = rsqrtf(wave_sum(o * o) * (1.0f / 64.0f) + EPS);
            const float g = bf2f(proj[(size_t)(row0 + t) * NPROJ + C_GR + h * 64 + lane]);
            og[(size_t)(row0 + t) * DM + h * 64 + lane] = f2bf(o * rn * gn * siluf(g));
        }
    } else if (hh < 12) {
        const int h = hh - 6;
        {
            const int t = lane >> 3, c0 = (lane & 7) * 4;
            const f32x4* ap = (const f32x4*)(projg + (size_t)(row0 + t) * 32);
            const f32x4 a0 = ap[0], a1 = ap[1], a2 = ap[2], a3 = ap[3];
            const float ag[16] = {a0[0], a0[1], a0[2], a0[3], a1[0], a1[1], a1[2], a1[3], a2[0], a2[1], a2[2], a2[3], a3[0], a3[1], a3[2], a3[3]};
#pragma unroll
            for (int cc = 0; cc < 4; ++cc) {
                const int col = h * 32 + c0 + cc;
                float x = P->in[I_BGA][layer * 192 + col];
                const float* wp = P->in[I_WGA2] + (size_t)layer * 16 * 192 + col;
#pragma unroll
                for (int r = 0; r < 16; ++r) x += ag[r] * wp[r * 192];
                as[t * 32 + c0 + cc] = expf(log_sigmoid(x) * (1.0f / 16.0f));
            }
        }
        if (lane < 32) {
#pragma unroll
            for (int t = 0; t < 8; ++t) {
                const bf16* rp = proj + (size_t)(row0 + t) * NPROJ;
                qs[t * 64 + lane] = bf2f(rp[C_QG + h * 32 + lane]) * 0.17677669529663687f;
                ks[t * 64 + lane] = bf2f(rp[C_KG + h * 32 + lane]);
            }
        }
        asm volatile("s_waitcnt lgkmcnt(0)" ::: "memory");
        const float* s0 = P->in[I_SGLA] + (((size_t)layer * DECB + b) * 6 + h) * 2048 + lane;
        float S[32];
#pragma unroll
        for (int d = 0; d < 32; ++d) S[d] = s0[d * 64];
#pragma unroll 1
        for (int t = 0; t < 8; ++t) {
            const bf16* rp = proj + (size_t)(row0 + t) * NPROJ;
            const float v = bf2f(rp[C_VG + h * 64 + lane]);
            float o = 0.f;
#pragma unroll
            for (int d4 = 0; d4 < 8; ++d4) {
                const f32x4 kk = *(const LAS f32x4*)(ks + t * 64 + 4 * d4), qq = *(const LAS f32x4*)(qs + t * 64 + 4 * d4), aa = *(const LAS f32x4*)(as + t * 32 + 4 * d4);
#pragma unroll
                for (int e = 0; e < 4; ++e) { S[4 * d4 + e] = aa[e] * S[4 * d4 + e] + kk[e] * v; o += qq[e] * S[4 * d4 + e]; }
            }
            const float rn = rsqrtf(wave_sum(o * o) * (1.0f / 64.0f) + EPS);
            const float g = bf2f(rp[C_RG + h * 64 + lane]);
            og[(size_t)(row0 + t) * DM + 384 + h * 64 + lane] = f2bf(o * rn * P->in[I_GGLA][layer * 384 + h * 64 + lane] * siluf(g));
        }
        float* so = P->out + O_SGLA + (((size_t)layer * DECB + b) * 6 + h) * 2048 + lane;
#pragma unroll
        for (int d = 0; d < 32; ++d) so[d * 64] = S[d];
    } else {
        const int h = hh - 12;
        {
#pragma unroll
            for (int which = 0; which < 2; ++which) {
                const int ch = which * 256 + h * 64 + lane;
                float up[11];
                const float* cbuf = P->in[I_SCONV] + ((size_t)layer * DECB + b) * 3 * 512 + ch;
#pragma unroll
                for (int r = 0; r < 3; ++r) up[r] = cbuf[r * 512];
#pragma unroll
                for (int t = 0; t < 8; ++t) up[3 + t] = bf2f(proj[(size_t)(row0 + t) * NPROJ + C_QKM + ch]);
                const float* cw = P->in[I_CONVW] + (size_t)layer * 4 * 512 + ch;
                const float w0 = cw[0], w1 = cw[512], w2 = cw[1024], w3 = cw[1536], cb = P->in[I_CONVB][layer * 512 + ch];
#pragma unroll
                for (int t = 0; t < 8; ++t) {
                    const float y = siluf(cb + w0 * up[t] + w1 * up[t + 1] + w2 * up[t + 2] + w3 * up[t + 3]);
                    if (which) ks[t * 64 + lane] = y * 0.125f; else qs[t * 64 + lane] = y;
                }
                float* co = P->out + O_SCONV + ((size_t)layer * DECB + b) * 3 * 512 + ch;
#pragma unroll
                for (int r = 0; r < 3; ++r) co[r * 512] = up[8 + r];
            }
        }
        asm volatile("s_waitcnt lgkmcnt(0)" ::: "memory");
        float nv = P->in[I_SN][(((size_t)layer * DECB + b) * 4 + h) * 64 + lane];
        float mm = P->in[I_SM][((size_t)layer * DECB + b) * 4 + h];
        const float bfv = P->in[I_BF][layer * 4 + h], biv = P->in[I_BI][layer * 4 + h];
        LAS float* fsl = as; LAS float* denl = as + 8; LAS float* emnl = as + 16;
#pragma unroll 1
        for (int t = 0; t < 8; ++t) {
            const float* gp = projg + (size_t)(row0 + t) * 32;
            const float lf = log_sigmoid(gp[20 + h] + bfv), li = gp[16 + h] + biv;
            const float mn = fmaxf(lf + mm, li);
            const float fsv = expf(lf + mm - mn), is = expf(li - mn);
            vl[t * 64 + lane] = bf2f(proj[(size_t)(row0 + t) * NPROJ + C_VM + h * 64 + lane]) * is;
            nv = fsv * nv + is * ks[t * 64 + lane];
            const float dn = wave_sum(qs[t * 64 + lane] * nv);
            if (lane == 0) { fsl[t] = fsv; denl[t] = dn; emnl[t] = expf(-mn); }
            mm = mn;
        }
        asm volatile("s_waitcnt lgkmcnt(0)" ::: "memory");
#pragma unroll 1
        for (int hf = 0; hf < 2; ++hf) {
            const float* c0p = P->in[I_SC] + (((size_t)layer * DECB + b) * 4 + h) * 4096 + hf * 2048 + lane;
            float S[32];
#pragma unroll
            for (int d = 0; d < 32; ++d) S[d] = c0p[d * 64];
#pragma unroll 1
            for (int t = 0; t < 8; ++t) {
                const float v = vl[t * 64 + lane], fsv = fsl[t];
                float o = 0.f;
#pragma unroll
                for (int d4 = 0; d4 < 8; ++d4) {
                    const f32x4 kk = *(const LAS f32x4*)(ks + t * 64 + hf * 32 + 4 * d4), qq = *(const LAS f32x4*)(qs + t * 64 + hf * 32 + 4 * d4);
#pragma unroll
                    for (int e = 0; e < 4; ++e) { S[4 * d4 + e] = fsv * S[4 * d4 + e] + kk[e] * v; o += qq[e] * S[4 * d4 + e]; }
                }
                ol[t * 64 + lane] = hf ? ol[t * 64 + lane] + o : o;
            }
            float* so = P->out + O_SC + (((size_t)layer * DECB + b) * 4 + h) * 4096 + hf * 2048 + lane;
#pragma unroll
            for (int d = 0; d < 32; ++d) so[d * 64] = S[d];
        }
        const float gn = P->in[I_GMLSTM][layer * 256 + h * 64 + lane];
#pragma unroll 1
        for (int t = 0; t < 8; ++t) {
            const float hv = ol[t * 64 + lane] / fmaxf(fabsf(denl[t]), emnl[t]);
            const float rn = rsqrtf(wave_sum(hv * hv) * (1.0f / 64.0f) + EPS);
            const float g = bf2f(proj[(size_t)(row0 + t) * NPROJ + C_OM + h * 64 + lane]);
            og[(size_t)(row0 + t) * DM + 768 + h * 64 + lane] = f2bf(hv * rn * gn * sigmoidf(g));
        }
        P->out[O_SN + (((size_t)layer * DECB + b) * 4 + h) * 64 + lane] = nv;
        if (lane == 0) P->out[O_SM + ((size_t)layer * DECB + b) * 4 + h] = mm;
    }
    asm volatile("s_waitcnt lgkmcnt(0)" ::: "memory");
}
constexpr int AP_BUF = 36864, AP_POFF = 2 * AP_BUF, AP_PW = 8448, AP_END = AP_POFF + 8 * AP_PW;
static_assert(AP_END <= LDS_BYTES - 64, "attention lds");
__device__ __forceinline__ void attn_prompt_tile(const bf16* __restrict__ q, const bf16* __restrict__ memK, const bf16* __restrict__ memVt, bf16* __restrict__ att, const int tile, LAS unsigned char* lds) {
    const int tid = opaque_tid(), lane = tid & 63, w = __builtin_amdgcn_readfirstlane(tid >> 6), l15 = lane & 15, l4 = lane >> 4;
    const int b = tile >> 6, head = (tile >> 4) & 3, tt = tile & 15;
    const int R0 = b * SEQ + tt * 128 + 16 * w;
    const bf16* qrow = q + (size_t)(R0 + l15) * DM + head * 256 + 8 * l4;
    bf16x8 yq[8];
#pragma unroll
    for (int ks = 0; ks < 8; ++ks) yq[ks] = *(const bf16x8*)(qrow + 32 * ks);
    const bf16* kg = memK + ((size_t)b * 256) * 1024 + head * 256;
    const bf16* vg = memVt + (((size_t)b * 4 + head) * 256) * 256;
    u32x4 stA[4], stB[4];
#define AP_LOAD(n, ST) do { _Pragma("unroll") for (int i_ = 0; i_ < 4; ++i_) { const int p_ = tid + 512 * i_; \
        if ((n) < 4) ST[i_] = *(const u32x4*)(kg + (size_t)(64 * (n) + (p_ >> 5)) * 1024 + (p_ & 31) * 8); \
        else ST[i_] = *(const u32x4*)(vg + (size_t)(p_ >> 3) * 256 + 64 * ((n) - 4) + (p_ & 7) * 8); } } while (0)
#define AP_STORE(n, ST) do { LAS unsigned char* bb_ = lds + ((n) & 1) * AP_BUF; _Pragma("unroll") for (int i_ = 0; i_ < 4; ++i_) { const int p_ = tid + 512 * i_; \
        if ((n) < 4) *(LAS u32x4*)(bb_ + ((p_ >> 5) * 264 + (p_ & 31) * 8) * 2) = ST[i_]; \
        else { const int d_ = p_ >> 3, sl_ = (d_ & ~31) | (((d_ >> 2) & 1) << 4) | (((d_ >> 3) & 3) << 2) | (d_ & 3);     \
               *(LAS u32x4*)(bb_ + (sl_ * 72 + (p_ & 7) * 8) * 2) = ST[i_]; } } } while (0)
    AP_LOAD(0, stA); AP_LOAD(1, stB); AP_STORE(0, stA);
    __syncthreads();
    f32x4 s[16];
    f32x4 o[16];
    float inv = 0.f;
    LAS unsigned char* Pw = lds + AP_POFF + w * AP_PW;
#pragma unroll
    for (int n = 0; n < 8; ++n) {
        if (n < 6) { if (n & 1) AP_LOAD(n + 2, stB); else AP_LOAD(n + 2, stA); }
        const LAS unsigned char* bb = lds + (n & 1) * AP_BUF;
        if (n < 4) {
#pragma unroll
            for (int j4 = 0; j4 < 4; ++j4) {
                f32x4 a = (f32x4){0.f, 0.f, 0.f, 0.f};
#pragma unroll
                for (int ks = 0; ks < 8; ++ks) a = mma16(lfrag(bb, 16 * j4 + l15, 264, 32 * ks + 8 * l4), yq[ks], a);
                s[4 * n + j4] = a;
            }
            if (n == 3) {
                float mx = -3.0e38f;
#pragma unroll
                for (int jt = 0; jt < 16; ++jt) mx = fmaxf(mx, fmaxf(fmaxf(s[jt][0], s[jt][1]), fmaxf(s[jt][2], s[jt][3])));
                mx = fmaxf(mx, __shfl_xor(mx, 16)); mx = fmaxf(mx, __shfl_xor(mx, 32));
                float sum = 0.f;
#pragma unroll
                for (int jt = 0; jt < 16; ++jt) {
#pragma unroll
                    for (int r = 0; r < 4; ++r) { const float p = __expf(s[jt][r] - mx); s[jt][r] = p; sum += p; }
                }
                sum += __shfl_xor(sum, 16); sum += __shfl_xor(sum, 32);
                inv = 1.0f / sum;
#pragma unroll
                for (int jt = 0; jt < 16; ++jt) { u32x2 wv; wv.x = pk2(s[jt][0], s[jt][1]); wv.y = pk2(s[jt][2], s[jt][3]); *(LAS u32x2*)(Pw + (l15 * 264 + jt * 16 + 4 * l4) * 2) = wv; }
#pragma unroll
                for (int dt = 0; dt < 16; ++dt) o[dt] = (f32x4){0.f, 0.f, 0.f, 0.f};
                asm volatile("s_waitcnt lgkmcnt(0)" ::: "memory");
            }
        } else {
#pragma unroll
            for (int k2 = 0; k2 < 2; ++k2) {
                const bf16x8 y = lfrag(Pw, l15, 264, 64 * (n - 4) + 32 * k2 + 8 * l4);
#pragma unroll
                for (int dt = 0; dt < 16; ++dt) o[dt] = mma16(lfrag(bb, 16 * dt + l15, 72, 32 * k2 + 8 * l4), y, o[dt]);
            }
        }
        if (n < 7) { if (n & 1) AP_STORE(n + 1, stA); else AP_STORE(n + 1, stB); __syncthreads(); }
    }
#undef AP_LOAD
#undef AP_STORE
    bf16* orow = att + (size_t)(R0 + l15) * DM + head * 256 + 8 * l4;
#pragma unroll
    for (int dp = 0; dp < 8; ++dp) { u32x4 wv; wv.x = pk2(o[2 * dp][0] * inv, o[2 * dp][1] * inv); wv.y = pk2(o[2 * dp][2] * inv, o[2 * dp][3] * inv);
        wv.z = pk2(o[2 * dp + 1][0] * inv, o[2 * dp + 1][1] * inv); wv.w = pk2(o[2 * dp + 1][2] * inv, o[2 * dp + 1][3] * inv); *(u32x4*)(orow + dp * 32) = wv; }
}

constexpr int AS_PT = 0, AS_OP = 16384, AS_MX = 81920, AS_SM = 82944, AS_END = 83968;
__device__ __forceinline__ void attn_sample_tile(const bf16* __restrict__ q, const float* __restrict__ ck, const float* __restrict__ cv, bf16* __restrict__ att, const int tile, LAS unsigned char* lds) {
    const int tid = opaque_tid(), lane = tid & 63, w = __builtin_amdgcn_readfirstlane(tid >> 6), l15 = lane & 15, l4 = lane >> 4;
    const int b = tile >> 1, hl = w >> 2, head = (tile & 1) * 2 + hl, qtr = w & 3;
    const int R0 = MP + b * DECT;
    const bf16* qrow = q + (size_t)(R0 + (l15 & 7)) * DM + head * 256 + 4 * l4;
    bf16x8 yq[8];
#pragma unroll
    for (int ks = 0; ks < 8; ++ks) { const u32x2 qa = *(const u32x2*)(qrow + 32 * ks), qc = *(const u32x2*)(qrow + 32 * ks + 16); u32x4 qw; qw.x = qa.x; qw.y = qa.y; qw.z = qc.x; qw.w = qc.y; yq[ks] = __builtin_bit_cast(bf16x8, qw); }
    const float* kb = ck + (((size_t)b * 256 + 64 * qtr + l15) * 4 + head) * 256 + 4 * l4;
    f32x4 s[4];
    f32x4 ka0[8], kc0[8], ka1[8], kc1[8];
#define AS_KLOAD(KA, KC, jt) do { _Pragma("unroll") for (int ks_ = 0; ks_ < 8; ++ks_) { const f32x4* kp_ = (const f32x4*)(kb + (size_t)(jt) * 16 * 1024 + 32 * ks_); KA[ks_] = __builtin_nontemporal_load(kp_); KC[ks_] = __builtin_nontemporal_load(kp_ + 4); } } while (0)
#define AS_KMMA(KA, KC, jt) do { s[jt] = (f32x4){0.f, 0.f, 0.f, 0.f}; _Pragma("unroll") for (int ks_ = 0; ks_ < 8; ++ks_) { \
        u32x4 xw_; xw_.x = pk2(KA[ks_][0], KA[ks_][1]); xw_.y = pk2(KA[ks_][2], KA[ks_][3]); xw_.z = pk2(KC[ks_][0], KC[ks_][1]); xw_.w = pk2(KC[ks_][2], KC[ks_][3]); \
        s[jt] = mma16(__builtin_bit_cast(bf16x8, xw_), yq[ks_], s[jt]); } } while (0)
    AS_KLOAD(ka0, kc0, 0); AS_KLOAD(ka1, kc1, 1);
    AS_KMMA(ka0, kc0, 0); AS_KLOAD(ka0, kc0, 2);
    AS_KMMA(ka1, kc1, 1); AS_KLOAD(ka1, kc1, 3);
    AS_KMMA(ka0, kc0, 2);
    AS_KMMA(ka1, kc1, 3);
#undef AS_KLOAD
#undef AS_KMMA
    LAS float* MX = (LAS float*)(lds + AS_MX); LAS float* SM = (LAS float*)(lds + AS_SM);
    float mx = -3.0e38f;
#pragma unroll
    for (int jt = 0; jt < 4; ++jt) mx = fmaxf(mx, fmaxf(fmaxf(s[jt][0], s[jt][1]), fmaxf(s[jt][2], s[jt][3])));
    mx = fmaxf(mx, __shfl_xor(mx, 16)); mx = fmaxf(mx, __shfl_xor(mx, 32));
    if (lane < 16) MX[w * 16 + lane] = mx;
    __syncthreads();
    {
        const int wb = hl * 4;
        mx = fmaxf(fmaxf(MX[(wb + 0) * 16 + l15], MX[(wb + 1) * 16 + l15]), fmaxf(MX[(wb + 2) * 16 + l15], MX[(wb + 3) * 16 + l15]));
    }
    float sum = 0.f;
#pragma unroll
    for (int jt = 0; jt < 4; ++jt) {
#pragma unroll
        for (int r = 0; r < 4; ++r) { const float p = __expf(s[jt][r] - mx); s[jt][r] = p; sum += p; }
    }
    sum += __shfl_xor(sum, 16); sum += __shfl_xor(sum, 32);
    if (lane < 16) SM[w * 16 + lane] = sum;
#pragma unroll
    for (int jt = 0; jt < 4; ++jt)
#pragma unroll
        for (int r = 0; r < 4; ++r) { float t_ = s[jt][r]; asm volatile("" : "+v"(t_)); s[jt][r] = t_; }
    float acc[8][4];
#pragma unroll
    for (int t = 0; t < 8; ++t)
#pragma unroll
        for (int e = 0; e < 4; ++e) acc[t][e] = 0.f;
    const float* vb = cv + (((size_t)b * 256 + 64 * qtr) * 4 + head) * 256 + lane * 4;
#pragma unroll
    for (int bi = 0; bi < 4; ++bi) {
        f32x4 v[16];
#pragma unroll
        for (int jj = 0; jj < 16; ++jj) v[jj] = __builtin_nontemporal_load((const f32x4*)(vb + (size_t)(16 * bi + jj) * 1024));
#pragma unroll
        for (int jj = 0; jj < 16; ++jj) {
#pragma unroll
            for (int t = 0; t < 8; ++t) {
                const float p = __shfl(s[bi][jj & 3], 16 * (jj >> 2) + t);
#pragma unroll
                for (int e = 0; e < 4; ++e) acc[t][e] += p * v[jj][e];
            }
        }
    }
    LAS float* OP = (LAS float*)(lds + AS_OP);
#pragma unroll
    for (int t = 0; t < 8; ++t) *(LAS f32x4*)(OP + (w * 8 + t) * 256 + lane * 4) = (f32x4){acc[t][0], acc[t][1], acc[t][2], acc[t][3]};
    __syncthreads();
    {
        const int wb = hl * 4;
#pragma unroll
        for (int tt = 0; tt < 2; ++tt) {
            const int t = 2 * qtr + tt;
            const float tot = (SM[(wb + 0) * 16 + t] + SM[(wb + 1) * 16 + t]) + (SM[(wb + 2) * 16 + t] + SM[(wb + 3) * 16 + t]);
            const float inv = 1.0f / tot;
            f32x4 o = *(const LAS f32x4*)(OP + ((wb + 0) * 8 + t) * 256 + lane * 4);
            o += *(const LAS f32x4*)(OP + ((wb + 1) * 8 + t) * 256 + lane * 4);
            o += *(const LAS f32x4*)(OP + ((wb + 2) * 8 + t) * 256 + lane * 4);
            o += *(const LAS f32x4*)(OP + ((wb + 3) * 8 + t) * 256 + lane * 4);
            u32x2 wv; wv.x = pk2(o[0] * inv, o[1] * inv); wv.y = pk2(o[2] * inv, o[3] * inv);
            *(u32x2*)(att + (size_t)(R0 + t) * DM + head * 256 + lane * 4) = wv;
        }
    }
}
constexpr int N_PHASES = 20;
#ifndef DBG_S_REPS
#define DBG_S_REPS 0
#endif
#ifndef DBG_E_REP
#define DBG_E_REP 0
#endif
#ifndef DBG_GEMM_REPS
#define DBG_GEMM_REPS 1
#endif
#ifndef DBG_SMALL_REPS
#define DBG_SMALL_REPS 1
#endif
#ifndef DBG_UNIT_REPS
#define DBG_UNIT_REPS 1
#endif
#ifndef DBG_EXTRA_BARS
#define DBG_EXTRA_BARS 0
#endif
#ifndef DBG_NOLO
#define DBG_NOLO 0
#endif
#ifndef REP_MASK
#define REP_MASK 0
#endif
__host__ __device__ constexpr bool rep_sub(int s9) { return s9 == 1 ? ((REP_MASK >> 10) & 1) : (s9 == 0 ? (REP_MASK & 1) : (((REP_MASK >> (s9 - 1)) & 1) && (s9 - 1) != 2 && (s9 - 1) != 5 && (s9 - 1) != 7)); }
#ifndef HP_LEVEL
#define HP_LEVEL 0
#endif
#ifndef DBG_VAR
#define DBG_VAR 0
#endif
#ifndef DBG_TYPES
#define DBG_TYPES 7
#endif
#ifndef DBG_REPS
#define DBG_REPS 1
#endif
#ifndef DBG_REP_SAMPLE
#define DBG_REP_SAMPLE 0
#endif
#ifndef USE_CG_SYNC
#define USE_CG_SYNC 0
#endif
#ifndef DBG_STOP
#define DBG_STOP 0
#endif
#define DBG_ONLY 0
#define DBG_SKIP_HELPER 0
#define DBG_EXPR ((i < (size_t)MP * DM && (i % 1024) < 384) ? bf2f(og[i]) : 0.f)
__device__ __forceinline__ void phase_dump(PP P) {
    const size_t n = (size_t)MT * DM;
    const bf16* proj = (const bf16*)(P->ws + WS_PROJ); const bf16* og = (const bf16*)(P->ws + WS_O); const bf16* qb = (const bf16*)(P->ws + WS_Q);
    const bf16* att = (const bf16*)(P->ws + WS_ATT); const bf16* hb = (const bf16*)(P->ws + WS_H); const float* xf = (const float*)(P->ws + WS_XF);
    const bf16* xb = (const bf16*)(P->ws + WS_XB); const float* projg = (const float*)(P->ws + WS_PROJG); const float* rss = (const float*)(P->ws + WS_RSS);
    for (size_t i = (size_t)blockIdx.x * NTHREADS + threadIdx.x; i < n; i += (size_t)gridDim.x * NTHREADS) {
        float v = 0.f;
#if DBG_ONLY
        v = DBG_EXPR;
#elif DBG_STOP >= 1
        v += bf2f(proj[i]) + bf2f(proj[i + n]) + bf2f(proj[i + 2 * n]) + bf2f(proj[(i + 3 * n) % ((size_t)MT * NPROJ)]) + projg[i % ((size_t)MT * 32)] + bf2f(xb[i]) + rss[i % ((size_t)MT * 16)];
#endif
#if DBG_STOP >= 2
        v += bf2f(og[i]);
#endif
#if DBG_STOP >= 3
        v += xf[i];
#endif
#if DBG_STOP >= 4
        v += bf2f(qb[i]);
#endif
#if DBG_STOP >= 5
        v += bf2f(att[i]);
#endif
#if DBG_STOP >= 7
        v += bf2f(hb[i]) + bf2f(hb[i + n]) + bf2f(hb[(i + 2 * n) % ((size_t)MT * DFF)]);
#endif
        P->out[i] = v;
    }
#ifdef DBG_KEEP
    {
        const size_t g0[4] = {O_YP, O_PRET, O_PMK, O_SRET}, g1[4] = {O_PRET, O_PMK, O_SRET, O_END};
#pragma unroll
        for (int k = 0; k < 4; ++k) if (!((DBG_KEEP >> k) & 1)) {
            for (size_t i = g0[k] + (size_t)blockIdx.x * NTHREADS + threadIdx.x; i < g1[k]; i += (size_t)gridDim.x * NTHREADS) P->out[i] = 1.0f; }
    }
#endif
#if DBG_STOP < 10
    {
        const size_t offs[13] = {O_PRET, O_PGLA, O_PC, O_PN, O_PM, O_PCONV, O_PMK, O_SRET, O_SGLA, O_SC, O_SN, O_SM, O_SCONV};
        const size_t ends[13] = {O_PGLA, O_PC, O_PN, O_PM, O_PCONV, O_PMK, O_PMK, O_SGLA, O_SC, O_SN, O_SM, O_SCONV, O_END};
#pragma unroll
        for (int k = 0; k < 13; ++k) { const size_t half = (ends[k] - offs[k]) / 2;
            for (size_t i = (size_t)blockIdx.x * NTHREADS + threadIdx.x; i < half; i += (size_t)gridDim.x * NTHREADS) P->out[offs[k] + half + i] = 1.0f; }
    }
#endif
}

__device__ __forceinline__ void unit_of_block256(const int c, pg8::Unit& u) { const int xcd = c & 7, off = c >> 3; u.pm = 8 * xcd + (off & 7); u.pn = off >> 3; }

__device__ __forceinline__ void finalize_panel(PP P, unsigned* cnt, const unsigned need, const int row0, const int nrows, LAS unsigned char* lds) {
    const int tid = opaque_tid(), lane = tid & 63, wave = __builtin_amdgcn_readfirstlane(tid >> 6);
    volatile LAS unsigned* flag = (volatile LAS unsigned*)(lds + LDS_BYTES - 64) + 8;
    asm volatile("s_waitcnt vmcnt(0)" ::: "memory");
    __syncthreads();
    if (tid == 0) {
        __builtin_amdgcn_fence(__ATOMIC_RELEASE, "agent");
        asm volatile("s_waitcnt vmcnt(0)" ::: "memory");
        flag[0] = __hip_atomic_fetch_add(cnt, 1u, __ATOMIC_RELAXED, __HIP_MEMORY_SCOPE_AGENT);
    }
    __syncthreads();
    const bool last = (flag[0] == need - 1u);
    if (last) {
        if (tid == 0) { __builtin_amdgcn_fence(__ATOMIC_ACQUIRE, "agent"); asm volatile("s_waitcnt vmcnt(0)" ::: "memory"); }
        __syncthreads();
        const float* xf = (const float*)(P->ws + WS_XF); const float* rss = (const float*)(P->ws + WS_RSS); const float* g = P->in[I_GFINAL];
        for (int r = wave; r < nrows; r += 8) {
            const int row = row0 + r;
            const float rs = row_rscale(rss, row);
#pragma unroll
            for (int j = 0; j < 4; ++j) {
                const int c = (lane + 64 * j) * 4;
                const f32x4 v = *(const f32x4*)(xf + (size_t)row * DM + c), gg = *(const f32x4*)(g + c);
                *(f32x4*)(P->out + O_YP + (size_t)row * DM + c) = v * rs * gg;
            }
        }
    }
    __syncthreads();
}

__device__ __forceinline__ void run_phase(PP P, const int ph_in, LAS unsigned char* lds) {
    const int nolo = ph_in >= 100 && ph_in != 199 ? 1 : 0; const int ph = (ph_in >= 100 && ph_in != 199) ? ph_in - 100 : (ph_in == 199 ? 99 : ph_in);
    unsigned char* ws = P->ws;
    bf16* xb = (bf16*)(ws + WS_XB); float* xf = (float*)(ws + WS_XF); float* rss = (float*)(ws + WS_RSS);
    bf16* proj = (bf16*)(ws + WS_PROJ); float* projg = (float*)(ws + WS_PROJG);
    bf16* og = (bf16*)(ws + WS_O); bf16* qb = (bf16*)(ws + WS_Q); bf16* att = (bf16*)(ws + WS_ATT); bf16* hb = (bf16*)(ws + WS_H);
    if (ph == 99) { phase_dump(P); return; }
    if (ph == 0) { phase_prep(P, lds); return; }
    if (ph == N_PHASES - 1) { phase_final(P); return; }
    const int l = (ph - 1) / 9, sub0 = (ph - 1) % 9;
    if (sub0 == 1) { phase_premix(P, l, lds, nolo ? DBG_PM_MASK : 7); return; }
    const int sub = sub0 == 0 ? 0 : sub0 - 1;
    const int G = gridDim.x, bx = blockIdx.x;
    switch (sub) {
    case 0: {
        pg8::Gemm g{xb, (const bf16*)(ws + WS_WIN) + (size_t)l * NPROJ * DM, MT, NPROJ, DM};
        pg8::StaticOrder S; S.init(MT, NPROJ, G, bx);
        EpiScaleBf16 E{proj, NPROJ, rss, 1.0f, projg, 14, nolo};
        pg8::gemm_phase<EpiScaleBf16, pg8::StaticOrder, true, true>(lds, g, S, E);
    } break;
    case 1: {
        const bool hp = (G == 256) && (HP_LEVEL > 0);
        const int otid0 = opaque_tid();
        HlpBarrier hbar; hbar.bar = nullptr; hbar.x = 0; hbar.st = nullptr;
        if (hp && bx >= 128) {
            volatile LAS unsigned* hst = (volatile LAS unsigned*)(lds + LDS_BYTES - 64) + 2;
            if (otid0 == 0) { hst[0] = 0u; hst[1] = 0u; }
            __syncthreads();
            hbar = hlp_barrier_post((unsigned*)(ws + WS_CTL) + (1 + l) * 4096, hst);
        }
        for (int task = bx; task < 256; task += G) {
            __syncthreads();
            if (task < 128) {
                const int b = task >> 4, hh = task & 15;
#if DBG_VAR
                for (int rep = 0; rep < DBG_REPS; ++rep) {
                if (hh < 6) { if (DBG_TYPES & 1) mixer_chain<0, DBG_VAR>(P, l, b, hh, lds); }
                else if (hh < 12) { if (DBG_TYPES & 2) mixer_chain<1, DBG_VAR>(P, l, b, hh - 6, lds); }
                else { if (DBG_TYPES & 4) mixer_chain<2, DBG_VAR>(P, l, b, hh - 12, lds); }
                __syncthreads(); }
#endif
                if (hh < 6) mixer_chain<0>(P, l, b, hh, lds);
                else if (hh < 12) mixer_chain<1>(P, l, b, hh - 6, lds);
                else mixer_chain<2>(P, l, b, hh - 12, lds);
            } else {
                const int hidx = task - 128;
                if (hidx < 64) {
                    const int lay = l, un = hidx;
                    pg8::Gemm g{(const bf16*)(ws + WS_MEMB), (const bf16*)(ws + WS_WXKV) + (size_t)lay * 2048 * DM, 2048, 2048, DM};
                    ListOrder S{un, un + 1, 1, 8};
                    EpiMemKV E{P->out + O_PMK + (size_t)lay * 2048 * 1024, P->out + O_PMV + (size_t)lay * 2048 * 1024,
                               (bf16*)(ws + WS_MEMK) + (size_t)lay * 2048 * 1024, (bf16*)(ws + WS_MEMVT) + (size_t)lay * 2048 * 1024, (const float*)(ws + WS_RMEM)};
                    pg8::gemm_phase<EpiMemKV, ListOrder, true, true>(lds, g, S, E);
                    __syncthreads();
                }
                const int otid = opaque_tid(); const int lane = otid & 63, wave = __builtin_amdgcn_readfirstlane(otid >> 6);
                {
                    const int nk = (hidx < 64) ? 1 : 3;
                    const int base = (hidx < 64) ? hidx * 8 + wave : 512 + ((hidx - 64) * 8 + wave) * 3;
                    for (int k = 0; k < nk * (1 + DBG_REP_SAMPLE); ++k) {
                        const int wt = base + (k % nk);
                        sample_mixer(P, l, wt >> 4, wt & 15, lds + wave * 10240, lane);
                    }
                }
                if (hp) {
                    hlp_barrier(hbar);
                    { EpiResid E{xb, rss};
                      for (int t = hidx; t < 256; t += 128) small_gemm_tile(og, (const bf16*)(ws + WS_WOUT) + (size_t)l * DM * DM, DM, MP + 64 * (t >> 4), 64 * (t & 15), E, lds); }
                    hlp_barrier(hbar);
                    { EpiScaleBf16 E{qb, DM, rss, 0.0625f, nullptr, -1};
                      for (int t = hidx; t < 256; t += 128) small_gemm_tile(xb, (const bf16*)(ws + WS_WXQ) + (size_t)l * DM * DM, DM, MP + 64 * (t >> 4), 64 * (t & 15), E, lds); }
#if HP_LEVEL >= 4
                    hlp_barrier(hbar);
                    { const float* ck = P->in[I_CK] + (size_t)l * DECB * 256 * 1024; const float* cv = P->in[I_CV] + (size_t)l * DECB * 256 * 1024;
                      for (int t = hidx; t < 256; t += 128) { __syncthreads(); attn_sample_tile(qb, ck, cv, att, t, lds); } }
                    hlp_barrier(hbar);
                    { EpiResid E{xb, rss};
                      for (int t = hidx; t < 256; t += 128) small_gemm_tile(att, (const bf16*)(ws + WS_WXO) + (size_t)l * DM * DM, DM, MP + 64 * (t >> 4), 64 * (t & 15), E, lds); }
#endif
                }
            }
        }
    } break;
    case 2: {
        pg8::Gemm g{og, (const bf16*)(ws + WS_WOUT) + (size_t)l * DM * DM, MP, DM, DM};
        pg8::StaticOrder S; S.init(MP, DM, G, bx);
        EpiResid E{xb, rss};
        if (G == 256) pg8::gemm_phase<EpiResid, pg8::StaticOrder, true, true, true>(lds, g, S, E);
        else { pg8::gemm_phase<EpiResid, pg8::StaticOrder, true, true>(lds, g, S, E);
               for (int t = bx; t < 256; t += G) small_gemm_tile(g.A, g.Bt, DM, MP + 64 * (t >> 4), 64 * (t & 15), E, lds); }
    } break;
    case 3: {
        pg8::Gemm g{xb, (const bf16*)(ws + WS_WXQ) + (size_t)l * DM * DM, MP, DM, DM};
        pg8::StaticOrder S; S.init(MP, DM, G, bx);
        EpiScaleBf16 E{qb, DM, rss, 0.0625f, nullptr, -1};
        if (G == 256) pg8::gemm_phase<EpiScaleBf16, pg8::StaticOrder, true, true, true>(lds, g, S, E);
        else { pg8::gemm_phase<EpiScaleBf16, pg8::StaticOrder, true, true>(lds, g, S, E);
               for (int t = bx; t < 256; t += G) small_gemm_tile(g.A, g.Bt, DM, MP + 64 * (t >> 4), 64 * (t & 15), E, lds); }
    } break;
    case 4: {
        const bf16* memK = (const bf16*)(ws + WS_MEMK) + (size_t)l * 2048 * 1024; const bf16* memVt = (const bf16*)(ws + WS_MEMVT) + (size_t)l * 2048 * 1024;
        const float* ck = P->in[I_CK] + (size_t)l * DECB * 256 * 1024; const float* cv = P->in[I_CV] + (size_t)l * DECB * 256 * 1024;
        if (G == 256 && HP_LEVEL < 4) {
            pg8::Unit u; unit_of_block256(bx, u);
            const int pt0 = (u.pm >> 3) * 64 + u.pn * 16 + 2 * (u.pm & 7), st = 4 * u.pm + u.pn;
            for (int i = 0; i < 3; ++i) {
                const int idx = (u.pm & 1) ? (i == 2 ? 0 : i + 1) : i;
                __syncthreads();
                if (idx == 0) { attn_sample_tile(qb, ck, cv, att, st, lds); for (int r_ = 0; r_ < DBG_S_REPS; ++r_) { __syncthreads(); attn_sample_tile(qb, ck, cv, att, st, lds); } }
                else { attn_prompt_tile(qb, memK, memVt, att, pt0 + idx - 1, lds); if (DBG_E_REP & 2) { __syncthreads(); attn_prompt_tile(qb, memK, memVt, att, pt0 + idx - 1, lds); } }
            }
        } else
        for (int task = ((G == 256 && HP_LEVEL >= 4) ? 256 + bx : bx); task < 256 + 512; task += G) {
            __syncthreads();
            if (task < 256) attn_sample_tile(qb, ck, cv, att, task, lds);
            else attn_prompt_tile(qb, memK, memVt, att, task - 256, lds);
        }
    } break;
    case 5: {
        pg8::Gemm g{att, (const bf16*)(ws + WS_WXO) + (size_t)l * DM * DM, MP, DM, DM};
        pg8::StaticOrder S; S.init(MP, DM, G, bx);
        EpiResid E{xb, rss};
        if (G == 256) pg8::gemm_phase<EpiResid, pg8::StaticOrder, true, true, true>(lds, g, S, E);
        else { pg8::gemm_phase<EpiResid, pg8::StaticOrder, true, true>(lds, g, S, E);
               for (int t = bx; t < 256; t += G) small_gemm_tile(g.A, g.Bt, DM, MP + 64 * (t >> 4), 64 * (t & 15), E, lds); }
    } break;
    case 6: {
        pg8::Gemm g{xb, (const bf16*)(ws + WS_WGU) + (size_t)l * NGU * DM, MT, NGU, DM};
        pg8::StaticOrder S; S.init(MT, NGU, G, bx);
        EpiGU E{hb, rss, nolo};
        pg8::gemm_phase<EpiGU, pg8::StaticOrder, true, true>(lds, g, S, E);
    } break;
    case 7: {
        pg8::Gemm g{hb, (const bf16*)(ws + WS_WDN) + (size_t)l * DM * DFF, MP, DM, DFF};
        pg8::StaticOrder S; S.init(MP, DM, G, bx);
        if (l == DEPTH - 1 && G == 256) {
            unsigned* fcnt = (unsigned*)(ws + WS_CTL) + 16384;
            EpiResidFinal E{xb, rss, fcnt, P->in[I_GFINAL], P->out + O_YP, ((volatile LAS unsigned*)(lds + LDS_BYTES - 64))[14] == 2u ? 1 : 0};
            pg8::gemm_phase<EpiResidFinal, pg8::StaticOrder, true, true, true>(lds, g, S, E);
        } else {
            EpiResid E{xb, rss};
            if (G == 256) pg8::gemm_phase<EpiResid, pg8::StaticOrder, true, true, true>(lds, g, S, E);
            else { pg8::gemm_phase<EpiResid, pg8::StaticOrder, true, true>(lds, g, S, E);
                   for (int t = bx; t < 256; t += G) small_gemm_tile(g.A, g.Bt, DFF, MP + 64 * (t >> 4), 64 * (t & 15), E, lds); }
        }
    } break;
    }
}

__device__ __forceinline__ void group_meet(PP P, const unsigned seq, LAS unsigned char* lds) {
    pg8::Unit u; unit_of_block256(blockIdx.x, u);
    unsigned* ctl = (unsigned*)(P->ws + WS_CTL);
    volatile LAS unsigned* gf = (volatile LAS unsigned*)(lds + LDS_BYTES - 64) + 14;
    unsigned f = gf[0];
    if (f == 0u) {
        __syncthreads();
        if (threadIdx.x == 0) { const unsigned mk = xb_ld(ctl + 31744 + u.pm); gf[0] = (mk != 0u && (mk & (mk - 1u)) == 0u) ? 2u : 3u; }
        __syncthreads();
        f = gf[0];
    }
    panel_meet(ctl + 25600 + 64 * u.pm, 4u * seq, f == 2u);
}

__global__ void __launch_bounds__(NTHREADS, 2) k_run(Params Pval) {
    PP P = get_params();
    extern __shared__ __attribute__((aligned(16))) unsigned char lds_raw[];
    LAS unsigned char* lds = (LAS unsigned char*)lds_raw;
    const int lo = P->ph_lo, hi = P->ph_hi;
#if USE_CG_SYNC
    cg::grid_group grid = cg::this_grid();
#define SEAM() grid.sync()
#else
    volatile LAS unsigned* bst = (volatile LAS unsigned*)(lds + LDS_BYTES - 64);
    if (threadIdx.x < 16) bst[threadIdx.x] = 0u;
    __syncthreads();
    XcdBarrier bar = xcd_barrier_post((unsigned*)(P->ws + WS_CTL), bst);
    if (threadIdx.x == 0 && gridDim.x == 256) { pg8::Unit u0; unit_of_block256(blockIdx.x, u0);
        (void)__hip_atomic_fetch_or((unsigned*)(P->ws + WS_CTL) + 31744 + u0.pm, 1u << xb_xcc_id(), __ATOMIC_RELAXED, __HIP_MEMORY_SCOPE_AGENT); }
#define SEAM() xcd_barrier(bar)
#endif
#ifndef REP_MASK
#define REP_MASK 0
#endif
#define GROUP_SEAM(k) ((k) == 4 ? 1 : (k) == 5 ? 2 : (k) == 6 ? 3 : (k) == 13 ? 4 : (k) == 14 ? 5 : (k) == 15 ? 6 : 0)
#define REPEAT(k) (((k) == 0 && (REP_MASK & 256)) || ((k) == 4 && (REP_MASK & 512)) || ((k) >= 1 && (k) <= 18 && rep_sub(((k) - 1) % 9)))
#ifndef DBG_PREFIX_K
#define DBG_PREFIX_K (-1)
#endif
#define N_PRE_MEETS ((4 < DBG_PREFIX_K) + (5 < DBG_PREFIX_K) + (6 < DBG_PREFIX_K) + (13 < DBG_PREFIX_K) + (14 < DBG_PREFIX_K) + (15 < DBG_PREFIX_K))
#define PREPASS(k) if ((k) <= DBG_PREFIX_K) { run_phase(get_params(), (k), lds); \
    if (((k) == 3 || (k) == 12) && gridDim.x == 256) { __syncthreads(); deferred_items(get_params(), (k) == 12 ? 1 : 0, lds, 1, 0); deferred_items(get_params(), (k) == 12 ? 1 : 0, lds, 1, 1); } \
    if (GROUP_SEAM(k) && gridDim.x == 256 && (k) < DBG_PREFIX_K) group_meet(get_params(), GROUP_SEAM(k), lds); else SEAM(); }
#define PHASE(k) if (lo <= (k) && (k) < hi) { if (REPEAT(k)) { run_phase(get_params(), (k) + (DBG_NOLO ? 100 : 0), lds); SEAM(); } \
    if (((k) == 3 || ((k) == 12 && DEFER_L1)) && gridDim.x == 256 && DEFER_ON && DEFER_SPLIT && blockIdx.x >= 128) { deferred_items(get_params(), (k) == 12 ? 1 : 0, lds, 0, 0); __syncthreads(); } \
    run_phase(get_params(), (k), lds); \
    if (((k) == 3 || ((k) == 12 && DEFER_L1)) && gridDim.x == 256 && DEFER_ON && !(blockIdx.x < 128 && (blockIdx.x & 15) >= 12)) { __syncthreads(); deferred_items(get_params(), (k) == 12 ? 1 : 0, lds, 0, 1); }         \
    if ((k) + 1 < hi) { if (GROUP_SEAM(k) && gridDim.x == 256) group_meet(get_params(), GROUP_SEAM(k) + N_PRE_MEETS, lds); else SEAM(); } }
#if DBG_PREFIX_K >= 0
    PREPASS(0) PREPASS(1) PREPASS(2) PREPASS(3) PREPASS(4) PREPASS(5) PREPASS(6) PREPASS(7) PREPASS(8) PREPASS(9) PREPASS(10) PREPASS(11) PREPASS(12) PREPASS(13) PREPASS(14) PREPASS(15) PREPASS(16) PREPASS(17)
#endif
    PHASE(0) PHASE(1) PHASE(2) PHASE(3) PHASE(4) PHASE(5) PHASE(6) PHASE(7) PHASE(8) PHASE(9) PHASE(10) PHASE(11) PHASE(12) PHASE(13) PHASE(14) PHASE(15) PHASE(16) PHASE(17) PHASE(18) PHASE(19)
#if DBG_EXTRA_BARS
    for (int i_ = 0; i_ < DBG_EXTRA_BARS; ++i_) SEAM();
#endif
#undef PHASE
#undef SEAM
    if (lo == 99) run_phase(get_params(), 199, lds);
}

#ifndef ONE_LAUNCH
#define ONE_LAUNCH 1
#endif

extern "C" void kernel_launch(void* const* d_in, const int* in_sizes, int n_in, void* d_out, int out_size, void* d_ws, size_t ws_size, hipStream_t stream) {
    static int grid = 0;
    if (grid == 0) {
        if (n_in != N_IN || (size_t)out_size != O_END || ws_size < WS_END) { fprintf(stderr, "kernel_launch: unexpected shapes n_in %d out %d ws %zu\n", n_in, out_size, ws_size); grid = -1; return; }
        int dev = 0, cus = 0, per_cu = 0;
        if (hipGetDevice(&dev) != hipSuccess || hipDeviceGetAttribute(&cus, hipDeviceAttributeMultiprocessorCount, dev) != hipSuccess) { grid = -1; return; }
        if (hipFuncSetAttribute((const void*)k_run, hipFuncAttributeMaxDynamicSharedMemorySize, LDS_BYTES) != hipSuccess) { fprintf(stderr, "kernel_launch: hipFuncSetAttribute failed\n"); grid = -1; return; }
        if (hipOccupancyMaxActiveBlocksPerMultiprocessor(&per_cu, (const void*)k_run, NTHREADS, LDS_BYTES) != hipSuccess || per_cu < 1) { fprintf(stderr, "kernel_launch: occupancy query says %d\n", per_cu); (void)hipGetLastError(); grid = -1; return; }
        grid = cus;
    }
    if (grid < 0) return;
    if (hipMemsetAsync((char*)d_ws + WS_CTL, 0, 131072, stream) != hipSuccess) { fprintf(stderr, "kernel_launch: memset failed\n"); return; }
    Params p{};
    for (int i = 0; i < N_IN; ++i) p.in[i] = (const float*)d_in[i];
    p.out = (float*)d_out; p.ws = (unsigned char*)d_ws;
#if ONE_LAUNCH
    p.ph_lo = 0; p.ph_hi = (grid == 256) ? N_PHASES - 1 : N_PHASES;
    void* args[] = {&p};
    hipError_t e = hipLaunchCooperativeKernel((const void*)k_run, dim3(grid), dim3(NTHREADS), args, LDS_BYTES, stream);
    if (e != hipSuccess) fprintf(stderr, "cooperative launch failed: %s (grid %d)\n", hipGetErrorString(e), grid);
#else
    for (int ph = 0; ph < (DBG_STOP ? DBG_STOP + 2 : N_PHASES); ++ph) {
        p.ph_lo = ph; p.ph_hi = ph + 1;
        if (DBG_STOP && ph == DBG_STOP + 1) { p.ph_lo = 99; p.ph_hi = 100; }
        hipLaunchKernelGGL(k_run, dim3(grid), dim3(NTHREADS), LDS_BYTES, stream, p);
    }
#endif
}
```
